# Optimizing an MI355X kernel written in HIP

```python
import jax, jax.numpy as jnp
from jax import lax
import numpy as np

D_MODEL = 2048
BATCH = 1
SEQ = 8192
DEPTH = 2

GRID_W = 64
CTX_LEN = 256
HEAD_DIM = 128
N_HEADS = D_MODEL // HEAD_DIM
NA_HEADS = N_HEADS // 2
NA_WIN_H = 8
NA_WIN_W = 16
SW_HEADS = N_HEADS - NA_HEADS
SW_KV_HEADS = 2
SW_RADIUS = 128
GQA_HEADS = N_HEADS
GQA_KV_HEADS = 4
BLOCK = 128
D_FF = ((8 * D_MODEL // 3 + 255) // 256) * 256
MACARON_WEIGHT = 0.5
ROPE_THETA = 10000.0
EPS = 1e-6
NEG_INF = -1e30
N_MOD = 9
N_EVEN = (DEPTH + 1) // 2
N_ODD = DEPTH // 2
AB_IN = (NA_HEADS + SW_HEADS + 2 * NA_HEADS + 2 * SW_KV_HEADS) * HEAD_DIM
C_IN = (GQA_HEADS + 2 * GQA_KV_HEADS) * HEAD_DIM
ATTN_SCALE = HEAD_DIM ** -0.5

kernel_name = 'hybrid_natten_swa_gqa_macaron_dit'


def rms_norm(x, g):
    xf = x.astype(jnp.float32)
    y = xf * lax.rsqrt(jnp.mean(xf * xf, axis=-1, keepdims=True) + EPS)
    return (y * g.astype(jnp.float32)).astype(x.dtype)


def modulate(x, g, shift, scale):
    return rms_norm(x, g) * (1 + scale) + shift


def heads(t, n):
    return t.reshape(t.shape[:-1] + (n, HEAD_DIM))


def swiglu(h, w_gate, w_up, w_down):
    return (jax.nn.silu(h @ w_gate) * (h @ w_up)) @ w_down


def axial_rope_tables(n_tokens):
    t = jnp.arange(n_tokens)
    row = (t // GRID_W).astype(jnp.float32)
    col = (t % GRID_W).astype(jnp.float32)
    axis_dim = HEAD_DIM // 2
    inv = ROPE_THETA ** (-jnp.arange(0, axis_dim, 2, dtype=jnp.float32) / axis_dim)
    ang = jnp.concatenate([row[:, None] * inv, col[:, None] * inv], axis=-1)
    return jnp.cos(ang), jnp.sin(ang)


def apply_rope(x, cos, sin):
    x1, x2 = jnp.split(x.astype(jnp.float32), 2, axis=-1)
    c = cos[None, :, None, :]
    s = sin[None, :, None, :]
    return jnp.concatenate([x1 * c - x2 * s, x1 * s + x2 * c], axis=-1).astype(x.dtype)


def ctx_self_attention(q, k, v, sink=None):
    B, L, Hq, d = q.shape
    Hk = k.shape[2]
    G = Hq // Hk
    qg = q.reshape(B, L, Hk, G, d)
    s = jnp.einsum('blkgd,bmkd->bkglm', qg, k).astype(jnp.float32) * ATTN_SCALE
    if sink is not None:
        sk = jnp.broadcast_to(sink.reshape(Hk, G)[None, :, :, None, None].astype(jnp.float32), s.shape[:-1] + (1,))
        s = jnp.concatenate([s, sk], axis=-1)
    p = jax.nn.softmax(s, axis=-1)[..., :L].astype(v.dtype)
    o = jnp.einsum('bkglm,bmkd->blkgd', p, v)
    return o.reshape(B, L, Hq * d)


def neighbourhood_attention(q, k, v, kc, vc, rel_bias):
    B, S, H, d = q.shape
    rows = S // GRID_W
    wh = min(NA_WIN_H, rows)
    ww = NA_WIN_W
    n_win = wh * ww
    col = jnp.arange(GRID_W)
    cs = jnp.clip(col - ww // 2, 0, GRID_W - ww)
    col_idx = cs[:, None] + jnp.arange(ww)[None, :]
    dc = col_idx - col[:, None]

    def row_block(r):
        rs = jnp.clip(r - wh // 2, 0, rows - wh)
        row_idx = rs + jnp.arange(wh)
        dr = row_idx - r
        tok = (row_idx[None, :, None] * GRID_W + col_idx[:, None, :]).reshape(GRID_W, n_win)
        kw = jnp.take(k, tok, axis=1)
        vw = jnp.take(v, tok, axis=1)
        qr = lax.dynamic_slice_in_dim(q, r * GRID_W, GRID_W, axis=1)
        bias = rel_bias[:, dr[None, :, None] + NA_WIN_H - 1, dc[:, None, :] + NA_WIN_W - 1]
        bias = bias.reshape(H, GRID_W, n_win).astype(jnp.float32)
        s_win = jnp.einsum('bqhd,bqnhd->bhqn', qr, kw).astype(jnp.float32) * ATTN_SCALE + bias[None]
        s_ctx = jnp.einsum('bqhd,bmhd->bhqm', qr, kc).astype(jnp.float32) * ATTN_SCALE
        p = jax.nn.softmax(jnp.concatenate([s_win, s_ctx], axis=-1), axis=-1).astype(v.dtype)
        return (jnp.einsum('bhqn,bqnhd->bqhd', p[..., :n_win], vw)
                + jnp.einsum('bhqm,bmhd->bqhd', p[..., n_win:], vc))

    out = lax.map(row_block, jnp.arange(rows))
    return out.transpose(1, 0, 2, 3, 4).reshape(B, S, H * d)


def sliding_window_attention(q, k, v, kc, vc, sink):
    B, S, Hq, d = q.shape
    Hk = k.shape[2]
    G = Hq // Hk
    L = kc.shape[1]
    nb = S // BLOCK
    pad = ((0, 0), (BLOCK, BLOCK), (0, 0), (0, 0))

    def bands(t):
        tp = jnp.pad(t, pad).reshape(B, nb + 2, BLOCK, Hk, d)
        return jnp.concatenate([tp[:, :-2], tp[:, 1:-1], tp[:, 2:]], axis=2)

    kb = bands(k)
    vb = bands(v)
    qb = q.reshape(B, nb, BLOCK, Hk, G, d)
    s_win = jnp.einsum('bnikgd,bnjkd->bnkgij', qb, kb).astype(jnp.float32) * ATTN_SCALE
    i = jnp.arange(BLOCK)[:, None]
    j = jnp.arange(3 * BLOCK)[None, :]
    rel = j - BLOCK - i
    kpos = jnp.arange(nb)[:, None] * BLOCK - BLOCK + jnp.arange(3 * BLOCK)[None, :]
    valid = (jnp.abs(rel) <= SW_RADIUS)[None] & ((kpos >= 0) & (kpos < S))[:, None, :]
    s_win = jnp.where(valid[None, :, None, None], s_win, NEG_INF)
    s_ctx = jnp.einsum('bnikgd,bmkd->bnkgim', qb, kc).astype(jnp.float32) * ATTN_SCALE
    s_sink = jnp.broadcast_to(sink.reshape(Hk, G)[None, None, :, :, None, None].astype(jnp.float32),
                              s_win.shape[:-1] + (1,))
    p = jax.nn.softmax(jnp.concatenate([s_win, s_ctx, s_sink], axis=-1), axis=-1).astype(v.dtype)
    nw = 3 * BLOCK
    o = (jnp.einsum('bnkgij,bnjkd->bnikgd', p[..., :nw], vb)
         + jnp.einsum('bnkgim,bmkd->bnikgd', p[..., nw:nw + L], vc))
    return o.reshape(B, S, Hq * d)


def dense_block_attention(q, k, v, kc, vc):
    B, S, Hq, d = q.shape
    Hk = k.shape[2]
    G = Hq // Hk
    nb = S // BLOCK
    kk = jnp.concatenate([k, kc], axis=1)
    vv = jnp.concatenate([v, vc], axis=1)
    qb = q.reshape(B, nb, BLOCK, Hk, G, d).transpose(1, 0, 2, 3, 4, 5)

    def blk(qi):
        s = jnp.einsum('bikgd,bjkd->bkgij', qi, kk).astype(jnp.float32) * ATTN_SCALE
        p = jax.nn.softmax(s, axis=-1).astype(vv.dtype)
        return jnp.einsum('bkgij,bjkd->bikgd', p, vv)

    o = lax.map(blk, qb)
    return o.transpose(1, 0, 2, 3, 4, 5).reshape(B, S, Hq * d)


def mixer_na_sw(h, hc, w_in, w_out, na_qg, na_kg, rel_bias, sw_qg, sw_kg, sink, cos, sin, with_ctx):
    qa_d = NA_HEADS * HEAD_DIM
    q_d = qa_d + SW_HEADS * HEAD_DIM
    kva = NA_HEADS * HEAD_DIM
    kvb = SW_KV_HEADS * HEAD_DIM

    def q_split(p):
        qa = rms_norm(heads(p[..., :qa_d], NA_HEADS), na_qg)
        qb = rms_norm(heads(p[..., qa_d:], SW_HEADS), sw_qg)
        return qa, qb

    def kv_split(p):
        ka = rms_norm(heads(p[..., :kva], NA_HEADS), na_kg)
        va = heads(p[..., kva:2 * kva], NA_HEADS)
        kb = rms_norm(heads(p[..., 2 * kva:2 * kva + kvb], SW_KV_HEADS), sw_kg)
        vb = heads(p[..., 2 * kva + kvb:], SW_KV_HEADS)
        return ka, va, kb, vb

    p = h @ w_in
    qa, qb = q_split(p[..., :q_d])
    ka, va, kb, vb = kv_split(p[..., q_d:])
    qb = apply_rope(qb, cos, sin)
    kb = apply_rope(kb, cos, sin)
    ka_c, va_c, kb_c, vb_c = kv_split(hc @ w_in[:, q_d:])
    o_a = neighbourhood_attention(qa, ka, va, ka_c, va_c, rel_bias)
    o_b = sliding_window_attention(qb, kb, vb, kb_c, vb_c, sink)
    out = jnp.concatenate([o_a, o_b], axis=-1) @ w_out
    out_c = None
    if with_ctx:
        qa_c, qb_c = q_split(hc @ w_in[:, :q_d])
        out_c = jnp.concatenate([ctx_self_attention(qa_c, ka_c, va_c),
                                 ctx_self_attention(qb_c, kb_c, vb_c, sink)], axis=-1) @ w_out
    return out, out_c


def mixer_gqa(h, hc, w_in, w_out, q_gain, k_gain, cos, sin, with_ctx):
    qd = GQA_HEADS * HEAD_DIM
    kd = GQA_KV_HEADS * HEAD_DIM
    p = h @ w_in
    q = apply_rope(rms_norm(heads(p[..., :qd], GQA_HEADS), q_gain), cos, sin)
    k = apply_rope(rms_norm(heads(p[..., qd:qd + kd], GQA_KV_HEADS), k_gain), cos, sin)
    v = heads(p[..., qd + kd:], GQA_KV_HEADS)
    pc = hc @ w_in[:, qd:]
    kc = rms_norm(heads(pc[..., :kd], GQA_KV_HEADS), k_gain)
    vc = heads(pc[..., kd:], GQA_KV_HEADS)
    out = dense_block_attention(q, k, v, kc, vc) @ w_out
    out_c = None
    if with_ctx:
        qc = rms_norm(heads(hc @ w_in[:, :qd], GQA_HEADS), q_gain)
        out_c = ctx_self_attention(qc, kc, vc) @ w_out
    return out, out_c


def setup_inputs(seed: int = 0) -> dict:
    key = jax.random.key(seed)
    ks = jax.random.split(key, 24)
    f32 = jnp.float32
    nrm = lambda k, shape, s: jax.random.normal(k, shape, f32) * s
    gain = lambda k, shape: 1.0 + 0.02 * jax.random.normal(k, shape, f32)
    return {
        'x': nrm(ks[0], (BATCH, SEQ, D_MODEL), 1.0),
        'c': nrm(ks[1], (BATCH, D_MODEL), 1.0),
        'ctx': nrm(ks[2], (BATCH, CTX_LEN, D_MODEL), 1.0),
        'c_ctx': nrm(ks[3], (D_MODEL,), 1.0),
        'adaln_w': nrm(ks[4], (DEPTH, D_MODEL, N_MOD * D_MODEL), 0.5 * D_MODEL ** -0.5),
        'adaln_b': nrm(ks[5], (DEPTH, N_MOD * D_MODEL), 0.02),
        'norm_g': gain(ks[6], (DEPTH, 3, D_MODEL)),
        'ffn_w_gate': nrm(ks[7], (DEPTH, 2, D_MODEL, D_FF), D_MODEL ** -0.5),
        'ffn_w_up': nrm(ks[8], (DEPTH, 2, D_MODEL, D_FF), D_MODEL ** -0.5),
        'ffn_w_down': nrm(ks[9], (DEPTH, 2, D_FF, D_MODEL), D_FF ** -0.5),
        'ab_w_in': nrm(ks[10], (N_EVEN, D_MODEL, AB_IN), D_MODEL ** -0.5),
        'ab_w_out': nrm(ks[11], (N_EVEN, N_HEADS * HEAD_DIM, D_MODEL), (N_HEADS * HEAD_DIM) ** -0.5),
        'na_q_gain': gain(ks[12], (N_EVEN, HEAD_DIM)),
        'na_k_gain': gain(ks[13], (N_EVEN, HEAD_DIM)),
        'na_rel_bias': nrm(ks[14], (N_EVEN, NA_HEADS, 2 * NA_WIN_H - 1, 2 * NA_WIN_W - 1), 0.1),
        'sw_q_gain': gain(ks[15], (N_EVEN, HEAD_DIM)),
        'sw_k_gain': gain(ks[16], (N_EVEN, HEAD_DIM)),
        'sw_sink': nrm(ks[17], (N_EVEN, SW_HEADS), 0.5),
        'gqa_w_in': nrm(ks[18], (N_ODD, D_MODEL, C_IN), D_MODEL ** -0.5),
        'gqa_w_out': nrm(ks[19], (N_ODD, GQA_HEADS * HEAD_DIM, D_MODEL), (GQA_HEADS * HEAD_DIM) ** -0.5),
        'gqa_q_gain': gain(ks[20], (N_ODD, HEAD_DIM)),
        'gqa_k_gain': gain(ks[21], (N_ODD, HEAD_DIM)),
    }


def reference(x, c, ctx, c_ctx, adaln_w, adaln_b, norm_g, ffn_w_gate, ffn_w_up, ffn_w_down,
              ab_w_in, ab_w_out, na_q_gain, na_k_gain, na_rel_bias, sw_q_gain, sw_k_gain, sw_sink,
              gqa_w_in, gqa_w_out, gqa_q_gain, gqa_k_gain):
    S = x.shape[1]
    cos, sin = axial_rope_tables(S)
    xc = ctx
    for i in range(DEPTH):
        with_ctx = i < DEPTH - 1
        m = [t[:, None, :] for t in jnp.split(jax.nn.silu(c) @ adaln_w[i] + adaln_b[i], N_MOD, axis=-1)]
        mc = jnp.split(jax.nn.silu(c_ctx) @ adaln_w[i] + adaln_b[i], N_MOD, axis=-1)
        wa = (ffn_w_gate[i, 0], ffn_w_up[i, 0], ffn_w_down[i, 0])
        x = x + MACARON_WEIGHT * m[2] * swiglu(modulate(x, norm_g[i, 0], m[0], m[1]), *wa)
        xc = xc + MACARON_WEIGHT * mc[2] * swiglu(modulate(xc, norm_g[i, 0], mc[0], mc[1]), *wa)
        h = modulate(x, norm_g[i, 1], m[3], m[4])
        hc = modulate(xc, norm_g[i, 1], mc[3], mc[4])
        if i % 2 == 0:
            e = i // 2
            out, out_c = mixer_na_sw(h, hc, ab_w_in[e], ab_w_out[e], na_q_gain[e], na_k_gain[e],
                                     na_rel_bias[e], sw_q_gain[e], sw_k_gain[e], sw_sink[e],
                                     cos, sin, with_ctx)
        else:
            o = i // 2
            out, out_c = mixer_gqa(h, hc, gqa_w_in[o], gqa_w_out[o], gqa_q_gain[o], gqa_k_gain[o],
                                   cos, sin, with_ctx)
        x = x + m[5] * out
        wb = (ffn_w_gate[i, 1], ffn_w_up[i, 1], ffn_w_down[i, 1])
        x = x + MACARON_WEIGHT * m[8] * swiglu(modulate(x, norm_g[i, 2], m[6], m[7]), *wb)
        if with_ctx:
            xc = xc + mc[5] * out_c
            xc = xc + MACARON_WEIGHT * mc[8] * swiglu(modulate(xc, norm_g[i, 2], mc[6], mc[7]), *wb)
    return x
```

```cpp
#include <hip/hip_runtime.h>
#include <hip/hip_cooperative_groups.h>
#include <cstdio>
#include <cstdint>
namespace cg = cooperative_groups;

#ifndef MK_MULTI
#define MK_MULTI 0
#endif

constexpr int SEQ = 8192, CTXL = 256, MT = SEQ + CTXL, DM = 2048, FF = 5632, NMODV = 9 * DM;
constexpr int AB_IN = 4608, C_IN = 3072, GRIDW = 64;
constexpr float EPS = 1e-6f;
constexpr int NPHASE = 23;
constexpr int NSPLIT_DOWN = 22, NT_SPLIT_DOWN = 4;
constexpr int NSPLIT_OUT = 16, NT_SPLIT_OUT = 2;

constexpr size_t MiB = 1u << 20;
constexpr size_t WS_MOD = 0;
constexpr size_t WS_XC = 1 * MiB;
constexpr size_t WS_PART = 4 * MiB;
constexpr size_t WS_H = 52 * MiB;
constexpr size_t WS_O = 88 * MiB;
constexpr size_t WS_P = 124 * MiB;
constexpr size_t WS_A = 200 * MiB;
constexpr size_t WS_WGU = 292 * MiB;
constexpr size_t WS_WD = 468 * MiB;
constexpr size_t WS_WABIN = 556 * MiB;
constexpr size_t WS_WABOUT = 574 * MiB;
constexpr size_t WS_WGIN = 582 * MiB;
constexpr size_t WS_WGOUT = 594 * MiB;
constexpr size_t WS_END = 602 * MiB;
constexpr size_t WGU_ELEMS = (size_t)2 * FF * DM, WD_ELEMS = (size_t)DM * FF;

constexpr int LDS_BYTES = 143360;

typedef unsigned short bf16_t;
typedef short bf16x8 __attribute__((ext_vector_type(8)));
typedef short s16x4 __attribute__((ext_vector_type(4)));
typedef float f32x4 __attribute__((ext_vector_type(4)));
typedef float f32x2 __attribute__((ext_vector_type(2)));
typedef float f32x16 __attribute__((ext_vector_type(16)));
typedef unsigned u32x4 __attribute__((ext_vector_type(4)));
typedef unsigned u32x2 __attribute__((ext_vector_type(2)));
#define LAS __attribute__((address_space(3)))

__device__ __forceinline__ unsigned cvt_pk_bf16(float lo, float hi) { unsigned r; asm volatile("v_cvt_pk_bf16_f32 %0, %1, %2" : "=v"(r) : "v"(lo), "v"(hi)); return r; }
__device__ __forceinline__ int TID() { int t = threadIdx.x; asm volatile("" : "+v"(t)); return t; }
__device__ __forceinline__ int BID() { int b = blockIdx.x; asm volatile("" : "+s"(b)); return b; }
__device__ __forceinline__ float bf2f(unsigned short b) { return __uint_as_float(((unsigned)b) << 16); }
__device__ __forceinline__ float wave_sum(float v) {
#pragma unroll
    for (int o = 1; o < 64; o <<= 1) v += __shfl_xor(v, o);
    return v;
}

namespace pg8 {
constexpr int BM = 256, BK = 64, HALF = 128, HTB = HALF * BK * 2, STAGE_BYTES = 8 * HTB, NXCD = 8, WGM = 8;
__host__ __device__ __forceinline__ int lds_byte(int r, int c) { const int st = (r >> 4) * 2 + (c >> 5), rr = r & 15, cc = c & 31, ob = rr * 64 + cc * 2; return st * 1024 + (ob ^ (((ob >> 9) & 1) << 5)); }
__host__ __device__ __forceinline__ void stage_rc(int b, int& R, int& C) { const int st = b / 1024, sb = b % 1024, swz = sb ^ (((sb >> 9) & 1) << 5); R = (st >> 1) * 16 + swz / 64; C = (st & 1) * 32 + (swz % 64) / 2; }
__host__ __device__ __forceinline__ int perm32(int rho) { const int n = rho >> 4, i = rho & 15; return 8 * (i >> 2) + 4 * n + (i & 3); }

struct Unit { int pm, pn, k0, nt, split; };
struct Gemm { const bf16_t* A; const bf16_t* Bt; int K; };

struct Sched {
    int nM, nN, nwg, G, c, nt_full, nsplit_units, split_nt, split_pm;
    __device__ __forceinline__ void init(int nM_, int nN_, int K, int G_, int c_, int nsplit, int snt, int spm) {
        nM = nM_; nN = nN_; nwg = nM * nN; G = G_; c = c_; nt_full = K / BK; nsplit_units = nsplit * nN_; split_nt = snt; split_pm = spm; }
    __device__ __forceinline__ bool next(int i, Unit& u) const {
        const long L = (long)i * G + c;
        const bool reg = L < nwg; const int s = reg ? 0 : (int)(L - nwg);
        if (!reg && s >= nsplit_units) return false;
        int wgid = reg ? (int)L : 0; { const int q = nwg / NXCD, r = nwg % NXCD, xcd = wgid % NXCD, off = wgid / NXCD; wgid = (xcd < r ? xcd * (q + 1) : r * (q + 1) + (xcd - r) * q) + off; }
        const int nig = WGM * nN, gid = wgid / nig, fm = gid * WGM, gsz = (nM - fm) < WGM ? (nM - fm) : WGM;
        const int pm_r = fm + ((wgid % nig) % gsz), pn_r = (wgid % nig) / gsz;
        const int pn_s = s % nN, sp_s = s / nN;
        u.pm = __builtin_amdgcn_readfirstlane(reg ? pm_r : split_pm); u.pn = __builtin_amdgcn_readfirstlane(reg ? pn_r : pn_s);
        u.split = __builtin_amdgcn_readfirstlane(reg ? -1 : sp_s); u.k0 = __builtin_amdgcn_readfirstlane(reg ? 0 : sp_s * split_nt); u.nt = __builtin_amdgcn_readfirstlane(reg ? nt_full : split_nt);
        return true;
    }
};

struct EpiBf16 {
    static constexpr bool PERM = true;
    bf16_t* O; int ldc;
    __device__ __forceinline__ void operator()(const f32x4 (&acc)[2][2][4][2], const Unit& u, int wr, int wc, int fr, int fq) const {
        asm volatile("" : "+v"(fr), "+v"(fq));
        const int row0 = u.pm * BM + wr * 64 + fr; const int col0 = u.pn * BM + wc * 32 + 8 * fq;
#pragma unroll
        for (int ai = 0; ai < 2; ++ai)
#pragma unroll
            for (int m = 0; m < 4; ++m) { bf16_t* rowp = O + (size_t)(row0 + ai * HALF + m * 16) * ldc + col0;
#pragma unroll
                for (int bj = 0; bj < 2; ++bj) { const f32x4 v0 = acc[ai][bj][m][0], v1 = acc[ai][bj][m][1];
                    u32x4 w; w.x = cvt_pk_bf16(v0[0], v0[1]); w.y = cvt_pk_bf16(v0[2], v0[3]); w.z = cvt_pk_bf16(v1[0], v1[1]); w.w = cvt_pk_bf16(v1[2], v1[3]);
                    *(u32x4*)(rowp + bj * HALF) = w; } }
    }
};
__device__ __forceinline__ float silu_mul(float g, float u) { const float e = __builtin_amdgcn_exp2f(-g * 1.4426950408889634f); return g * __builtin_amdgcn_rcpf(1.0f + e) * u; }
struct EpiSwiGLU {
    static constexpr bool PERM = true;
    bf16_t* O; int ldc;
    __device__ __forceinline__ void operator()(const f32x4 (&acc)[2][2][4][2], const Unit& u, int wr, int wc, int fr, int fq) const {
        asm volatile("" : "+v"(fr), "+v"(fq));
        const int row0 = u.pm * BM + wr * 64 + fr; const int col0 = u.pn * HALF + wc * 32 + 8 * fq;
#pragma unroll
        for (int ai = 0; ai < 2; ++ai)
#pragma unroll
            for (int m = 0; m < 4; ++m) { bf16_t* rowp = O + (size_t)(row0 + ai * HALF + m * 16) * ldc + col0;
                const f32x4 g0 = acc[ai][0][m][0], g1 = acc[ai][0][m][1], u0 = acc[ai][1][m][0], u1 = acc[ai][1][m][1];
                u32x4 w; w.x = cvt_pk_bf16(silu_mul(g0[0], u0[0]), silu_mul(g0[1], u0[1])); w.y = cvt_pk_bf16(silu_mul(g0[2], u0[2]), silu_mul(g0[3], u0[3]));
                w.z = cvt_pk_bf16(silu_mul(g1[0], u1[0]), silu_mul(g1[1], u1[1])); w.w = cvt_pk_bf16(silu_mul(g1[2], u1[2]), silu_mul(g1[3], u1[3]));
                *(u32x4*)rowp = w; }
    }
};
struct EpiResid {
    static constexpr bool PERM = false;
    float* X; const float* gate; float coef; float* part;
    __device__ __forceinline__ void operator()(const f32x4 (&acc)[2][2][4][2], const Unit& u, int wr, int wc, int fr, int fq) const {
        asm volatile("" : "+v"(fr), "+v"(fq));
        const int col0 = u.pn * BM + wc * 32 + 4 * fq;
        if (u.split < 0) {
            f32x4 gv[2][2];
#pragma unroll
            for (int bj = 0; bj < 2; ++bj)
#pragma unroll
                for (int n = 0; n < 2; ++n) gv[bj][n] = *(const f32x4*)(gate + col0 + bj * HALF + n * 16) * coef;
#pragma unroll
            for (int ai = 0; ai < 2; ++ai)
#pragma unroll
                for (int m = 0; m < 4; ++m) { float* rowp = X + (size_t)(u.pm * BM + ai * HALF + wr * 64 + m * 16 + fr) * DM + col0;
#pragma unroll
                    for (int bj = 0; bj < 2; ++bj)
#pragma unroll
                        for (int n = 0; n < 2; ++n) { f32x4* p = (f32x4*)(rowp + bj * HALF + n * 16); *p = *p + gv[bj][n] * acc[ai][bj][m][n]; }
                    asm volatile("" ::: "memory"); }
        } else {
            float* base = part + (size_t)u.split * 256 * DM;
#pragma unroll
            for (int ai = 0; ai < 2; ++ai)
#pragma unroll
                for (int m = 0; m < 4; ++m) { float* rowp = base + (size_t)(ai * HALF + wr * 64 + m * 16 + fr) * DM + col0;
#pragma unroll
                    for (int bj = 0; bj < 2; ++bj)
#pragma unroll
                        for (int n = 0; n < 2; ++n) *(f32x4*)(rowp + bj * HALF + n * 16) = acc[ai][bj][m][n]; }
        }
    }
};

template <class Epi, bool ALIGN_EPI, bool SP2>
__device__ __forceinline__ void gemm_phase(LAS unsigned char* lds, const Gemm g, const Sched& S, const Epi& E) {
    const int tid = TID(), wid = __builtin_amdgcn_readfirstlane(tid >> 6), lane = tid & 63, wr = wid >> 2, wc = wid & 3, fr = lane & 15, fq = lane >> 4;
    const int K = g.K;
    unsigned voffA[2], voffB[2];
#pragma unroll
    for (int i = 0; i < 2; ++i) { int R, C; stage_rc(tid * 16 + i * 8192, R, C); const int Rb = Epi::PERM ? ((R & ~31) + perm32(R & 31)) : R;
        voffA[i] = (unsigned)(R * K + C) * 2u; voffB[i] = (unsigned)(Rb * K + C) * 2u; }
    const size_t kstep = (size_t)(BK * 2);
    const size_t hstep = (size_t)HALF * K * 2;
    const size_t tstep = 2 * hstep;
    const unsigned ldsw = (unsigned)wid * 1024u;
    const int aoff = lds_byte(wr * 64 + fr, fq * 8), boff = lds_byte(wc * 32 + fr, fq * 8);
#define PG8_SA(b, h) (((b) * 2 + (h)) * HTB)
#define PG8_SB(b, h) ((4 + (b) * 2 + (h)) * HTB)
#define PG8_STAGE(bufoff, gbase, voff) do { _Pragma("unroll") for (int _i = 0; _i < 2; ++_i) \
        __builtin_amdgcn_global_load_lds((const unsigned*)((const char*)(gbase) + (voff)[_i]), (LAS unsigned*)(lds + (bufoff) + ldsw + _i * 8192), 16, 0, 0); } while (0)
#define PG8_LDA(dst, b, h) do { _Pragma("unroll") for (int m = 0; m < 4; ++m) _Pragma("unroll") for (int k = 0; k < 2; ++k) dst[m][k] = *(const LAS bf16x8*)(lds + PG8_SA(b, h) + aoff + m * 2048 + k * 1024); } while (0)
#define PG8_LDB(dst, b, h) do { _Pragma("unroll") for (int n = 0; n < 2; ++n) _Pragma("unroll") for (int k = 0; k < 2; ++k) dst[n][k] = *(const LAS bf16x8*)(lds + PG8_SB(b, h) + boff + n * 2048 + k * 1024); } while (0)
#define PG8_MMA(ai, bj, At, Bt) do { __builtin_amdgcn_s_setprio(1); _Pragma("unroll") for (int m = 0; m < 4; ++m) _Pragma("unroll") for (int n = 0; n < 2; ++n) _Pragma("unroll") for (int k = 0; k < 2; ++k) \
        acc[ai][bj][m][n] = __builtin_amdgcn_mfma_f32_16x16x32_bf16(Bt[n][k], At[m][k], acc[ai][bj][m][n], 0, 0, 0); __builtin_amdgcn_s_setprio(0); } while (0)
#define PG8_WAIT_V(n) asm volatile("s_waitcnt vmcnt(" #n ")" ::: "memory")
#define PG8_WAIT_L(n) asm volatile("s_waitcnt lgkmcnt(" #n ")" ::: "memory")
#define PG8_BAR __builtin_amdgcn_s_barrier()
#define PG8_SCHED __builtin_amdgcn_sched_barrier(0)
    Unit cur, nxt; int ui = 0;
    if (!S.next(0, cur)) return;
    f32x4 acc[2][2][4][2];
#pragma unroll
    for (int a = 0; a < 2; ++a)
#pragma unroll
        for (int b = 0; b < 2; ++b)
#pragma unroll
            for (int m = 0; m < 4; ++m)
#pragma unroll
                for (int n = 0; n < 2; ++n) acc[a][b][m][n] = (f32x4){0.f, 0.f, 0.f, 0.f};
    bf16x8 At[4][2], B0[2][2], B1[2][2];
    const char* cA = (const char*)g.A + (size_t)cur.pm * tstep + (size_t)cur.k0 * kstep; const char* cB = (const char*)g.Bt + (size_t)cur.pn * tstep + (size_t)cur.k0 * kstep;
    if constexpr (SP2) {
        PG8_STAGE(PG8_SB(0, 0), cB, voffB); PG8_STAGE(PG8_SB(0, 1), cB + hstep, voffB); PG8_STAGE(PG8_SA(0, 0), cA, voffA); PG8_STAGE(PG8_SA(0, 1), cA + hstep, voffA);
        if (wr == 1) PG8_BAR;
        PG8_WAIT_V(2); PG8_BAR;
        PG8_STAGE(PG8_SB(1, 0), cB + kstep, voffB); PG8_STAGE(PG8_SA(1, 0), cA + kstep, voffA); PG8_STAGE(PG8_SB(1, 1), cB + hstep + kstep, voffB);
        PG8_WAIT_V(6); PG8_BAR;
    } else {
        PG8_STAGE(PG8_SB(0, 0), cB, voffB); PG8_STAGE(PG8_SA(0, 0), cA, voffA); PG8_STAGE(PG8_SB(0, 1), cB + hstep, voffB); PG8_STAGE(PG8_SA(0, 1), cA + hstep, voffA);
        if (wr == 1) PG8_BAR;
        PG8_WAIT_V(4); PG8_BAR;
        PG8_STAGE(PG8_SB(1, 0), cB + kstep, voffB); PG8_STAGE(PG8_SA(1, 0), cA + kstep, voffA); PG8_STAGE(PG8_SB(1, 1), cB + hstep + kstep, voffB);
        PG8_WAIT_V(6); PG8_BAR;
    }
    for (;;) {
        const bool has_next = S.next(ui + 1, nxt);
        const int nt = cur.nt;
        const char* nA = has_next ? (const char*)g.A + (size_t)nxt.pm * tstep + (size_t)nxt.k0 * kstep : cA; const char* nB = has_next ? (const char*)g.Bt + (size_t)nxt.pn * tstep + (size_t)nxt.k0 * kstep : cB;
        for (int t = 0; t < nt; t += 2) {
            const bool last = (t == nt - 2);
            const char* a1 = cA + (size_t)(t + 1) * kstep;
            const char* a2 = last ? nA : cA + (size_t)(t + 2) * kstep; const char* b2 = last ? nB : cB + (size_t)(t + 2) * kstep;
            const char* a3 = a2 + kstep; const char* b3 = b2 + kstep;
            if constexpr (SP2) {
            PG8_LDB(B0, 0, 0); PG8_LDB(B1, 0, 1); PG8_SCHED; PG8_LDA(At, 0, 0); PG8_STAGE(PG8_SA(1, 1), a1 + hstep, voffA);
            PG8_WAIT_V(8); PG8_WAIT_L(0); PG8_BAR; PG8_MMA(0, 0, At, B0); PG8_MMA(0, 1, At, B1); PG8_BAR; PG8_SCHED;
            PG8_LDA(At, 0, 1); PG8_STAGE(PG8_SB(0, 0), b2, voffB); PG8_STAGE(PG8_SB(0, 1), b2 + hstep, voffB); PG8_STAGE(PG8_SA(0, 0), a2, voffA);
            PG8_WAIT_V(8); PG8_WAIT_L(0); PG8_BAR; PG8_MMA(1, 0, At, B0); PG8_MMA(1, 1, At, B1); PG8_BAR; PG8_SCHED;
            PG8_LDB(B0, 1, 0); PG8_LDB(B1, 1, 1); PG8_SCHED; PG8_LDA(At, 1, 0); PG8_STAGE(PG8_SA(0, 1), a2 + hstep, voffA);
            PG8_WAIT_V(8); PG8_WAIT_L(0); PG8_BAR; PG8_MMA(0, 0, At, B0); PG8_MMA(0, 1, At, B1); PG8_BAR; PG8_SCHED;
            PG8_LDA(At, 1, 1); PG8_STAGE(PG8_SB(1, 0), b3, voffB); PG8_STAGE(PG8_SB(1, 1), b3 + hstep, voffB); PG8_STAGE(PG8_SA(1, 0), a3, voffA);
            PG8_WAIT_V(8); PG8_WAIT_L(0); PG8_BAR; PG8_MMA(1, 0, At, B0); PG8_MMA(1, 1, At, B1); PG8_BAR; PG8_SCHED;
            } else {
            PG8_LDB(B0, 0, 0); PG8_SCHED; PG8_LDA(At, 0, 0); PG8_STAGE(PG8_SA(1, 1), a1 + hstep, voffA);
            PG8_WAIT_L(8); PG8_BAR; PG8_WAIT_L(0); PG8_MMA(0, 0, At, B0); PG8_BAR; PG8_SCHED;
            PG8_LDB(B1, 0, 1); PG8_STAGE(PG8_SB(0, 0), b2, voffB);
            PG8_BAR; PG8_WAIT_L(0); PG8_MMA(0, 1, At, B1); PG8_BAR;
            PG8_LDA(At, 0, 1); PG8_STAGE(PG8_SA(0, 0), a2, voffA);
            PG8_BAR; PG8_WAIT_L(0); PG8_MMA(1, 0, At, B0); PG8_BAR; PG8_SCHED;
            PG8_STAGE(PG8_SB(0, 1), b2 + hstep, voffB);
            PG8_WAIT_V(6); PG8_BAR; PG8_MMA(1, 1, At, B1); PG8_BAR;
            PG8_LDB(B0, 1, 0); PG8_SCHED; PG8_LDA(At, 1, 0); PG8_STAGE(PG8_SA(0, 1), a2 + hstep, voffA);
            PG8_WAIT_L(8); PG8_BAR; PG8_WAIT_L(0); PG8_MMA(0, 0, At, B0); PG8_BAR; PG8_SCHED;
            PG8_LDB(B1, 1, 1); PG8_STAGE(PG8_SB(1, 0), b3, voffB);
            PG8_BAR; PG8_WAIT_L(0); PG8_MMA(0, 1, At, B1); PG8_BAR;
            PG8_LDA(At, 1, 1); PG8_STAGE(PG8_SA(1, 0), a3, voffA);
            PG8_BAR; PG8_WAIT_L(0); PG8_MMA(1, 0, At, B0); PG8_BAR; PG8_SCHED;
            PG8_STAGE(PG8_SB(1, 1), b3 + hstep, voffB);
            PG8_WAIT_V(6); PG8_BAR; PG8_MMA(1, 1, At, B1); PG8_BAR;
            }
        }
        if constexpr (ALIGN_EPI) { if (wr == 0) PG8_BAR; }
        E(acc, cur, wr, wc, fr, fq);
        if (!has_next) break;
#pragma unroll
        for (int a = 0; a < 2; ++a)
#pragma unroll
            for (int b = 0; b < 2; ++b)
#pragma unroll
                for (int m = 0; m < 4; ++m)
#pragma unroll
                    for (int n = 0; n < 2; ++n) acc[a][b][m][n] = (f32x4){0.f, 0.f, 0.f, 0.f};
        cur = nxt; cA = nA; cB = nB; ++ui;
        if constexpr (ALIGN_EPI) { if (wr == 1) PG8_BAR; }
    }
    PG8_WAIT_V(0);
    if constexpr (!ALIGN_EPI) { if (wr == 0) PG8_BAR; }
    PG8_BAR;
#undef PG8_SA
#undef PG8_SB
#undef PG8_STAGE
#undef PG8_LDA
#undef PG8_LDB
#undef PG8_MMA
#undef PG8_WAIT_V
#undef PG8_WAIT_L
#undef PG8_BAR
#undef PG8_SCHED
}
}

namespace att {
constexpr int D = 128, NW = 8, QBLK = 32, KVBLK = 64;
constexpr float SCALE = 0.088388347648318440f;
constexpr float INV_SCALE = 11.313708498984761f;
constexpr float THR = 8.f;
constexpr float NEG = -1e30f;
constexpr size_t SHM_V = KVBLK * D * 2, SHM_K = KVBLK * D * 2, SHM_ATTN = 2 * SHM_V + 2 * SHM_K + NW * 64 * 4;
constexpr int BIAS_OFF = (int)SHM_ATTN;
enum { DENSE = 0, NA = 1, SW = 2 };
#define KSWZ(row, colB) ((row) * 256 + ((colB) ^ (((row) & 7) << 4)))
#define SBAR() __builtin_amdgcn_sched_barrier(0)
__device__ __forceinline__ int crow(int r, int hi) { return (r & 3) + 8 * (r >> 2) + 4 * hi; }

__device__ __forceinline__ void partialSM(f32x16& p0, f32x16& p1, float& m_reg, float& mn, float& alpha) {
  constexpr float C = SCALE * 1.4426950408889634f;
  float pmax = p0[0];
#pragma unroll
  for (int r = 1; r < 16; ++r) pmax = fmaxf(pmax, p0[r]);
#pragma unroll
  for (int r = 0; r < 16; ++r) pmax = fmaxf(pmax, p1[r]);
  { auto rr = __builtin_amdgcn_permlane32_swap(__float_as_uint(pmax), __float_as_uint(pmax), false, false);
    pmax = fmaxf(__uint_as_float(rr[0]), __uint_as_float(rr[1])); }
  if (__builtin_expect(__all(pmax - m_reg <= THR / SCALE), 1)) { mn = m_reg; alpha = 1.f; }
  else { mn = fmaxf(m_reg, pmax); alpha = __builtin_amdgcn_exp2f((m_reg - mn) * C); m_reg = mn; }
  float mnC = -mn * C;
#pragma unroll
  for (int r = 0; r < 16; ++r) p0[r] = fmaf(p0[r], C, mnC);
#pragma unroll
  for (int r = 0; r < 16; ++r) p1[r] = fmaf(p1[r], C, mnC);
#pragma unroll
  for (int r = 0; r < 16; ++r) p0[r] = __builtin_amdgcn_exp2f(p0[r]);
}
__device__ __forceinline__ void finishSM(f32x16& p0, f32x16& p1, float alpha, float& l_reg, bf16x8& pa0, bf16x8& pa1, bf16x8& pa2, bf16x8& pa3) {
#pragma unroll
  for (int r = 0; r < 16; ++r) p1[r] = __builtin_amdgcn_exp2f(p1[r]);
  float ps = 0;
#pragma unroll
  for (int r = 0; r < 16; ++r) ps += p0[r];
#pragma unroll
  for (int r = 0; r < 16; ++r) ps += p1[r];
  { auto rr = __builtin_amdgcn_permlane32_swap(__float_as_uint(ps), __float_as_uint(ps), false, false);
    ps = __uint_as_float(rr[0]) + __uint_as_float(rr[1]); }
  l_reg = l_reg * alpha + ps;
#define PK4(P, BASE, OUT) do { unsigned a0 = cvt_pk_bf16(P[BASE + 0], P[BASE + 1]), a1 = cvt_pk_bf16(P[BASE + 2], P[BASE + 3]);   \
    unsigned b0 = cvt_pk_bf16(P[BASE + 4], P[BASE + 5]), b1 = cvt_pk_bf16(P[BASE + 6], P[BASE + 7]);                              \
    auto r0 = __builtin_amdgcn_permlane32_swap(a0, b0, false, false); auto r1 = __builtin_amdgcn_permlane32_swap(a1, b1, false, false); \
    u32x4 w = {r0[0], r1[0], r0[1], r1[1]}; OUT = *reinterpret_cast<bf16x8*>(&w); } while (0)
  PK4(p0, 0, pa0); PK4(p0, 8, pa1); PK4(p1, 0, pa2); PK4(p1, 8, pa3);
#undef PK4
}
__device__ __forceinline__ void qkt(f32x16& p0, f32x16& p1, const bf16_t* Ks, const bf16x8* qr, int r32, int hi) {
  p0 = f32x16{}; p1 = f32x16{};
#pragma unroll
  for (int d0 = 0; d0 < 8; ++d0) { int cb = (d0 * 16 + hi * 8) * 2;
    bf16x8 b0 = *reinterpret_cast<const bf16x8*>((const char*)Ks + KSWZ(r32, cb));
    bf16x8 b1 = *reinterpret_cast<const bf16x8*>((const char*)Ks + KSWZ(32 + r32, cb));
    p0 = __builtin_amdgcn_mfma_f32_32x32x16_bf16(b0, qr[d0], p0, 0, 0, 0);
    p1 = __builtin_amdgcn_mfma_f32_32x32x16_bf16(b1, qr[d0], p1, 0, 0, 0); }
}
__device__ __forceinline__ int v_st(int k, int c) { const int kk = (k & ~0xC) | ((k & 4) << 1) | ((k & 8) >> 1); return ((kk >> 3) * 4 + (c >> 5)) * 512 + ((kk & 7) * 32 + (c & 31)) * 2; }
__device__ __forceinline__ int v_rd_base(int lane) { return ((lane & 3) << 3) | (((lane >> 2) & 3) << 6) | (((lane >> 4) & 1) << 5) | (((lane >> 5) & 1) << 8); }
constexpr int v_rd_off(int d0, int ks, int half) { return d0 * 512 + ks * 4096 + half * 2048; }
template <int OFF> __device__ __forceinline__ s16x4 tr_read(int vb) {
  s16x4 r; asm volatile("ds_read_b64_tr_b16 %0, %1 offset:%2" : "=&v"(r) : "v"(vb), "i"(OFF) : "memory"); return r;
}
template <int D0> __device__ __forceinline__ void pv_one(f32x16& od, int vb, bf16x8 pa0, bf16x8 pa1, bf16x8 pa2, bf16x8 pa3) {
  const s16x4 l0 = tr_read<v_rd_off(D0, 0, 0)>(vb), h0 = tr_read<v_rd_off(D0, 0, 1)>(vb), l1 = tr_read<v_rd_off(D0, 1, 0)>(vb), h1 = tr_read<v_rd_off(D0, 1, 1)>(vb);
  const s16x4 l2 = tr_read<v_rd_off(D0, 2, 0)>(vb), h2 = tr_read<v_rd_off(D0, 2, 1)>(vb), l3 = tr_read<v_rd_off(D0, 3, 0)>(vb), h3 = tr_read<v_rd_off(D0, 3, 1)>(vb);
  asm volatile("s_waitcnt lgkmcnt(0)" ::: "memory"); SBAR();
#define PK(L, H) (bf16x8){L[0], L[1], L[2], L[3], H[0], H[1], H[2], H[3]}
  od = __builtin_amdgcn_mfma_f32_32x32x16_bf16(pa0, PK(l0, h0), od, 0, 0, 0);
  od = __builtin_amdgcn_mfma_f32_32x32x16_bf16(pa1, PK(l1, h1), od, 0, 0, 0);
  od = __builtin_amdgcn_mfma_f32_32x32x16_bf16(pa2, PK(l2, h2), od, 0, 0, 0);
  od = __builtin_amdgcn_mfma_f32_32x32x16_bf16(pa3, PK(l3, h3), od, 0, 0, 0);
#undef PK
}
__device__ __forceinline__ void pv_d0(f32x16* o, int vb, bf16x8 pa0, bf16x8 pa1, bf16x8 pa2, bf16x8 pa3) {
  pv_one<0>(o[0], vb, pa0, pa1, pa2, pa3); pv_one<1>(o[1], vb, pa0, pa1, pa2, pa3); pv_one<2>(o[2], vb, pa0, pa1, pa2, pa3); pv_one<3>(o[3], vb, pa0, pa1, pa2, pa3);
}

struct UnitP { const bf16_t* Q; const bf16_t* K; const bf16_t* V; bf16_t* O; int ldq, ldk, ldo, NT, base_row, qb; float sink_l2e; };

template <int MODE> __device__ __forceinline__ int tile_row0(const UnitP& u, int t) {
  if (MODE == DENSE) return u.base_row + KVBLK * t;
  if (t < 4) return SEQ + KVBLK * t;
  if (MODE == NA) { int R0 = 4 * u.qb - 4; R0 = R0 < 0 ? 0 : (R0 > 120 ? 120 : R0); int kr = R0 + t - 4; kr = kr > 127 ? 127 : kr; return kr * 64; }
  int k0 = 256 * u.qb - 128 + 64 * (t - 4); k0 = k0 < 0 ? 0 : (k0 > SEQ - 64 ? SEQ - 64 : k0); return k0;
}
template <int MODE> __device__ __forceinline__ void mask_tile(f32x16& p0, f32x16& p1, const UnitP& u, int t, int wid, int r32, int hi, const float* biasL) {
  if (MODE == DENSE) return;
  if (t < 4) return;
  if (MODE == SW) {
    const int kpos0 = 256 * u.qb - 128 + 64 * (t - 4); int qpos = 256 * u.qb + wid * 32 + r32; int hi_ = hi;
    asm volatile("" : "+v"(qpos), "+v"(hi_));
#pragma unroll
    for (int r = 0; r < 16; ++r) { const int k0 = kpos0 + crow(r, hi_), k1 = k0 + 32; const int d0 = k0 - qpos, d1 = k1 - qpos;
      const bool v0 = (k0 >= 0) && (k0 < SEQ) && (d0 <= 128) && (d0 >= -128); const bool v1 = (k1 >= 0) && (k1 < SEQ) && (d1 <= 128) && (d1 >= -128);
      p0[r] = v0 ? p0[r] : NEG; p1[r] = v1 ? p1[r] : NEG; }
  } else {
    int R0 = 4 * u.qb - 4; R0 = R0 < 0 ? 0 : (R0 > 120 ? 120 : R0); const int kr = R0 + t - 4;
    const int rq = 4 * u.qb + (wid >> 1); int rs = rq - 4; rs = rs < 0 ? 0 : (rs > 120 ? 120 : rs);
    const bool rowvalid = (kr >= rs) && (kr < rs + 8);
    if (!rowvalid) {
#pragma unroll
      for (int r = 0; r < 16; ++r) { p0[r] = NEG; p1[r] = NEG; }
      return; }
    int cq = (wid & 1) * 32 + r32; int hi_ = hi;
    asm volatile("" : "+v"(cq), "+v"(hi_));
    int cs = cq - 8; cs = cs < 0 ? 0 : (cs > 48 ? 48 : cs);
    int brow = kr - rq + 7; brow = brow < 0 ? 0 : (brow > 14 ? 14 : brow);
    const float* bl = biasL + brow * 31 + 15 - cq;
#pragma unroll
    for (int r = 0; r < 16; ++r) { const int k0 = crow(r, hi_), k1 = k0 + 32;
      const bool v0 = rowvalid && (k0 >= cs) && (k0 < cs + 16); const bool v1 = rowvalid && (k1 >= cs) && (k1 < cs + 16);
      int i0 = k0 - cq; i0 = i0 < -15 ? -15 : (i0 > 15 ? 15 : i0); int i1 = k1 - cq; i1 = i1 < -15 ? -15 : (i1 > 15 ? 15 : i1);
      const float b0 = bl[cq + i0], b1 = bl[cq + i1];
      p0[r] = v0 ? p0[r] + b0 : NEG; p1[r] = v1 ? p1[r] + b1 : NEG;
      SBAR(); }
  }
}

template <int MODE, int SDEPTH>
__device__ __forceinline__ void attn_unit(const UnitP& u, char* lds) {
  const int tid = TID(), wid = tid >> 6, lane = tid & 63, r32 = lane & 31, hi = lane >> 5;
  bf16_t* V_lds = (bf16_t*)lds; bf16_t* K_lds = (bf16_t*)(lds + 2 * SHM_V);
  float* ws = (float*)(lds + 2 * SHM_V + 2 * SHM_K) + wid * 64; float* li_l = ws; float* al_l = ws + 32;
  const float* biasL = (const float*)(lds + BIAS_OFF);
  const bf16_t* __restrict__ Kh = u.K; const bf16_t* __restrict__ Vh = u.V; const int LDK = u.ldk;
  float m_reg = -1e30f, l_reg = 0; f32x16 o[4] = {}; bf16x8 qr[8];
  const bf16_t* Qw = u.Q + (long)(wid * QBLK + r32) * u.ldq + hi * 8;
#pragma unroll
  for (int d0 = 0; d0 < 8; ++d0) qr[d0] = *reinterpret_cast<const bf16x8*>(Qw + d0 * 16);
  const int vb0 = (int)(uintptr_t)V_lds + v_rd_base(lane);
  struct { bf16x8 vs0, vs1, ks0, ks1; } sr_[SDEPTH];
#define SLOAD(i, k0) do { int t_ = tid; if (MODE != DENSE) asm volatile("" : "+v"(t_)); const int sr = t_ >> 4, sc = (t_ & 15) * 8; \
    const long _r0 = (long)((k0) + sr) * LDK + sc, _r1 = (long)((k0) + 32 + sr) * LDK + sc; \
    sr_[i].vs0 = *reinterpret_cast<const bf16x8*>(&Vh[_r0]); sr_[i].vs1 = *reinterpret_cast<const bf16x8*>(&Vh[_r1]); \
    sr_[i].ks0 = *reinterpret_cast<const bf16x8*>(&Kh[_r0]); sr_[i].ks1 = *reinterpret_cast<const bf16x8*>(&Kh[_r1]); } while (0)
#define SWRITE(b, i) do { int t_ = tid; if (MODE != DENSE) asm volatile("" : "+v"(t_)); const int sr = t_ >> 4, sc = (t_ & 15) * 8, vst0 = v_st(sr, sc), vst1 = v_st(32 + sr, sc); \
    *(bf16x8*)((char*)V_lds + (b) * SHM_V + vst0) = sr_[i].vs0;          \
    *(bf16x8*)((char*)V_lds + (b) * SHM_V + vst1) = sr_[i].vs1; int kc = sc * 2;               \
    *(bf16x8*)((char*)K_lds + (b) * SHM_K + KSWZ(sr, kc)) = sr_[i].ks0;                       \
    *(bf16x8*)((char*)K_lds + (b) * SHM_K + KSWZ(32 + sr, kc)) = sr_[i].ks1; } while (0)
#define SWAIT() do { if constexpr (SDEPTH == 2) asm volatile("s_waitcnt vmcnt(4)" ::: "memory"); else asm volatile("s_waitcnt vmcnt(0)" ::: "memory"); } while (0)
#define RESC(a) do { if (__any((a) < 1.f)) { if (hi == 0) al_l[r32] = (a); asm volatile("s_waitcnt lgkmcnt(0)" ::: "memory"); \
    _Pragma("unroll") for (int d = 0; d < 4; ++d) _Pragma("unroll") for (int r = 0; r < 16; ++r) o[d][r] *= al_l[crow(r, hi)]; } } while (0)
#define ROW0(t) tile_row0<MODE>(u, (t))
  f32x16 pA0, pA1, pB0, pB1; float mnA, mnB, alA, alB; bf16x8 pa0, pa1, pa2, pa3; const int NT = u.NT;
  constexpr int SE = 0, SO = SDEPTH - 1;
  SLOAD(SE, ROW0(0)); asm volatile("s_waitcnt vmcnt(0)" ::: "memory"); SWRITE(0, SE); __syncthreads();
  qkt(pA0, pA1, K_lds, qr, r32, hi); mask_tile<MODE>(pA0, pA1, u, 0, wid, r32, hi, biasL); partialSM(pA0, pA1, m_reg, mnA, alA);
  SLOAD(SO, ROW0(1)); if constexpr (SDEPTH == 2) { if (2 < NT) SLOAD(SE, ROW0(2)); }
  SWAIT(); SWRITE(1, SO); __syncthreads();
  for (int j = 1; j + 1 < NT; j += 2) {
    SBAR(); qkt(pB0, pB1, (bf16_t*)((char*)K_lds + SHM_K), qr, r32, hi);
    finishSM(pA0, pA1, alA, l_reg, pa0, pa1, pa2, pa3); SBAR();
    SLOAD(SO, ROW0(j + SDEPTH)); SBAR();
    pv_d0(o, vb0, pa0, pa1, pa2, pa3); mask_tile<MODE>(pB0, pB1, u, j, wid, r32, hi, biasL); partialSM(pB0, pB1, m_reg, mnB, alB);
    __syncthreads(); SWAIT(); SWRITE(0, SE);
    RESC(alB); __syncthreads();
    SBAR(); qkt(pA0, pA1, K_lds, qr, r32, hi);
    finishSM(pB0, pB1, alB, l_reg, pa0, pa1, pa2, pa3); SBAR();
    if (SDEPTH == 1 || j + 3 < NT) SLOAD(SE, ROW0(j + 1 + SDEPTH)); SBAR();
    pv_d0(o, vb0 + (int)SHM_V, pa0, pa1, pa2, pa3); mask_tile<MODE>(pA0, pA1, u, j + 1, wid, r32, hi, biasL); partialSM(pA0, pA1, m_reg, mnA, alA);
    __syncthreads(); SWAIT(); SWRITE(1, SO);
    RESC(alA); __syncthreads();
  }
  SBAR(); qkt(pB0, pB1, (bf16_t*)((char*)K_lds + SHM_K), qr, r32, hi);
  finishSM(pA0, pA1, alA, l_reg, pa0, pa1, pa2, pa3); SBAR();
  pv_d0(o, vb0, pa0, pa1, pa2, pa3); mask_tile<MODE>(pB0, pB1, u, NT - 1, wid, r32, hi, biasL); partialSM(pB0, pB1, m_reg, mnB, alB);
  __syncthreads(); RESC(alB);
  finishSM(pB0, pB1, alB, l_reg, pa0, pa1, pa2, pa3); SBAR();
  pv_d0(o, vb0 + (int)SHM_V, pa0, pa1, pa2, pa3);
  l_reg += __builtin_amdgcn_exp2f(u.sink_l2e - m_reg * (SCALE * 1.4426950408889634f));
  if (hi == 0) li_l[r32] = l_reg; asm volatile("s_waitcnt lgkmcnt(0)" ::: "memory");
  float rli[16];
#pragma unroll
  for (int r = 0; r < 16; ++r) rli[r] = __builtin_amdgcn_rcpf(li_l[crow(r, hi)]);
  bf16_t* Ow = u.O + (long)(wid * QBLK) * u.ldo;
#pragma unroll
  for (int r = 0; r < 16; ++r) { int orow = crow(r, hi);
#pragma unroll
    for (int d0 = 0; d0 < 4; ++d0) { const float v = o[d0][r] * rli[r]; Ow[(long)orow * u.ldo + d0 * 32 + r32] = (bf16_t)(cvt_pk_bf16(v, v) & 0xffffu); } }
  __syncthreads();
#undef SLOAD
#undef SWRITE
#undef SWAIT
#undef RESC
#undef ROW0
}
#undef KSWZ
#undef SBAR
}

struct Args { const float* in[22]; float* out; unsigned char* ws; int ph_lo, ph_hi; };
enum { I_X = 0, I_C, I_CTX, I_CCTX, I_ADAW, I_ADAB, I_NORMG, I_WG, I_WU, I_WD, I_ABIN, I_ABOUT, I_NAQG, I_NAKG, I_NABIAS, I_SWQG, I_SWKG, I_SINK, I_GIN, I_GOUT, I_GQG, I_GKG };

__device__ __forceinline__ unsigned f2bf(float f) { unsigned u = __builtin_bit_cast(unsigned, f); return (u + 0x7fffu + ((u >> 16) & 1u)) >> 16; }
__device__ __forceinline__ unsigned pk2(float lo, float hi) { return f2bf(lo) | (f2bf(hi) << 16); }
__device__ __forceinline__ void transpose_item(const float* __restrict__ W, int K, int N, bf16_t* WT, int mode, LAS float* scr, int item, int lane) {
    const int nblk = N / 32, kb = item / nblk, nb = item % nblk, k0 = 64 * kb, n0 = 32 * nb;
#pragma unroll 8
    for (int i = 0; i < 32; ++i) { const int kk = 2 * i + (lane >> 5); scr[kk * 33 + (lane & 31)] = W[(size_t)(k0 + kk) * N + n0 + (lane & 31)]; }
    asm volatile("s_waitcnt lgkmcnt(0)" ::: "memory");
    const int c = lane & 7;
    const int rbase = (mode == 0) ? n0 : ((n0 >> 7) * 256 + (n0 & 127) + (mode == 2 ? 128 : 0));
#pragma unroll
    for (int j = 0; j < 4; ++j) { const int n = (lane >> 3) + 8 * j; const LAS float* s = scr + (8 * c) * 33 + n;
        u32x4 o; o.x = pk2(s[0 * 33], s[1 * 33]); o.y = pk2(s[2 * 33], s[3 * 33]); o.z = pk2(s[4 * 33], s[5 * 33]); o.w = pk2(s[6 * 33], s[7 * 33]);
        *(u32x4*)(WT + (size_t)(rbase + n) * K + k0 + 8 * c) = o; }
    asm volatile("s_waitcnt lgkmcnt(0)" ::: "memory");
}
__device__ __forceinline__ void phase0(const Args& a, unsigned char* lds_g, int G) {
    const int tid = TID(), lane = tid & 63, wave = tid >> 6; const int bid = BID();
    float* sc = (float*)lds_g;
    float* red = sc + 4096;
    for (int i = tid; i < DM; i += 512) { const float c = a.in[I_C][i]; sc[i] = c / (1.0f + __expf(-c)); const float cc = a.in[I_CCTX][i]; sc[DM + i] = cc / (1.0f + __expf(-cc)); }
    __syncthreads();
    float* mod = (float*)(a.ws + WS_MOD);
    for (int unit = bid; unit < 256; unit += G) {
        const int layer = unit >> 7, col0 = (unit & 127) * 144;
        f32x4 a1 = {0.f, 0.f, 0.f, 0.f}, a2 = {0.f, 0.f, 0.f, 0.f};
        if (lane < 36) {
            const float* W = a.in[I_ADAW] + (size_t)layer * DM * NMODV + col0 + 4 * lane;
            for (int k = wave * 256; k < wave * 256 + 256; k += 8) {
                f32x4 w[8];
#pragma unroll
                for (int q = 0; q < 8; ++q) w[q] = __builtin_nontemporal_load((const f32x4*)(W + (size_t)(k + q) * NMODV));
#pragma unroll
                for (int q = 0; q < 8; ++q) { a1 += w[q] * sc[k + q]; a2 += w[q] * sc[DM + k + q]; }
            }
#pragma unroll
            for (int e = 0; e < 4; ++e) { red[(wave * 2 + 0) * 144 + 4 * lane + e] = a1[e]; red[(wave * 2 + 1) * 144 + 4 * lane + e] = a2[e]; }
        }
        __syncthreads();
        if (tid < 288) { const int v = tid / 144, j = tid % 144; float s = a.in[I_ADAB][layer * NMODV + col0 + j];
#pragma unroll
            for (int w = 0; w < 8; ++w) s += red[(w * 2 + v) * 144 + j];
            mod[(size_t)(layer * 2 + v) * NMODV + col0 + j] = s; }
        __syncthreads();
    }
    LAS float* scr = (LAS float*)((LAS unsigned char*)lds_g + wave * 16384);
    const int gw = bid * 8 + wave, NGW = G * 8;
    constexpr int I_GU1 = (DM / 64) * (FF / 32);
    constexpr int I_D1 = (FF / 64) * (DM / 32);
    constexpr int I_GU = 8 * I_GU1, I_D = 4 * I_D1, I_ABI = (DM / 64) * (AB_IN / 32), I_SQ = (DM / 64) * (DM / 32), I_GI = (DM / 64) * (C_IN / 32);
    constexpr int NITEMS = I_GU + I_D + I_ABI + I_SQ + I_GI + I_SQ;
    bf16_t* wgu = (bf16_t*)(a.ws + WS_WGU); bf16_t* wd = (bf16_t*)(a.ws + WS_WD);
    for (int it = gw; it < NITEMS; it += NGW) {
        int r = it;
        if (r < I_GU) { const int q = r / I_GU1, lf = q >> 1, gu = q & 1; r -= q * I_GU1;
            transpose_item((gu ? a.in[I_WU] : a.in[I_WG]) + (size_t)lf * DM * FF, DM, FF, wgu + (size_t)lf * WGU_ELEMS, 1 + gu, scr, r, lane); continue; }
        r -= I_GU;
        if (r < I_D) { const int lf = r / I_D1; r -= lf * I_D1; transpose_item(a.in[I_WD] + (size_t)lf * FF * DM, FF, DM, wd + (size_t)lf * WD_ELEMS, 0, scr, r, lane); continue; }
        r -= I_D;
        if (r < I_ABI) { transpose_item(a.in[I_ABIN], DM, AB_IN, (bf16_t*)(a.ws + WS_WABIN), 0, scr, r, lane); continue; }
        r -= I_ABI;
        if (r < I_SQ) { transpose_item(a.in[I_ABOUT], DM, DM, (bf16_t*)(a.ws + WS_WABOUT), 0, scr, r, lane); continue; }
        r -= I_SQ;
        if (r < I_GI) { transpose_item(a.in[I_GIN], DM, C_IN, (bf16_t*)(a.ws + WS_WGIN), 0, scr, r, lane); continue; }
        r -= I_GI;
        transpose_item(a.in[I_GOUT], DM, DM, (bf16_t*)(a.ws + WS_WGOUT), 0, scr, r, lane);
    }
}

__device__ __forceinline__ void modulate_phase(const float* xsrc, float* xcopy, const float* csrc, float* cdst, const float* part, int nsplit, const float* cgate, float ccoef,
                                               const float* g, const float* shift_l, const float* scale_l, const float* shift_c, const float* scale_c, bf16_t* h, int nrows, int G) {
    const int tid = TID(), lane = tid & 63, wave = tid >> 6;
    const int gw = BID() * 8 + wave, NGW = G * 8;
    for (int row = gw; row < nrows; row += NGW) {
        const bool isctx = row >= SEQ;
        f32x4 v[8];
        if (!isctx) {
            const f32x4* xr = (const f32x4*)(xsrc + (size_t)row * DM) + lane;
#pragma unroll
            for (int j = 0; j < 8; ++j) v[j] = xr[64 * j];
            if (xcopy) { f32x4* xo = (f32x4*)(xcopy + (size_t)row * DM) + lane;
#pragma unroll
                for (int j = 0; j < 8; ++j) xo[64 * j] = v[j]; }
        } else {
            const int r = row - SEQ;
            const f32x4* xr = (const f32x4*)(csrc + (size_t)r * DM) + lane;
#pragma unroll
            for (int j = 0; j < 8; ++j) v[j] = xr[64 * j];
            if (nsplit > 0) {
                f32x4 s[8];
#pragma unroll
                for (int j = 0; j < 8; ++j) s[j] = (f32x4){0.f, 0.f, 0.f, 0.f};
                for (int sp = 0; sp < nsplit; ++sp) { const f32x4* pr = (const f32x4*)(part + ((size_t)sp * 256 + r) * DM) + lane;
#pragma unroll
                    for (int j = 0; j < 8; ++j) s[j] += pr[64 * j]; }
#pragma unroll
                for (int j = 0; j < 8; ++j) { const f32x4 gt = *((const f32x4*)cgate + lane + 64 * j); v[j] += ccoef * gt * s[j]; }
            }
            if (cdst) { f32x4* xo = (f32x4*)(cdst + (size_t)r * DM) + lane;
#pragma unroll
                for (int j = 0; j < 8; ++j) xo[64 * j] = v[j]; }
        }
        float ss = 0.f;
#pragma unroll
        for (int j = 0; j < 8; ++j) ss += (v[j].x * v[j].x + v[j].y * v[j].y) + (v[j].z * v[j].z + v[j].w * v[j].w);
        const float rstd = 1.0f / sqrtf(wave_sum(ss) * (1.0f / DM) + EPS);
        const f32x4* sh = (const f32x4*)(isctx ? shift_c : shift_l) + lane; const f32x4* scl = (const f32x4*)(isctx ? scale_c : scale_l) + lane;
        const f32x4* gg = (const f32x4*)g + lane;
        u32x2* ho = (u32x2*)(h + (size_t)row * DM) + lane;
#pragma unroll
        for (int j = 0; j < 8; ++j) { const f32x4 y = (v[j] * rstd) * gg[64 * j]; const f32x4 z = y * (scl[64 * j] + 1.0f) + sh[64 * j];
            u32x2 w; w.x = cvt_pk_bf16(z.x, z.y); w.y = cvt_pk_bf16(z.z, z.w); ho[64 * j] = w; }
    }
}

__device__ __forceinline__ void qknorm_phase(const Args& a, int layer, int G) {
    const int tid = TID(), lane = tid & 63, wave = tid >> 6, hw = lane >> 5, l5 = lane & 31;
    const int gw = BID() * 8 + wave, NGW = G * 8;
    bf16_t* P = (bf16_t*)(a.ws + WS_P); const int ld = layer == 0 ? AB_IN : C_IN;
    const int npairs = layer == 0 ? 13 : 10;
    const int d0 = 2 * l5, d1 = d0 + 1;
    const float inv0 = exp2f(-(float)(d0 & 31) * (13.287712379549449f / 32.0f)), inv1 = exp2f(-(float)(d1 & 31) * (13.287712379549449f / 32.0f));
    for (int row = gw; row < MT; row += NGW) {
        const bool isctx = row >= SEQ;
        const float pos = (l5 < 16) ? (float)(row >> 6) : (float)(row & 63);
        float c0 = 1.f, s0 = 0.f, c1 = 1.f, s1 = 0.f;
        if (!isctx) { float rv0 = pos * inv0 * 0.15915494309189535f, rv1 = pos * inv1 * 0.15915494309189535f; rv0 -= floorf(rv0); rv1 -= floorf(rv1);
            s0 = __builtin_amdgcn_sinf(rv0); c0 = __builtin_amdgcn_cosf(rv0); s1 = __builtin_amdgcn_sinf(rv1); c1 = __builtin_amdgcn_cosf(rv1); }
        bf16_t* prow = P + (size_t)row * ld;
        for (int it = 0; it < npairs; ++it) {
            int slot = 2 * it + hw; const float* gain; bool rope;
            if (layer == 0) { if (slot >= 24) slot += 8;
                if (slot < 8) { gain = a.in[I_NAQG]; rope = false; } else if (slot < 16) { gain = a.in[I_SWQG]; rope = true; }
                else if (slot < 24) { gain = a.in[I_NAKG]; rope = false; } else { gain = a.in[I_SWKG]; rope = true; } }
            else { if (slot < 16) gain = a.in[I_GQG]; else gain = a.in[I_GKG]; rope = true; }
            unsigned* p1 = (unsigned*)(prow + slot * 128 + d0); unsigned* p2 = (unsigned*)(prow + slot * 128 + 64 + d0);
            const unsigned w1 = *p1, w2 = *p2;
            float x10 = __uint_as_float(w1 << 16), x11 = __uint_as_float(w1 & 0xffff0000u), x20 = __uint_as_float(w2 << 16), x21 = __uint_as_float(w2 & 0xffff0000u);
            float ss = x10 * x10 + x11 * x11 + x20 * x20 + x21 * x21;
#pragma unroll
            for (int o = 1; o < 32; o <<= 1) ss += __shfl_xor(ss, o);
            const float rstd = 1.0f / sqrtf(ss * (1.0f / 128.0f) + EPS);
            x10 = x10 * rstd * gain[d0]; x11 = x11 * rstd * gain[d1]; x20 = x20 * rstd * gain[64 + d0]; x21 = x21 * rstd * gain[64 + d1];
            float y10 = x10, y11 = x11, y20 = x20, y21 = x21;
            if (rope && !isctx) { y10 = x10 * c0 - x20 * s0; y20 = x10 * s0 + x20 * c0; y11 = x11 * c1 - x21 * s1; y21 = x11 * s1 + x21 * c1; }
            *p1 = cvt_pk_bf16(y10, y11); *p2 = cvt_pk_bf16(y20, y21);
        }
    }
}

__device__ __forceinline__ void attn_phase0(const Args& a, unsigned char* lds_g, int G) {
    bf16_t* P = (bf16_t*)(a.ws + WS_P); bf16_t* O = (bf16_t*)(a.ws + WS_O);
    float* biasL = (float*)(lds_g + att::BIAS_OFF);
    const int tid0 = TID();
    for (int un = BID(); un < 528; un += G) {
        att::UnitP u; u.ldq = AB_IN; u.ldk = AB_IN; u.ldo = DM; u.sink_l2e = -INFINITY;
        if (un < 256) {
            const int h = un & 7, qb = un >> 3;
            for (int i = tid0; i < 465; i += 512) biasL[i] = a.in[I_NABIAS][h * 465 + i] * att::INV_SCALE;
            __syncthreads();
            u.Q = P + (size_t)(256 * qb) * AB_IN + h * 128; u.K = P + (16 + h) * 128; u.V = P + (24 + h) * 128; u.O = O + (size_t)(256 * qb) * DM + h * 128;
            u.NT = 16; u.base_row = 0; u.qb = qb;
            att::attn_unit<att::NA, 1>(u, (char*)lds_g);
        } else if (un < 512) {
            const int hq = (un - 256) & 7, qb = (un - 256) >> 3, kvh = hq >> 2;
            u.Q = P + (size_t)(256 * qb) * AB_IN + (8 + hq) * 128; u.K = P + (32 + kvh) * 128; u.V = P + (34 + kvh) * 128; u.O = O + (size_t)(256 * qb) * DM + (8 + hq) * 128;
            u.NT = 12; u.base_row = 0; u.qb = qb; u.sink_l2e = a.in[I_SINK][hq] * 1.4426950408889634f;
            att::attn_unit<att::SW, 1>(u, (char*)lds_g);
        } else {
            const int hh = un - 512;
            u.Q = P + (size_t)SEQ * AB_IN + hh * 128; u.O = O + (size_t)SEQ * DM + hh * 128;
            const bool nah = hh < 8; const int hq = nah ? 0 : hh - 8, kvh = hq >> 2;
            const int kslot = nah ? 16 + hh : 32 + kvh, vslot = nah ? 24 + hh : 34 + kvh;
            u.K = P + kslot * 128; u.V = P + vslot * 128;
            const float sk = a.in[I_SINK][hq] * 1.4426950408889634f; u.sink_l2e = nah ? -INFINITY : sk;
            u.NT = 4; u.base_row = SEQ; u.qb = 0;
            att::attn_unit<att::DENSE, 2>(u, (char*)lds_g);
        }
    }
}
__device__ __forceinline__ void attn_phase1(const Args& a, unsigned char* lds_g, int G) {
    bf16_t* P = (bf16_t*)(a.ws + WS_P); bf16_t* O = (bf16_t*)(a.ws + WS_O);
    const int bid = BID();
    for (int i = 0;; ++i) {
        int un;
        if ((G & 7) == 0) { const int x = bid & 7, j = (bid >> 3) + i * (G >> 3); if (j >= 64) break; un = x * 64 + j; }
        else { un = bid + i * G; if (un >= 512) break; }
        const int h = un >> 5, qb = un & 31, kvh = h >> 2;
        att::UnitP u; u.ldq = C_IN; u.ldk = C_IN; u.ldo = DM; u.sink_l2e = -INFINITY;
        u.Q = P + (size_t)(256 * qb) * C_IN + h * 128; u.K = P + (16 + kvh) * 128; u.V = P + (20 + kvh) * 128; u.O = O + (size_t)(256 * qb) * DM + h * 128;
        u.NT = MT / 64; u.base_row = 0; u.qb = qb;
        att::attn_unit<att::DENSE, 2>(u, (char*)lds_g);
    }
}

__global__ void __launch_bounds__(512, 2) mk_fwd(Args a) {
    extern __shared__ __attribute__((aligned(16))) unsigned char lds[];
    cg::grid_group grid = cg::this_grid();
    const int G = gridDim.x;
    LAS unsigned char* lds3 = (LAS unsigned char*)lds;
    float* mod = (float*)(a.ws + WS_MOD);
    float* xc = (float*)(a.ws + WS_XC); float* part = (float*)(a.ws + WS_PART);
    bf16_t* H = (bf16_t*)(a.ws + WS_H); bf16_t* O = (bf16_t*)(a.ws + WS_O); bf16_t* P = (bf16_t*)(a.ws + WS_P); bf16_t* A = (bf16_t*)(a.ws + WS_A);
    for (int ph = a.ph_lo; ph < a.ph_hi; ++ph) {
        if (ph == 0) { phase0(a, lds, G); }
        else {
            const int layer = (ph - 1) / 11, sub = (ph - 1) % 11;
            const float* mL = mod + (size_t)(layer * 2 + 0) * NMODV; const float* mC = mod + (size_t)(layer * 2 + 1) * NMODV;
            const bool with_ctx = layer == 0;
            if (sub == 0 || sub == 3 || sub == 8) {
                const int k = sub == 0 ? 0 : (sub == 3 ? 1 : 2);
                const bool first = (ph == 1);
                const float* xsrc = first ? a.in[I_X] : a.out; float* xcopy = first ? a.out : nullptr;
                const float* csrc = first ? a.in[I_CTX] : xc;
                const bool upd_prev = (sub == 0 && layer == 1);
                const int nsplit = (upd_prev || sub == 3) ? NSPLIT_DOWN : ((sub == 8) ? NSPLIT_OUT : 0);
                const float* cgate = upd_prev ? (mod + (size_t)(0 * 2 + 1) * NMODV + 8 * DM) : (sub == 3 ? mC + 2 * DM : mC + 5 * DM);
                const float ccoef = (sub == 8) ? 1.0f : 0.5f;
                const int nrows = (sub == 8 && !with_ctx) ? SEQ : MT;
                modulate_phase(xsrc, xcopy, csrc, xc, part, nsplit, cgate, ccoef, a.in[I_NORMG] + (size_t)(layer * 3 + k) * DM,
                               mL + (3 * k) * DM, mL + (3 * k + 1) * DM, mC + (3 * k) * DM, mC + (3 * k + 1) * DM, H, nrows, G);
            } else if (sub == 1 || sub == 9) {
                const int f = sub == 1 ? 0 : 1; const int nM = (f == 1 && !with_ctx) ? SEQ / 256 : MT / 256;
                pg8::Gemm g{H, (const bf16_t*)(a.ws + WS_WGU) + (size_t)(layer * 2 + f) * WGU_ELEMS, DM};
                pg8::Sched S; S.init(nM, 2 * FF / 256, DM, G, BID(), 0, 0, 0);
                pg8::EpiSwiGLU E{A, FF};
                pg8::gemm_phase<pg8::EpiSwiGLU, true, true>(lds3, g, S, E);
            } else if (sub == 2 || sub == 10) {
                const int f = sub == 2 ? 0 : 1; const bool ctxrows = !(f == 1 && !with_ctx);
                pg8::Gemm g{A, (const bf16_t*)(a.ws + WS_WD) + (size_t)(layer * 2 + f) * WD_ELEMS, FF};
                pg8::Sched S; S.init(SEQ / 256, DM / 256, FF, G, BID(), ctxrows ? NSPLIT_DOWN : 0, NT_SPLIT_DOWN, SEQ / 256);
                pg8::EpiResid E{a.out, mL + (f == 0 ? 2 : 8) * DM, 0.5f, part};
                pg8::gemm_phase<pg8::EpiResid, true, true>(lds3, g, S, E);
            } else if (sub == 4) {
                const int N = layer == 0 ? AB_IN : C_IN;
                pg8::Gemm g{H, (const bf16_t*)(a.ws + (layer == 0 ? WS_WABIN : WS_WGIN)), DM};
                pg8::Sched S; S.init(MT / 256, N / 256, DM, G, BID(), 0, 0, 0);
                pg8::EpiBf16 E{P, N};
                pg8::gemm_phase<pg8::EpiBf16, true, true>(lds3, g, S, E);
            } else if (sub == 5) { qknorm_phase(a, layer, G); }
            else if (sub == 6) { if (layer == 0) attn_phase0(a, lds, G); else attn_phase1(a, lds, G); }
            else if (sub == 7) {
                pg8::Gemm g{O, (const bf16_t*)(a.ws + (layer == 0 ? WS_WABOUT : WS_WGOUT)), DM};
                pg8::Sched S; S.init(SEQ / 256, DM / 256, DM, G, BID(), with_ctx ? NSPLIT_OUT : 0, NT_SPLIT_OUT, SEQ / 256);
                pg8::EpiResid E{a.out, mL + 5 * DM, 1.0f, part};
                pg8::gemm_phase<pg8::EpiResid, true, true>(lds3, g, S, E);
            }
        }
        if (ph + 1 < a.ph_hi) grid.sync();
    }
}

extern "C" void kernel_launch(void* const* d_in, const int* in_sizes, int n_in, void* d_out, int out_size, void* d_ws, size_t ws_size, hipStream_t stream) {
    static int grid = 0;
    if (grid == 0) {
        if (n_in != 22 || out_size != SEQ * DM || ws_size < WS_END) { fprintf(stderr, "kernel_launch: unexpected shapes (n_in %d out %d ws %zu)\n", n_in, out_size, ws_size); grid = -1; return; }
        int dev = 0, cus = 0, per_cu = 0;
        hipGetDevice(&dev); hipDeviceGetAttribute(&cus, hipDeviceAttributeMultiprocessorCount, dev);
        if (hipFuncSetAttribute((const void*)mk_fwd, hipFuncAttributeMaxDynamicSharedMemorySize, LDS_BYTES) != hipSuccess) { fprintf(stderr, "kernel_launch: hipFuncSetAttribute failed\n"); grid = -1; return; }
        if (hipOccupancyMaxActiveBlocksPerMultiprocessor(&per_cu, (const void*)mk_fwd, 512, LDS_BYTES) != hipSuccess || per_cu < 1) { fprintf(stderr, "kernel_launch: occupancy query gave %d\n", per_cu); per_cu = 1; }
        (void)hipGetLastError();
        grid = cus * per_cu;
        if (grid > 256) grid = 256;
    }
    if (grid < 0) return;
    Args a{};
    for (int i = 0; i < 22; ++i) a.in[i] = (const float*)d_in[i];
    a.out = (float*)d_out; a.ws = (unsigned char*)d_ws;
#if MK_MULTI
    for (int p = 0; p < NPHASE; ++p) { a.ph_lo = p; a.ph_hi = p + 1; hipLaunchKernelGGL(mk_fwd, dim3(grid), dim3(512), LDS_BYTES, stream, a); }
#else
    a.ph_lo = 0; a.ph_hi = NPHASE;
    void* args[] = {&a};
    hipError_t e = hipLaunchCooperativeKernel((const void*)mk_fwd, dim3(grid), dim3(512), args, LDS_BYTES, stream);
    if (e != hipSuccess) fprintf(stderr, "cooperative launch failed: %s (grid %d)\n", hipGetErrorString(e), grid);
#endif
}
```

```cpp
#include <hip/hip_runtime.h>
#include <hip/hip_cooperative_groups.h>
#include <cstdio>
#include <cstdint>
namespace cg = cooperative_groups;

#ifndef REPMASK
#define REPMASK 0
#endif
#ifndef MK_MULTI
#define MK_MULTI 0
#endif

constexpr int SEQ = 8192, CTXL = 256, MT = SEQ + CTXL, DM = 2048, FF = 5632, NMODV = 9 * DM;
constexpr int AB_IN = 4608, C_IN = 3072, GRIDW = 64;
constexpr float EPS = 1e-6f;
constexpr int NPHASE = 23;
constexpr int NSPLIT_DOWN = 22, NT_SPLIT_DOWN = 4;
constexpr int NSPLIT_OUT = 16, NT_SPLIT_OUT = 2;

constexpr size_t MiB = 1u << 20;
constexpr size_t WS_MOD = 0;
constexpr size_t WS_BAR = 512 * 1024, BAR_BYTES = 16384;
constexpr size_t WS_XC = 1 * MiB;
constexpr size_t WS_PART = 4 * MiB;
constexpr size_t WS_H = 52 * MiB;
constexpr size_t WS_O = 88 * MiB;
constexpr size_t WS_P = 124 * MiB;
constexpr size_t WS_A = 200 * MiB;
constexpr size_t WS_WGU = 292 * MiB;
constexpr size_t WS_WD = 468 * MiB;
constexpr size_t WS_WABIN = 556 * MiB;
constexpr size_t WS_WABOUT = 574 * MiB;
constexpr size_t WS_WGIN = 582 * MiB;
constexpr size_t WS_WGOUT = 594 * MiB;
constexpr size_t WS_END = 602 * MiB;
constexpr size_t WGU_ELEMS = (size_t)2 * FF * DM, WD_ELEMS = (size_t)DM * FF;

constexpr int LDS_BYTES = 143360;
constexpr int MISC_OFF = 135168;

typedef unsigned short bf16_t;
typedef short bf16x8 __attribute__((ext_vector_type(8)));
typedef short s16x4 __attribute__((ext_vector_type(4)));
typedef float f32x4 __attribute__((ext_vector_type(4)));
typedef float f32x2 __attribute__((ext_vector_type(2)));
typedef float f32x16 __attribute__((ext_vector_type(16)));
typedef unsigned u32x4 __attribute__((ext_vector_type(4)));
typedef unsigned u32x2 __attribute__((ext_vector_type(2)));
#define LAS __attribute__((address_space(3)))

__device__ __forceinline__ unsigned cvt_pk_bf16(float lo, float hi) { unsigned r; asm volatile("v_cvt_pk_bf16_f32 %0, %1, %2" : "=v"(r) : "v"(lo), "v"(hi)); return r; }
__device__ __forceinline__ int TID() { int t = threadIdx.x; asm volatile("" : "+v"(t)); return t; }
__device__ __forceinline__ int BID() { int b = blockIdx.x; asm volatile("" : "+s"(b)); return b; }
__device__ __forceinline__ float bf2f(unsigned short b) { return __uint_as_float(((unsigned)b) << 16); }
__device__ __forceinline__ float wave_sum(float v) {
#pragma unroll
    for (int o = 1; o < 64; o <<= 1) v += __shfl_xor(v, o);
    return v;
}

namespace pg8 {
constexpr int BM = 256, BK = 64, HALF = 128, HTB = HALF * BK * 2, STAGE_BYTES = 8 * HTB, NXCD = 8, WGM = 8;
__host__ __device__ __forceinline__ int lds_byte(int r, int c) { const int st = (r >> 4) * 2 + (c >> 5), rr = r & 15, cc = c & 31, ob = rr * 64 + cc * 2; return st * 1024 + (ob ^ (((ob >> 9) & 1) << 5)); }
__host__ __device__ __forceinline__ void stage_rc(int b, int& R, int& C) { const int st = b / 1024, sb = b % 1024, swz = sb ^ (((sb >> 9) & 1) << 5); R = (st >> 1) * 16 + swz / 64; C = (st & 1) * 32 + (swz % 64) / 2; }
__host__ __device__ __forceinline__ int perm32(int rho) { const int n = rho >> 4, i = rho & 15; return 8 * (i >> 2) + 4 * n + (i & 3); }

struct Unit { int pm, pn, k0, nt, split; };
struct Gemm { const bf16_t* A; const bf16_t* Bt; int K; };

struct Sched {
    int nM, nN, nwg, G, c, nt_full, nsplit_units, split_nt, split_pm;
    __device__ __forceinline__ void init(int nM_, int nN_, int K, int G_, int c_, int nsplit, int snt, int spm) {
        nM = nM_; nN = nN_; nwg = nM * nN; G = G_; c = c_; nt_full = K / BK; nsplit_units = nsplit * nN_; split_nt = snt; split_pm = spm; }
    __device__ __forceinline__ bool next(int i, Unit& u) const {
        const long L = (long)i * G + c;
        const bool reg = L < nwg; const int s = reg ? 0 : (int)(L - nwg);
        if (!reg && s >= nsplit_units) return false;
        int wgid = reg ? (int)L : 0; { const int q = nwg / NXCD, r = nwg % NXCD, xcd = wgid % NXCD, off = wgid / NXCD; wgid = (xcd < r ? xcd * (q + 1) : r * (q + 1) + (xcd - r) * q) + off; }
        const int nig = WGM * nN, gid = wgid / nig, fm = gid * WGM, gsz = (nM - fm) < WGM ? (nM - fm) : WGM;
        const int pm_r = fm + ((wgid % nig) % gsz), pn_r = (wgid % nig) / gsz;
        const int pn_s = s % nN, sp_s = s / nN;
        u.pm = __builtin_amdgcn_readfirstlane(reg ? pm_r : split_pm); u.pn = __builtin_amdgcn_readfirstlane(reg ? pn_r : pn_s);
        u.split = __builtin_amdgcn_readfirstlane(reg ? -1 : sp_s); u.k0 = __builtin_amdgcn_readfirstlane(reg ? 0 : sp_s * split_nt); u.nt = __builtin_amdgcn_readfirstlane(reg ? nt_full : split_nt);
        return true;
    }
};

struct EpiBf16 {
    static constexpr bool PERM = true;
    bf16_t* O; int ldc;
    __device__ __forceinline__ void operator()(const f32x4 (&acc)[2][2][4][2], const Unit& u, int wr, int wc, int fr, int fq) const {
        asm volatile("" : "+v"(fr), "+v"(fq));
        const int row0 = u.pm * BM + wr * 64 + fr; const int col0 = u.pn * BM + wc * 32 + 8 * fq;
#pragma unroll
        for (int ai = 0; ai < 2; ++ai)
#pragma unroll
            for (int m = 0; m < 4; ++m) { bf16_t* rowp = O + (size_t)(row0 + ai * HALF + m * 16) * ldc + col0;
#pragma unroll
                for (int bj = 0; bj < 2; ++bj) { const f32x4 v0 = acc[ai][bj][m][0], v1 = acc[ai][bj][m][1];
                    u32x4 w; w.x = cvt_pk_bf16(v0[0], v0[1]); w.y = cvt_pk_bf16(v0[2], v0[3]); w.z = cvt_pk_bf16(v1[0], v1[1]); w.w = cvt_pk_bf16(v1[2], v1[3]);
                    *(u32x4*)(rowp + bj * HALF) = w; } }
    }
};
__device__ __forceinline__ float silu_mul(float g, float u) { const float e = __builtin_amdgcn_exp2f(-g * 1.4426950408889634f); return g * __builtin_amdgcn_rcpf(1.0f + e) * u; }
struct EpiSwiGLU {
    static constexpr bool PERM = true;
    bf16_t* O; int ldc;
    __device__ __forceinline__ void operator()(const f32x4 (&acc)[2][2][4][2], const Unit& u, int wr, int wc, int fr, int fq) const {
        asm volatile("" : "+v"(fr), "+v"(fq));
        const int row0 = u.pm * BM + wr * 64 + fr; const int col0 = u.pn * HALF + wc * 32 + 8 * fq;
#pragma unroll
        for (int ai = 0; ai < 2; ++ai)
#pragma unroll
            for (int m = 0; m < 4; ++m) { bf16_t* rowp = O + (size_t)(row0 + ai * HALF + m * 16) * ldc + col0;
                const f32x4 g0 = acc[ai][0][m][0], g1 = acc[ai][0][m][1], u0 = acc[ai][1][m][0], u1 = acc[ai][1][m][1];
                u32x4 w; w.x = cvt_pk_bf16(silu_mul(g0[0], u0[0]), silu_mul(g0[1], u0[1])); w.y = cvt_pk_bf16(silu_mul(g0[2], u0[2]), silu_mul(g0[3], u0[3]));
                w.z = cvt_pk_bf16(silu_mul(g1[0], u1[0]), silu_mul(g1[1], u1[1])); w.w = cvt_pk_bf16(silu_mul(g1[2], u1[2]), silu_mul(g1[3], u1[3]));
                *(u32x4*)rowp = w; }
    }
};
struct EpiResid {
    static constexpr bool PERM = false;
    float* X; const float* gate; float coef; float* part;
    __device__ __forceinline__ void operator()(const f32x4 (&acc)[2][2][4][2], const Unit& u, int wr, int wc, int fr, int fq) const {
        asm volatile("" : "+v"(fr), "+v"(fq));
        const int col0 = u.pn * BM + wc * 32 + 4 * fq;
        if (u.split < 0) {
            f32x4 gv[2][2];
#pragma unroll
            for (int bj = 0; bj < 2; ++bj)
#pragma unroll
                for (int n = 0; n < 2; ++n) gv[bj][n] = *(const f32x4*)(gate + col0 + bj * HALF + n * 16) * coef;
#pragma unroll
            for (int ai = 0; ai < 2; ++ai)
#pragma unroll
                for (int m = 0; m < 4; ++m) { float* rowp = X + (size_t)(u.pm * BM + ai * HALF + wr * 64 + m * 16 + fr) * DM + col0;
#pragma unroll
                    for (int bj = 0; bj < 2; ++bj)
#pragma unroll
                        for (int n = 0; n < 2; ++n) { f32x4* p = (f32x4*)(rowp + bj * HALF + n * 16); *p = *p + gv[bj][n] * acc[ai][bj][m][n]; }
                    asm volatile("" ::: "memory"); }
        } else {
            float* base = part + (size_t)u.split * 256 * DM;
#pragma unroll
            for (int ai = 0; ai < 2; ++ai)
#pragma unroll
                for (int m = 0; m < 4; ++m) { float* rowp = base + (size_t)(ai * HALF + wr * 64 + m * 16 + fr) * DM + col0;
#pragma unroll
                    for (int bj = 0; bj < 2; ++bj)
#pragma unroll
                        for (int n = 0; n < 2; ++n) *(f32x4*)(rowp + bj * HALF + n * 16) = acc[ai][bj][m][n]; }
        }
    }
};

template <class Epi, bool ALIGN_EPI, bool SP2>
__device__ __forceinline__ void gemm_phase(LAS unsigned char* lds, const Gemm g, const Sched& S, const Epi& E) {
    const int tid = TID(), wid = __builtin_amdgcn_readfirstlane(tid >> 6), lane = tid & 63, wr = wid >> 2, wc = wid & 3, fr = lane & 15, fq = lane >> 4;
    const int K = g.K;
    unsigned voffA[2], voffB[2];
#pragma unroll
    for (int i = 0; i < 2; ++i) { int R, C; stage_rc(tid * 16 + i * 8192, R, C); const int Rb = Epi::PERM ? ((R & ~31) + perm32(R & 31)) : R;
        voffA[i] = (unsigned)(R * K + C) * 2u; voffB[i] = (unsigned)(Rb * K + C) * 2u; }
    const size_t kstep = (size_t)(BK * 2);
    const size_t hstep = (size_t)HALF * K * 2;
    const size_t tstep = 2 * hstep;
    const unsigned ldsw = (unsigned)wid * 1024u;
    const int aoff = lds_byte(wr * 64 + fr, fq * 8), boff = lds_byte(wc * 32 + fr, fq * 8);
#define PG8_SA(b, h) (((b) * 2 + (h)) * HTB)
#define PG8_SB(b, h) ((4 + (b) * 2 + (h)) * HTB)
#define PG8_STAGE(bufoff, gbase, voff) do { _Pragma("unroll") for (int _i = 0; _i < 2; ++_i) \
        __builtin_amdgcn_global_load_lds((const unsigned*)((const char*)(gbase) + (voff)[_i]), (LAS unsigned*)(lds + (bufoff) + ldsw + _i * 8192), 16, 0, 0); } while (0)
#define PG8_LDA(dst, b, h) do { _Pragma("unroll") for (int m = 0; m < 4; ++m) _Pragma("unroll") for (int k = 0; k < 2; ++k) dst[m][k] = *(const LAS bf16x8*)(lds + PG8_SA(b, h) + aoff + m * 2048 + k * 1024); } while (0)
#define PG8_LDB(dst, b, h) do { _Pragma("unroll") for (int n = 0; n < 2; ++n) _Pragma("unroll") for (int k = 0; k < 2; ++k) dst[n][k] = *(const LAS bf16x8*)(lds + PG8_SB(b, h) + boff + n * 2048 + k * 1024); } while (0)
#define PG8_MMA(ai, bj, At, Bt) do { __builtin_amdgcn_s_setprio(1); _Pragma("unroll") for (int m = 0; m < 4; ++m) _Pragma("unroll") for (int n = 0; n < 2; ++n) _Pragma("unroll") for (int k = 0; k < 2; ++k) \
        acc[ai][bj][m][n] = __builtin_amdgcn_mfma_f32_16x16x32_bf16(Bt[n][k], At[m][k], acc[ai][bj][m][n], 0, 0, 0); __builtin_amdgcn_s_setprio(0); } while (0)
#define PG8_WAIT_V(n) asm volatile("s_waitcnt vmcnt(" #n ")" ::: "memory")
#define PG8_WAIT_L(n) asm volatile("s_waitcnt lgkmcnt(" #n ")" ::: "memory")
#define PG8_BAR __builtin_amdgcn_s_barrier()
#define PG8_SCHED __builtin_amdgcn_sched_barrier(0)
    Unit cur, nxt; int ui = 0;
    if (!S.next(0, cur)) return;
    f32x4 acc[2][2][4][2];
#pragma unroll
    for (int a = 0; a < 2; ++a)
#pragma unroll
        for (int b = 0; b < 2; ++b)
#pragma unroll
            for (int m = 0; m < 4; ++m)
#pragma unroll
                for (int n = 0; n < 2; ++n) acc[a][b][m][n] = (f32x4){0.f, 0.f, 0.f, 0.f};
    bf16x8 At[4][2], B0[2][2], B1[2][2];
    const char* cA = (const char*)g.A + (size_t)cur.pm * tstep + (size_t)cur.k0 * kstep; const char* cB = (const char*)g.Bt + (size_t)cur.pn * tstep + (size_t)cur.k0 * kstep;
    if constexpr (SP2) {
        PG8_STAGE(PG8_SB(0, 0), cB, voffB); PG8_STAGE(PG8_SB(0, 1), cB + hstep, voffB); PG8_STAGE(PG8_SA(0, 0), cA, voffA); PG8_STAGE(PG8_SA(0, 1), cA + hstep, voffA);
        if (wr == 1) PG8_BAR;
        PG8_WAIT_V(2); PG8_BAR;
        PG8_STAGE(PG8_SB(1, 0), cB + kstep, voffB); PG8_STAGE(PG8_SA(1, 0), cA + kstep, voffA); PG8_STAGE(PG8_SB(1, 1), cB + hstep + kstep, voffB);
        PG8_WAIT_V(6); PG8_BAR;
    } else {
        PG8_STAGE(PG8_SB(0, 0), cB, voffB); PG8_STAGE(PG8_SA(0, 0), cA, voffA); PG8_STAGE(PG8_SB(0, 1), cB + hstep, voffB); PG8_STAGE(PG8_SA(0, 1), cA + hstep, voffA);
        if (wr == 1) PG8_BAR;
        PG8_WAIT_V(4); PG8_BAR;
        PG8_STAGE(PG8_SB(1, 0), cB + kstep, voffB); PG8_STAGE(PG8_SA(1, 0), cA + kstep, voffA); PG8_STAGE(PG8_SB(1, 1), cB + hstep + kstep, voffB);
        PG8_WAIT_V(6); PG8_BAR;
    }
    for (;;) {
        const bool has_next = S.next(ui + 1, nxt);
        const int nt = cur.nt;
        const char* nA = has_next ? (const char*)g.A + (size_t)nxt.pm * tstep + (size_t)nxt.k0 * kstep : cA; const char* nB = has_next ? (const char*)g.Bt + (size_t)nxt.pn * tstep + (size_t)nxt.k0 * kstep : cB;
        for (int t = 0; t < nt; t += 2) {
            const bool last = (t == nt - 2);
            const char* a1 = cA + (size_t)(t + 1) * kstep;
            const char* a2 = last ? nA : cA + (size_t)(t + 2) * kstep; const char* b2 = last ? nB : cB + (size_t)(t + 2) * kstep;
            const char* a3 = a2 + kstep; const char* b3 = b2 + kstep;
            if constexpr (SP2) {
            PG8_LDB(B0, 0, 0); PG8_LDB(B1, 0, 1); PG8_SCHED; PG8_LDA(At, 0, 0); PG8_STAGE(PG8_SA(1, 1), a1 + hstep, voffA);
            PG8_WAIT_V(8); PG8_WAIT_L(0); PG8_BAR; PG8_MMA(0, 0, At, B0); PG8_MMA(0, 1, At, B1); PG8_BAR; PG8_SCHED;
            PG8_LDA(At, 0, 1); PG8_STAGE(PG8_SB(0, 0), b2, voffB); PG8_STAGE(PG8_SB(0, 1), b2 + hstep, voffB); PG8_STAGE(PG8_SA(0, 0), a2, voffA);
            PG8_WAIT_V(8); PG8_WAIT_L(0); PG8_BAR; PG8_MMA(1, 0, At, B0); PG8_MMA(1, 1, At, B1); PG8_BAR; PG8_SCHED;
            PG8_LDB(B0, 1, 0); PG8_LDB(B1, 1, 1); PG8_SCHED; PG8_LDA(At, 1, 0); PG8_STAGE(PG8_SA(0, 1), a2 + hstep, voffA);
            PG8_WAIT_V(8); PG8_WAIT_L(0); PG8_BAR; PG8_MMA(0, 0, At, B0); PG8_MMA(0, 1, At, B1); PG8_BAR; PG8_SCHED;
            PG8_LDA(At, 1, 1); PG8_STAGE(PG8_SB(1, 0), b3, voffB); PG8_STAGE(PG8_SB(1, 1), b3 + hstep, voffB); PG8_STAGE(PG8_SA(1, 0), a3, voffA);
            PG8_WAIT_V(8); PG8_WAIT_L(0); PG8_BAR; PG8_MMA(1, 0, At, B0); PG8_MMA(1, 1, At, B1); PG8_BAR; PG8_SCHED;
            } else {
            PG8_LDB(B0, 0, 0); PG8_SCHED; PG8_LDA(At, 0, 0); PG8_STAGE(PG8_SA(1, 1), a1 + hstep, voffA);
            PG8_WAIT_L(8); PG8_BAR; PG8_WAIT_L(0); PG8_MMA(0, 0, At, B0); PG8_BAR; PG8_SCHED;
            PG8_LDB(B1, 0, 1); PG8_STAGE(PG8_SB(0, 0), b2, voffB);
            PG8_BAR; PG8_WAIT_L(0); PG8_MMA(0, 1, At, B1); PG8_BAR;
            PG8_LDA(At, 0, 1); PG8_STAGE(PG8_SA(0, 0), a2, voffA);
            PG8_BAR; PG8_WAIT_L(0); PG8_MMA(1, 0, At, B0); PG8_BAR; PG8_SCHED;
            PG8_STAGE(PG8_SB(0, 1), b2 + hstep, voffB);
            PG8_WAIT_V(6); PG8_BAR; PG8_MMA(1, 1, At, B1); PG8_BAR;
            PG8_LDB(B0, 1, 0); PG8_SCHED; PG8_LDA(At, 1, 0); PG8_STAGE(PG8_SA(0, 1), a2 + hstep, voffA);
            PG8_WAIT_L(8); PG8_BAR; PG8_WAIT_L(0); PG8_MMA(0, 0, At, B0); PG8_BAR; PG8_SCHED;
            PG8_LDB(B1, 1, 1); PG8_STAGE(PG8_SB(1, 0), b3, voffB);
            PG8_BAR; PG8_WAIT_L(0); PG8_MMA(0, 1, At, B1); PG8_BAR;
            PG8_LDA(At, 1, 1); PG8_STAGE(PG8_SA(1, 0), a3, voffA);
            PG8_BAR; PG8_WAIT_L(0); PG8_MMA(1, 0, At, B0); PG8_BAR; PG8_SCHED;
            PG8_STAGE(PG8_SB(1, 1), b3 + hstep, voffB);
            PG8_WAIT_V(6); PG8_BAR; PG8_MMA(1, 1, At, B1); PG8_BAR;
            }
        }
        if constexpr (ALIGN_EPI) { if (wr == 0) PG8_BAR; }
        E(acc, cur, wr, wc, fr, fq);
        if (!has_next) break;
#pragma unroll
        for (int a = 0; a < 2; ++a)
#pragma unroll
            for (int b = 0; b < 2; ++b)
#pragma unroll
                for (int m = 0; m < 4; ++m)
#pragma unroll
                    for (int n = 0; n < 2; ++n) acc[a][b][m][n] = (f32x4){0.f, 0.f, 0.f, 0.f};
        cur = nxt; cA = nA; cB = nB; ++ui;
        if constexpr (ALIGN_EPI) { if (wr == 1) PG8_BAR; }
    }
    PG8_WAIT_V(0);
    if constexpr (!ALIGN_EPI) { if (wr == 0) PG8_BAR; }
    PG8_BAR;
#undef PG8_SA
#undef PG8_SB
#undef PG8_STAGE
#undef PG8_LDA
#undef PG8_LDB
#undef PG8_MMA
#undef PG8_WAIT_V
#undef PG8_WAIT_L
#undef PG8_BAR
#undef PG8_SCHED
}
}

namespace att {
constexpr int D = 128, NW = 8, QBLK = 32, KVBLK = 64;
constexpr float SCALE = 0.088388347648318440f;
constexpr float INV_SCALE = 11.313708498984761f;
constexpr float THR = 8.f;
constexpr float NEG = -1e30f;
constexpr size_t SHM_V = KVBLK * D * 2, SHM_K = KVBLK * D * 2, SHM_ATTN = 2 * SHM_V + 2 * SHM_K + NW * 64 * 4;
constexpr int BIAS_OFF = (int)SHM_ATTN;
enum { DENSE = 0, NA = 1, SW = 2 };
#define KSWZ(row, colB) ((row) * 256 + ((colB) ^ (((row) & 7) << 4)))
#define SBAR() __builtin_amdgcn_sched_barrier(0)
__device__ __forceinline__ int crow(int r, int hi) { return (r & 3) + 8 * (r >> 2) + 4 * hi; }

__device__ __forceinline__ void partialSM(f32x16& p0, f32x16& p1, float& m_reg, float& mn, float& alpha) {
  constexpr float C = SCALE * 1.4426950408889634f;
  float pmax = p0[0];
#pragma unroll
  for (int r = 1; r < 16; ++r) pmax = fmaxf(pmax, p0[r]);
#pragma unroll
  for (int r = 0; r < 16; ++r) pmax = fmaxf(pmax, p1[r]);
  { auto rr = __builtin_amdgcn_permlane32_swap(__float_as_uint(pmax), __float_as_uint(pmax), false, false);
    pmax = fmaxf(__uint_as_float(rr[0]), __uint_as_float(rr[1])); }
  if (__builtin_expect(__all(pmax - m_reg <= THR / SCALE), 1)) { mn = m_reg; alpha = 1.f; }
  else { mn = fmaxf(m_reg, pmax); alpha = __builtin_amdgcn_exp2f((m_reg - mn) * C); m_reg = mn; }
  float mnC = -mn * C;
#pragma unroll
  for (int r = 0; r < 16; ++r) p0[r] = fmaf(p0[r], C, mnC);
#pragma unroll
  for (int r = 0; r < 16; ++r) p1[r] = fmaf(p1[r], C, mnC);
#pragma unroll
  for (int r = 0; r < 16; ++r) p0[r] = __builtin_amdgcn_exp2f(p0[r]);
}
__device__ __forceinline__ void finishSM(f32x16& p0, f32x16& p1, float alpha, float& l_reg, bf16x8& pa0, bf16x8& pa1, bf16x8& pa2, bf16x8& pa3) {
#pragma unroll
  for (int r = 0; r < 16; ++r) p1[r] = __builtin_amdgcn_exp2f(p1[r]);
  float ps = 0;
#pragma unroll
  for (int r = 0; r < 16; ++r) ps += p0[r];
#pragma unroll
  for (int r = 0; r < 16; ++r) ps += p1[r];
  { auto rr = __builtin_amdgcn_permlane32_swap(__float_as_uint(ps), __float_as_uint(ps), false, false);
    ps = __uint_as_float(rr[0]) + __uint_as_float(rr[1]); }
  l_reg = l_reg * alpha + ps;
#define PK4(P, BASE, OUT) do { unsigned a0 = cvt_pk_bf16(P[BASE + 0], P[BASE + 1]), a1 = cvt_pk_bf16(P[BASE + 2], P[BASE + 3]);   \
    unsigned b0 = cvt_pk_bf16(P[BASE + 4], P[BASE + 5]), b1 = cvt_pk_bf16(P[BASE + 6], P[BASE + 7]);                              \
    auto r0 = __builtin_amdgcn_permlane32_swap(a0, b0, false, false); auto r1 = __builtin_amdgcn_permlane32_swap(a1, b1, false, false); \
    u32x4 w = {r0[0], r1[0], r0[1], r1[1]}; OUT = *reinterpret_cast<bf16x8*>(&w); } while (0)
  PK4(p0, 0, pa0); PK4(p0, 8, pa1); PK4(p1, 0, pa2); PK4(p1, 8, pa3);
#undef PK4
}
__device__ __forceinline__ void qkt(f32x16& p0, f32x16& p1, const bf16_t* Ks, const bf16x8* qr, int r32, int hi) {
  p0 = f32x16{}; p1 = f32x16{};
#pragma unroll
  for (int d0 = 0; d0 < 8; ++d0) { int cb = (d0 * 16 + hi * 8) * 2;
    bf16x8 b0 = *reinterpret_cast<const bf16x8*>((const char*)Ks + KSWZ(r32, cb));
    bf16x8 b1 = *reinterpret_cast<const bf16x8*>((const char*)Ks + KSWZ(32 + r32, cb));
    p0 = __builtin_amdgcn_mfma_f32_32x32x16_bf16(b0, qr[d0], p0, 0, 0, 0);
    p1 = __builtin_amdgcn_mfma_f32_32x32x16_bf16(b1, qr[d0], p1, 0, 0, 0); }
}
__device__ __forceinline__ int v_st(int k, int c) { const int kk = (k & ~0xC) | ((k & 4) << 1) | ((k & 8) >> 1); return ((kk >> 3) * 4 + (c >> 5)) * 512 + ((kk & 7) * 32 + (c & 31)) * 2; }
__device__ __forceinline__ int v_rd_base(int lane) { return ((lane & 3) << 3) | (((lane >> 2) & 3) << 6) | (((lane >> 4) & 1) << 5) | (((lane >> 5) & 1) << 8); }
constexpr int v_rd_off(int d0, int ks, int half) { return d0 * 512 + ks * 4096 + half * 2048; }
template <int OFF> __device__ __forceinline__ s16x4 tr_read(int vb) {
  s16x4 r; asm volatile("ds_read_b64_tr_b16 %0, %1 offset:%2" : "=&v"(r) : "v"(vb), "i"(OFF) : "memory"); return r;
}
template <int D0> __device__ __forceinline__ void pv_one(f32x16& od, int vb, bf16x8 pa0, bf16x8 pa1, bf16x8 pa2, bf16x8 pa3) {
  const s16x4 l0 = tr_read<v_rd_off(D0, 0, 0)>(vb), h0 = tr_read<v_rd_off(D0, 0, 1)>(vb), l1 = tr_read<v_rd_off(D0, 1, 0)>(vb), h1 = tr_read<v_rd_off(D0, 1, 1)>(vb);
  const s16x4 l2 = tr_read<v_rd_off(D0, 2, 0)>(vb), h2 = tr_read<v_rd_off(D0, 2, 1)>(vb), l3 = tr_read<v_rd_off(D0, 3, 0)>(vb), h3 = tr_read<v_rd_off(D0, 3, 1)>(vb);
  asm volatile("s_waitcnt lgkmcnt(0)" ::: "memory"); SBAR();
#define PK(L, H) (bf16x8){L[0], L[1], L[2], L[3], H[0], H[1], H[2], H[3]}
  od = __builtin_amdgcn_mfma_f32_32x32x16_bf16(pa0, PK(l0, h0), od, 0, 0, 0);
  od = __builtin_amdgcn_mfma_f32_32x32x16_bf16(pa1, PK(l1, h1), od, 0, 0, 0);
  od = __builtin_amdgcn_mfma_f32_32x32x16_bf16(pa2, PK(l2, h2), od, 0, 0, 0);
  od = __builtin_amdgcn_mfma_f32_32x32x16_bf16(pa3, PK(l3, h3), od, 0, 0, 0);
#undef PK
}
__device__ __forceinline__ void pv_d0(f32x16* o, int vb, bf16x8 pa0, bf16x8 pa1, bf16x8 pa2, bf16x8 pa3) {
  pv_one<0>(o[0], vb, pa0, pa1, pa2, pa3); pv_one<1>(o[1], vb, pa0, pa1, pa2, pa3); pv_one<2>(o[2], vb, pa0, pa1, pa2, pa3); pv_one<3>(o[3], vb, pa0, pa1, pa2, pa3);
}

struct UnitP { const bf16_t* Q; const bf16_t* K; const bf16_t* V; bf16_t* O; int ldq, ldk, ldo, NT, base_row, qb; float sink_l2e; };

template <int MODE> __device__ __forceinline__ int tile_row0(const UnitP& u, int t) {
  if (MODE == DENSE) return u.base_row + KVBLK * t;
  if (t < 4) return SEQ + KVBLK * t;
  if (MODE == NA) { int R0 = 4 * u.qb - 4; R0 = R0 < 0 ? 0 : (R0 > 120 ? 120 : R0); int kr = R0 + t - 4; kr = kr > 127 ? 127 : kr; return kr * 64; }
  int k0 = 256 * u.qb - 128 + 64 * (t - 4); k0 = k0 < 0 ? 0 : (k0 > SEQ - 64 ? SEQ - 64 : k0); return k0;
}
template <int MODE> __device__ __forceinline__ void mask_tile(f32x16& p0, f32x16& p1, const UnitP& u, int t, int wid, int r32, int hi, const float* biasL) {
  if (MODE == DENSE) return;
  if (t < 4) return;
  if (MODE == SW) {
    const int kpos0 = 256 * u.qb - 128 + 64 * (t - 4); int qpos = 256 * u.qb + wid * 32 + r32; int hi_ = hi;
    asm volatile("" : "+v"(qpos), "+v"(hi_));
#pragma unroll
    for (int r = 0; r < 16; ++r) { const int k0 = kpos0 + crow(r, hi_), k1 = k0 + 32; const int d0 = k0 - qpos, d1 = k1 - qpos;
      const bool v0 = (k0 >= 0) && (k0 < SEQ) && (d0 <= 128) && (d0 >= -128); const bool v1 = (k1 >= 0) && (k1 < SEQ) && (d1 <= 128) && (d1 >= -128);
      p0[r] = v0 ? p0[r] : NEG; p1[r] = v1 ? p1[r] : NEG; }
  } else {
    int R0 = 4 * u.qb - 4; R0 = R0 < 0 ? 0 : (R0 > 120 ? 120 : R0); const int kr = R0 + t - 4;
    const int rq = 4 * u.qb + (wid >> 1); int rs = rq - 4; rs = rs < 0 ? 0 : (rs > 120 ? 120 : rs);
    const bool rowvalid = (kr >= rs) && (kr < rs + 8);
    if (!rowvalid) {
#pragma unroll
      for (int r = 0; r < 16; ++r) { p0[r] = NEG; p1[r] = NEG; }
      return; }
    int cq = (wid & 1) * 32 + r32; int hi_ = hi;
    asm volatile("" : "+v"(cq), "+v"(hi_));
    int cs = cq - 8; cs = cs < 0 ? 0 : (cs > 48 ? 48 : cs);
    int brow = kr - rq + 7; brow = brow < 0 ? 0 : (brow > 14 ? 14 : brow);
    const float* bl = biasL + brow * 31 + 15 - cq;
#pragma unroll
    for (int r = 0; r < 16; ++r) { const int k0 = crow(r, hi_), k1 = k0 + 32;
      const bool v0 = rowvalid && (k0 >= cs) && (k0 < cs + 16); const bool v1 = rowvalid && (k1 >= cs) && (k1 < cs + 16);
      int i0 = k0 - cq; i0 = i0 < -15 ? -15 : (i0 > 15 ? 15 : i0); int i1 = k1 - cq; i1 = i1 < -15 ? -15 : (i1 > 15 ? 15 : i1);
      const float b0 = bl[cq + i0], b1 = bl[cq + i1];
      p0[r] = v0 ? p0[r] + b0 : NEG; p1[r] = v1 ? p1[r] + b1 : NEG;
      SBAR(); }
  }
}

template <int MODE, int SDEPTH>
__device__ __forceinline__ void attn_unit(const UnitP& u, char* lds) {
  const int tid = TID(), wid = tid >> 6, lane = tid & 63, r32 = lane & 31, hi = lane >> 5;
  bf16_t* V_lds = (bf16_t*)lds; bf16_t* K_lds = (bf16_t*)(lds + 2 * SHM_V);
  float* ws = (float*)(lds + 2 * SHM_V + 2 * SHM_K) + wid * 64; float* li_l = ws; float* al_l = ws + 32;
  const float* biasL = (const float*)(lds + BIAS_OFF);
  const bf16_t* __restrict__ Kh = u.K; const bf16_t* __restrict__ Vh = u.V; const int LDK = u.ldk;
  float m_reg = -1e30f, l_reg = 0; f32x16 o[4] = {}; bf16x8 qr[8];
  const bf16_t* Qw = u.Q + (long)(wid * QBLK + r32) * u.ldq + hi * 8;
#pragma unroll
  for (int d0 = 0; d0 < 8; ++d0) qr[d0] = *reinterpret_cast<const bf16x8*>(Qw + d0 * 16);
  const int vb0 = (int)(uintptr_t)V_lds + v_rd_base(lane);
  struct { bf16x8 vs0, vs1, ks0, ks1; } sr_[SDEPTH];
#define SLOAD(i, k0) do { int t_ = tid; if (MODE != DENSE) asm volatile("" : "+v"(t_)); const int sr = t_ >> 4, sc = (t_ & 15) * 8; \
    const long _r0 = (long)((k0) + sr) * LDK + sc, _r1 = (long)((k0) + 32 + sr) * LDK + sc; \
    sr_[i].vs0 = *reinterpret_cast<const bf16x8*>(&Vh[_r0]); sr_[i].vs1 = *reinterpret_cast<const bf16x8*>(&Vh[_r1]); \
    sr_[i].ks0 = *reinterpret_cast<const bf16x8*>(&Kh[_r0]); sr_[i].ks1 = *reinterpret_cast<const bf16x8*>(&Kh[_r1]); } while (0)
#define SWRITE(b, i) do { int t_ = tid; if (MODE != DENSE) asm volatile("" : "+v"(t_)); const int sr = t_ >> 4, sc = (t_ & 15) * 8, vst0 = v_st(sr, sc), vst1 = v_st(32 + sr, sc); \
    *(bf16x8*)((char*)V_lds + (b) * SHM_V + vst0) = sr_[i].vs0;          \
    *(bf16x8*)((char*)V_lds + (b) * SHM_V + vst1) = sr_[i].vs1; int kc = sc * 2;               \
    *(bf16x8*)((char*)K_lds + (b) * SHM_K + KSWZ(sr, kc)) = sr_[i].ks0;                       \
    *(bf16x8*)((char*)K_lds + (b) * SHM_K + KSWZ(32 + sr, kc)) = sr_[i].ks1; } while (0)
#define SWAIT() do { if constexpr (SDEPTH == 2) asm volatile("s_waitcnt vmcnt(4)" ::: "memory"); else asm volatile("s_waitcnt vmcnt(0)" ::: "memory"); } while (0)
#define RESC(a) do { if (__any((a) < 1.f)) { if (hi == 0) al_l[r32] = (a); asm volatile("s_waitcnt lgkmcnt(0)" ::: "memory"); \
    _Pragma("unroll") for (int d = 0; d < 4; ++d) _Pragma("unroll") for (int r = 0; r < 16; ++r) o[d][r] *= al_l[crow(r, hi)]; } } while (0)
#define ROW0(t) tile_row0<MODE>(u, (t))
  f32x16 pA0, pA1, pB0, pB1; float mnA, mnB, alA, alB; bf16x8 pa0, pa1, pa2, pa3; const int NT = u.NT;
  constexpr int SE = 0, SO = SDEPTH - 1;
  SLOAD(SE, ROW0(0)); asm volatile("s_waitcnt vmcnt(0)" ::: "memory"); SWRITE(0, SE); __syncthreads();
  qkt(pA0, pA1, K_lds, qr, r32, hi); mask_tile<MODE>(pA0, pA1, u, 0, wid, r32, hi, biasL); partialSM(pA0, pA1, m_reg, mnA, alA);
  SLOAD(SO, ROW0(1)); if constexpr (SDEPTH == 2) { if (2 < NT) SLOAD(SE, ROW0(2)); }
  SWAIT(); SWRITE(1, SO); __syncthreads();
  for (int j = 1; j + 1 < NT; j += 2) {
    SBAR(); qkt(pB0, pB1, (bf16_t*)((char*)K_lds + SHM_K), qr, r32, hi);
    finishSM(pA0, pA1, alA, l_reg, pa0, pa1, pa2, pa3); SBAR();
    SLOAD(SO, ROW0(j + SDEPTH)); SBAR();
    pv_d0(o, vb0, pa0, pa1, pa2, pa3); mask_tile<MODE>(pB0, pB1, u, j, wid, r32, hi, biasL); partialSM(pB0, pB1, m_reg, mnB, alB);
    __syncthreads(); SWAIT(); SWRITE(0, SE);
    RESC(alB); __syncthreads();
    SBAR(); qkt(pA0, pA1, K_lds, qr, r32, hi);
    finishSM(pB0, pB1, alB, l_reg, pa0, pa1, pa2, pa3); SBAR();
    if (SDEPTH == 1 || j + 3 < NT) SLOAD(SE, ROW0(j + 1 + SDEPTH)); SBAR();
    pv_d0(o, vb0 + (int)SHM_V, pa0, pa1, pa2, pa3); mask_tile<MODE>(pA0, pA1, u, j + 1, wid, r32, hi, biasL); partialSM(pA0, pA1, m_reg, mnA, alA);
    __syncthreads(); SWAIT(); SWRITE(1, SO);
    RESC(alA); __syncthreads();
  }
  SBAR(); qkt(pB0, pB1, (bf16_t*)((char*)K_lds + SHM_K), qr, r32, hi);
  finishSM(pA0, pA1, alA, l_reg, pa0, pa1, pa2, pa3); SBAR();
  pv_d0(o, vb0, pa0, pa1, pa2, pa3); mask_tile<MODE>(pB0, pB1, u, NT - 1, wid, r32, hi, biasL); partialSM(pB0, pB1, m_reg, mnB, alB);
  __syncthreads(); RESC(alB);
  finishSM(pB0, pB1, alB, l_reg, pa0, pa1, pa2, pa3); SBAR();
  pv_d0(o, vb0 + (int)SHM_V, pa0, pa1, pa2, pa3);
  l_reg += __builtin_amdgcn_exp2f(u.sink_l2e - m_reg * (SCALE * 1.4426950408889634f));
  if (hi == 0) li_l[r32] = l_reg; asm volatile("s_waitcnt lgkmcnt(0)" ::: "memory");
  float rli[16];
#pragma unroll
  for (int r = 0; r < 16; ++r) rli[r] = __builtin_amdgcn_rcpf(li_l[crow(r, hi)]);
  bf16_t* Ow = u.O + (long)(wid * QBLK) * u.ldo;
#pragma unroll
  for (int r = 0; r < 16; ++r) { int orow = crow(r, hi);
#pragma unroll
    for (int d0 = 0; d0 < 4; ++d0) { const float v = o[d0][r] * rli[r]; Ow[(long)orow * u.ldo + d0 * 32 + r32] = (bf16_t)(cvt_pk_bf16(v, v) & 0xffffu); } }
  __syncthreads();
#undef SLOAD
#undef SWRITE
#undef SWAIT
#undef RESC
#undef ROW0
}
#undef KSWZ
#undef SBAR
}

struct Args { const float* in[22]; float* out; unsigned char* ws; int ph_lo, ph_hi; };
enum { I_X = 0, I_C, I_CTX, I_CCTX, I_ADAW, I_ADAB, I_NORMG, I_WG, I_WU, I_WD, I_ABIN, I_ABOUT, I_NAQG, I_NAKG, I_NABIAS, I_SWQG, I_SWKG, I_SINK, I_GIN, I_GOUT, I_GQG, I_GKG };

__device__ __forceinline__ unsigned f2bf(float f) { unsigned u = __builtin_bit_cast(unsigned, f); return (u + 0x7fffu + ((u >> 16) & 1u)) >> 16; }
__device__ __forceinline__ unsigned pk2(float lo, float hi) { return f2bf(lo) | (f2bf(hi) << 16); }
__device__ __forceinline__ void transpose_item(const float* __restrict__ W, int K, int N, bf16_t* WT, int mode, LAS float* scr, int item, int lane) {
    const int nblk = N / 32, kb = item / nblk, nb = item % nblk, k0 = 64 * kb, n0 = 32 * nb;
#pragma unroll 8
    for (int i = 0; i < 32; ++i) { const int kk = 2 * i + (lane >> 5); scr[kk * 33 + (lane & 31)] = W[(size_t)(k0 + kk) * N + n0 + (lane & 31)]; }
    asm volatile("s_waitcnt lgkmcnt(0)" ::: "memory");
    const int c = lane & 7;
    const int rbase = (mode == 0) ? n0 : ((n0 >> 7) * 256 + (n0 & 127) + (mode == 2 ? 128 : 0));
#pragma unroll
    for (int j = 0; j < 4; ++j) { const int n = (lane >> 3) + 8 * j; const LAS float* s = scr + (8 * c) * 33 + n;
        u32x4 o; o.x = pk2(s[0 * 33], s[1 * 33]); o.y = pk2(s[2 * 33], s[3 * 33]); o.z = pk2(s[4 * 33], s[5 * 33]); o.w = pk2(s[6 * 33], s[7 * 33]);
        *(u32x4*)(WT + (size_t)(rbase + n) * K + k0 + 8 * c) = o; }
    asm volatile("s_waitcnt lgkmcnt(0)" ::: "memory");
}
__device__ __forceinline__ void phase0(const Args& a, unsigned char* lds_g, int G) {
    const int tid = TID(), lane = tid & 63, wave = tid >> 6; const int bid = BID();
    float* sc = (float*)lds_g;
    float* red = sc + 4096;
    for (int i = tid; i < DM; i += 512) { const float c = a.in[I_C][i]; sc[i] = c / (1.0f + __expf(-c)); const float cc = a.in[I_CCTX][i]; sc[DM + i] = cc / (1.0f + __expf(-cc)); }
    __syncthreads();
    float* mod = (float*)(a.ws + WS_MOD);
    for (int unit = bid; unit < 256; unit += G) {
        const int layer = unit >> 7, col0 = (unit & 127) * 144;
        f32x4 a1 = {0.f, 0.f, 0.f, 0.f}, a2 = {0.f, 0.f, 0.f, 0.f};
        if (lane < 36) {
            const float* W = a.in[I_ADAW] + (size_t)layer * DM * NMODV + col0 + 4 * lane;
            for (int k = wave * 256; k < wave * 256 + 256; k += 8) {
                f32x4 w[8];
#pragma unroll
                for (int q = 0; q < 8; ++q) w[q] = __builtin_nontemporal_load((const f32x4*)(W + (size_t)(k + q) * NMODV));
#pragma unroll
                for (int q = 0; q < 8; ++q) { a1 += w[q] * sc[k + q]; a2 += w[q] * sc[DM + k + q]; }
            }
#pragma unroll
            for (int e = 0; e < 4; ++e) { red[(wave * 2 + 0) * 144 + 4 * lane + e] = a1[e]; red[(wave * 2 + 1) * 144 + 4 * lane + e] = a2[e]; }
        }
        __syncthreads();
        if (tid < 288) { const int v = tid / 144, j = tid % 144; float s = a.in[I_ADAB][layer * NMODV + col0 + j];
#pragma unroll
            for (int w = 0; w < 8; ++w) s += red[(w * 2 + v) * 144 + j];
            mod[(size_t)(layer * 2 + v) * NMODV + col0 + j] = s; }
        __syncthreads();
    }
    LAS float* scr = (LAS float*)((LAS unsigned char*)lds_g + wave * 16384);
    const int gw = bid * 8 + wave, NGW = G * 8;
    constexpr int I_GU1 = (DM / 64) * (FF / 32);
    constexpr int I_D1 = (FF / 64) * (DM / 32);
    constexpr int I_GU = 8 * I_GU1, I_D = 4 * I_D1, I_ABI = (DM / 64) * (AB_IN / 32), I_SQ = (DM / 64) * (DM / 32), I_GI = (DM / 64) * (C_IN / 32);
    constexpr int NITEMS = I_GU + I_D + I_ABI + I_SQ + I_GI + I_SQ;
    bf16_t* wgu = (bf16_t*)(a.ws + WS_WGU); bf16_t* wd = (bf16_t*)(a.ws + WS_WD);
    for (int it = gw; it < NITEMS; it += NGW) {
        int r = it;
        if (r < I_GU) { const int q = r / I_GU1, lf = q >> 1, gu = q & 1; r -= q * I_GU1;
            transpose_item((gu ? a.in[I_WU] : a.in[I_WG]) + (size_t)lf * DM * FF, DM, FF, wgu + (size_t)lf * WGU_ELEMS, 1 + gu, scr, r, lane); continue; }
        r -= I_GU;
        if (r < I_D) { const int lf = r / I_D1; r -= lf * I_D1; transpose_item(a.in[I_WD] + (size_t)lf * FF * DM, FF, DM, wd + (size_t)lf * WD_ELEMS, 0, scr, r, lane); continue; }
        r -= I_D;
        if (r < I_ABI) { transpose_item(a.in[I_ABIN], DM, AB_IN, (bf16_t*)(a.ws + WS_WABIN), 0, scr, r, lane); continue; }
        r -= I_ABI;
        if (r < I_SQ) { transpose_item(a.in[I_ABOUT], DM, DM, (bf16_t*)(a.ws + WS_WABOUT), 0, scr, r, lane); continue; }
        r -= I_SQ;
        if (r < I_GI) { transpose_item(a.in[I_GIN], DM, C_IN, (bf16_t*)(a.ws + WS_WGIN), 0, scr, r, lane); continue; }
        r -= I_GI;
        transpose_item(a.in[I_GOUT], DM, DM, (bf16_t*)(a.ws + WS_WGOUT), 0, scr, r, lane);
    }
}

__device__ __forceinline__ void modulate_phase(const float* xsrc, float* xcopy, const float* csrc, float* cdst, const float* part, int nsplit, const float* cgate, float ccoef,
                                               const float* g, const float* shift_l, const float* scale_l, const float* shift_c, const float* scale_c, bf16_t* h, int nrows, int G) {
    const int tid = TID(), lane = tid & 63, wave = tid >> 6;
    const int gw = BID() * 8 + wave, NGW = G * 8;
    for (int row = gw; row < nrows; row += NGW) {
        const bool isctx = row >= SEQ;
        f32x4 v[8];
        if (!isctx) {
            const f32x4* xr = (const f32x4*)(xsrc + (size_t)row * DM) + lane;
#pragma unroll
            for (int j = 0; j < 8; ++j) v[j] = xr[64 * j];
            if (xcopy) { f32x4* xo = (f32x4*)(xcopy + (size_t)row * DM) + lane;
#pragma unroll
                for (int j = 0; j < 8; ++j) xo[64 * j] = v[j]; }
        } else {
            const int r = row - SEQ;
            const f32x4* xr = (const f32x4*)(csrc + (size_t)r * DM) + lane;
#pragma unroll
            for (int j = 0; j < 8; ++j) v[j] = xr[64 * j];
            if (nsplit > 0) {
                f32x4 s[8];
#pragma unroll
                for (int j = 0; j < 8; ++j) s[j] = (f32x4){0.f, 0.f, 0.f, 0.f};
                for (int sp = 0; sp < nsplit; ++sp) { const f32x4* pr = (const f32x4*)(part + ((size_t)sp * 256 + r) * DM) + lane;
#pragma unroll
                    for (int j = 0; j < 8; ++j) s[j] += pr[64 * j]; }
#pragma unroll
                for (int j = 0; j < 8; ++j) { const f32x4 gt = *((const f32x4*)cgate + lane + 64 * j); v[j] += ccoef * gt * s[j]; }
            }
            if (cdst) { f32x4* xo = (f32x4*)(cdst + (size_t)r * DM) + lane;
#pragma unroll
                for (int j = 0; j < 8; ++j) xo[64 * j] = v[j]; }
        }
        float ss = 0.f;
#pragma unroll
        for (int j = 0; j < 8; ++j) ss += (v[j].x * v[j].x + v[j].y * v[j].y) + (v[j].z * v[j].z + v[j].w * v[j].w);
        const float rstd = 1.0f / sqrtf(wave_sum(ss) * (1.0f / DM) + EPS);
        const f32x4* sh = (const f32x4*)(isctx ? shift_c : shift_l) + lane; const f32x4* scl = (const f32x4*)(isctx ? scale_c : scale_l) + lane;
        const f32x4* gg = (const f32x4*)g + lane;
        u32x2* ho = (u32x2*)(h + (size_t)row * DM) + lane;
#pragma unroll
        for (int j = 0; j < 8; ++j) { const f32x4 y = (v[j] * rstd) * gg[64 * j]; const f32x4 z = y * (scl[64 * j] + 1.0f) + sh[64 * j];
            u32x2 w; w.x = cvt_pk_bf16(z.x, z.y); w.y = cvt_pk_bf16(z.z, z.w); ho[64 * j] = w; }
    }
}

__device__ __forceinline__ void qknorm_phase(const Args& a, int layer, int G) {
    const int tid = TID(), lane = tid & 63, wave = tid >> 6, hw = lane >> 5, l5 = lane & 31;
    const int gw = BID() * 8 + wave, NGW = G * 8;
    bf16_t* P = (bf16_t*)(a.ws + WS_P); const int ld = layer == 0 ? AB_IN : C_IN;
    const int npairs = layer == 0 ? 13 : 10;
    const int d0 = 2 * l5, d1 = d0 + 1;
    const float inv0 = exp2f(-(float)(d0 & 31) * (13.287712379549449f / 32.0f)), inv1 = exp2f(-(float)(d1 & 31) * (13.287712379549449f / 32.0f));
    for (int row = gw; row < MT; row += NGW) {
        const bool isctx = row >= SEQ;
        const float pos = (l5 < 16) ? (float)(row >> 6) : (float)(row & 63);
        float c0 = 1.f, s0 = 0.f, c1 = 1.f, s1 = 0.f;
        if (!isctx) { float rv0 = pos * inv0 * 0.15915494309189535f, rv1 = pos * inv1 * 0.15915494309189535f; rv0 -= floorf(rv0); rv1 -= floorf(rv1);
            s0 = __builtin_amdgcn_sinf(rv0); c0 = __builtin_amdgcn_cosf(rv0); s1 = __builtin_amdgcn_sinf(rv1); c1 = __builtin_amdgcn_cosf(rv1); }
        bf16_t* prow = P + (size_t)row * ld;
        for (int it = 0; it < npairs; ++it) {
            int slot = 2 * it + hw; const float* gain; bool rope;
            if (layer == 0) { if (slot >= 24) slot += 8;
                if (slot < 8) { gain = a.in[I_NAQG]; rope = false; } else if (slot < 16) { gain = a.in[I_SWQG]; rope = true; }
                else if (slot < 24) { gain = a.in[I_NAKG]; rope = false; } else { gain = a.in[I_SWKG]; rope = true; } }
            else { if (slot < 16) gain = a.in[I_GQG]; else gain = a.in[I_GKG]; rope = true; }
            unsigned* p1 = (unsigned*)(prow + slot * 128 + d0); unsigned* p2 = (unsigned*)(prow + slot * 128 + 64 + d0);
            const unsigned w1 = *p1, w2 = *p2;
            float x10 = __uint_as_float(w1 << 16), x11 = __uint_as_float(w1 & 0xffff0000u), x20 = __uint_as_float(w2 << 16), x21 = __uint_as_float(w2 & 0xffff0000u);
            float ss = x10 * x10 + x11 * x11 + x20 * x20 + x21 * x21;
#pragma unroll
            for (int o = 1; o < 32; o <<= 1) ss += __shfl_xor(ss, o);
            const float rstd = 1.0f / sqrtf(ss * (1.0f / 128.0f) + EPS);
            x10 = x10 * rstd * gain[d0]; x11 = x11 * rstd * gain[d1]; x20 = x20 * rstd * gain[64 + d0]; x21 = x21 * rstd * gain[64 + d1];
            float y10 = x10, y11 = x11, y20 = x20, y21 = x21;
            if (rope && !isctx) { y10 = x10 * c0 - x20 * s0; y20 = x10 * s0 + x20 * c0; y11 = x11 * c1 - x21 * s1; y21 = x11 * s1 + x21 * c1; }
            *p1 = cvt_pk_bf16(y10, y11); *p2 = cvt_pk_bf16(y20, y21);
        }
    }
}

__device__ __forceinline__ void attn_phase0(const Args& a, unsigned char* lds_g, int G) {
    bf16_t* P = (bf16_t*)(a.ws + WS_P); bf16_t* O = (bf16_t*)(a.ws + WS_O);
    float* biasL = (float*)(lds_g + att::BIAS_OFF);
    const int tid0 = TID();
    for (int un = BID(); un < 528; un += G) {
        att::UnitP u; u.ldq = AB_IN; u.ldk = AB_IN; u.ldo = DM; u.sink_l2e = -INFINITY;
        if (un < 256) {
            const int h = un & 7, qb = un >> 3;
            for (int i = tid0; i < 465; i += 512) biasL[i] = a.in[I_NABIAS][h * 465 + i] * att::INV_SCALE;
            __syncthreads();
            u.Q = P + (size_t)(256 * qb) * AB_IN + h * 128; u.K = P + (16 + h) * 128; u.V = P + (24 + h) * 128; u.O = O + (size_t)(256 * qb) * DM + h * 128;
            u.NT = 16; u.base_row = 0; u.qb = qb;
            att::attn_unit<att::NA, 1>(u, (char*)lds_g);
        } else if (un < 512) {
            const int hq = (un - 256) & 7, qb = (un - 256) >> 3, kvh = hq >> 2;
            u.Q = P + (size_t)(256 * qb) * AB_IN + (8 + hq) * 128; u.K = P + (32 + kvh) * 128; u.V = P + (34 + kvh) * 128; u.O = O + (size_t)(256 * qb) * DM + (8 + hq) * 128;
            u.NT = 12; u.base_row = 0; u.qb = qb; u.sink_l2e = a.in[I_SINK][hq] * 1.4426950408889634f;
            att::attn_unit<att::SW, 1>(u, (char*)lds_g);
        } else {
            const int hh = un - 512;
            u.Q = P + (size_t)SEQ * AB_IN + hh * 128; u.O = O + (size_t)SEQ * DM + hh * 128;
            const bool nah = hh < 8; const int hq = nah ? 0 : hh - 8, kvh = hq >> 2;
            const int kslot = nah ? 16 + hh : 32 + kvh, vslot = nah ? 24 + hh : 34 + kvh;
            u.K = P + kslot * 128; u.V = P + vslot * 128;
            const float sk = a.in[I_SINK][hq] * 1.4426950408889634f; u.sink_l2e = nah ? -INFINITY : sk;
            u.NT = 4; u.base_row = SEQ; u.qb = 0;
            att::attn_unit<att::DENSE, 2>(u, (char*)lds_g);
        }
    }
}
__device__ __forceinline__ void attn_phase1(const Args& a, unsigned char* lds_g, int G) {
    bf16_t* P = (bf16_t*)(a.ws + WS_P); bf16_t* O = (bf16_t*)(a.ws + WS_O);
    const int bid = BID();
    for (int i = 0;; ++i) {
        int un;
        if ((G & 7) == 0) { const int x = bid & 7, j = (bid >> 3) + i * (G >> 3); if (j >= 64) break; un = x * 64 + j; }
        else { un = bid + i * G; if (un >= 512) break; }
        const int h = un >> 5, qb = un & 31, kvh = h >> 2;
        att::UnitP u; u.ldq = C_IN; u.ldk = C_IN; u.ldo = DM; u.sink_l2e = -INFINITY;
        u.Q = P + (size_t)(256 * qb) * C_IN + h * 128; u.K = P + (16 + kvh) * 128; u.V = P + (20 + kvh) * 128; u.O = O + (size_t)(256 * qb) * DM + h * 128;
        u.NT = MT / 64; u.base_row = 0; u.qb = qb;
        att::attn_unit<att::DENSE, 2>(u, (char*)lds_g);
    }
}

#define XB_TMO      128
#define XB_XCNT(j)  (256  + 64 * (j))
#define XB_XSUB(j)  (1280 + 64 * (j))
#define XB_XGEN(j)  (2304 + 64 * (j))
#define XB_TOP      3328
#define XB_TOPGEN   3392
#define XCD_BAR_WORDS 3456
#define XB_SPIN_CAP (1u << 18)
__device__ __forceinline__ unsigned xb_ld(unsigned* p)              { return __hip_atomic_load(p, __ATOMIC_RELAXED, __HIP_MEMORY_SCOPE_AGENT); }
__device__ __forceinline__ unsigned xb_add(unsigned* p, unsigned v) { return __hip_atomic_fetch_add(p, v, __ATOMIC_RELAXED, __HIP_MEMORY_SCOPE_AGENT); }
__device__ __forceinline__ unsigned xb_xcc_id() { return (unsigned)__builtin_amdgcn_s_getreg((3 << 11) | 20) & 0xFu; }
#define XB_SPIN(cond, bar) do { unsigned _sp = 0; while (cond) { __builtin_amdgcn_s_sleep(1); \
    if ((++_sp & 255u) == 0u) { if (xb_ld(&(bar)[XB_TMO])) break; if (_sp > XB_SPIN_CAP) { atomicAdd(&(bar)[XB_TMO], 1u); break; } } } } while (0)
struct XcdBarrier { unsigned* bar; unsigned x; volatile LAS unsigned* st; };
__device__ __forceinline__ XcdBarrier xcd_barrier_post(unsigned* bar, volatile LAS unsigned* st) {
    XcdBarrier b; b.bar = bar; b.x = xb_xcc_id(); b.st = st;
    if (threadIdx.x == 0) (void)xb_add(&bar[XB_XCNT(b.x)], 1u);
    return b;
}
__device__ __forceinline__ void xcd_barrier_complete(unsigned* bar, unsigned x, unsigned& nloc, unsigned& nx) {
    const unsigned G = gridDim.x * gridDim.y * gridDim.z;
    unsigned sum, cnt, mine, sp = 0u;
    for (;;) {
        sum = 0u; cnt = 0u; mine = 0u;
#pragma unroll
        for (unsigned j = 0; j < 16; ++j) { const unsigned c = xb_ld(&bar[XB_XCNT(j)]); sum += c; cnt += (c > 0u) ? 1u : 0u; mine = (j == x) ? c : mine; }
        if (sum == G) break;
        __builtin_amdgcn_s_sleep(1);
        if ((++sp & 255u) == 0u) { if (xb_ld(&bar[XB_TMO])) break; if (sp > XB_SPIN_CAP) { atomicAdd(&bar[XB_TMO], 1u); break; } }
    }
    nloc = mine > 0u ? mine : 1u; nx = cnt > 0u ? cnt : 1u;
}
__device__ __forceinline__ void xcd_barrier(const XcdBarrier& b) {
    asm volatile("s_waitcnt vmcnt(0)" ::: "memory");
    __syncthreads();
    if (threadIdx.x == 0) {
        unsigned* bar = b.bar;
        __builtin_amdgcn_s_waitcnt(0);
        unsigned nloc = b.st[0], nx = b.st[1];
        if (nloc == 0u) { xcd_barrier_complete(bar, b.x, nloc, nx); b.st[0] = nloc; b.st[1] = nx; }
        const unsigned old = xb_add(&bar[XB_XSUB(b.x)], 1u);
        const unsigned gen = old / nloc;
        if (old + 1u == (gen + 1u) * nloc) {
            __builtin_amdgcn_fence(__ATOMIC_RELEASE, "agent");
            asm volatile("s_waitcnt vmcnt(0)" ::: "memory");
            const unsigned og = xb_add(&bar[XB_TOP], 1u);
            const unsigned tg = og / nx;
            if (og + 1u == (tg + 1u) * nx) xb_add(&bar[XB_TOPGEN], 1u);
            else XB_SPIN(xb_ld(&bar[XB_TOPGEN]) == tg, bar);
            __builtin_amdgcn_fence(__ATOMIC_ACQUIRE, "agent");
            xb_add(&bar[XB_XGEN(b.x)], 1u);
            asm volatile("s_waitcnt vmcnt(0)" ::: "memory");
        } else {
            XB_SPIN(xb_ld(&bar[XB_XGEN(b.x)]) == gen, bar);
            __builtin_amdgcn_fence(__ATOMIC_ACQUIRE, "agent");
            asm volatile("s_waitcnt vmcnt(0)" ::: "memory");
        }
    }
    __syncthreads();
}

__global__ void __launch_bounds__(512, 2) mk_fwd(Args a) {
    extern __shared__ __attribute__((aligned(16))) unsigned char lds[];
    cg::grid_group grid = cg::this_grid();
    const int G = gridDim.x;
    LAS unsigned char* lds3 = (LAS unsigned char*)lds;
    volatile LAS unsigned* misc = (volatile LAS unsigned*)(lds3 + MISC_OFF);
    if (threadIdx.x < 2) misc[threadIdx.x] = 0u;
    __syncthreads();
    XcdBarrier bar = xcd_barrier_post((unsigned*)(a.ws + WS_BAR), misc);
    float* mod = (float*)(a.ws + WS_MOD);
    float* xc = (float*)(a.ws + WS_XC); float* part = (float*)(a.ws + WS_PART);
    bf16_t* H = (bf16_t*)(a.ws + WS_H); bf16_t* O = (bf16_t*)(a.ws + WS_O); bf16_t* P = (bf16_t*)(a.ws + WS_P); bf16_t* A = (bf16_t*)(a.ws + WS_A);
    for (int ph = a.ph_lo; ph < a.ph_hi; ++ph) {
        if (ph == 0) { phase0(a, lds, G); if (REPMASK & 1) { __syncthreads(); phase0(a, lds, G); } }
        else {
            const int layer = (ph - 1) / 11, sub = (ph - 1) % 11;
            const float* mL = mod + (size_t)(layer * 2 + 0) * NMODV; const float* mC = mod + (size_t)(layer * 2 + 1) * NMODV;
            const bool with_ctx = layer == 0;
            if (sub == 0 || sub == 3 || sub == 8) {
                const int k = sub == 0 ? 0 : (sub == 3 ? 1 : 2);
                const bool first = (ph == 1);
                const float* xsrc = first ? a.in[I_X] : a.out; float* xcopy = first ? a.out : nullptr;
                const float* csrc = first ? a.in[I_CTX] : xc;
                const bool upd_prev = (sub == 0 && layer == 1);
                const int nsplit = (upd_prev || sub == 3) ? NSPLIT_DOWN : ((sub == 8) ? NSPLIT_OUT : 0);
                const float* cgate = upd_prev ? (mod + (size_t)(0 * 2 + 1) * NMODV + 8 * DM) : (sub == 3 ? mC + 2 * DM : mC + 5 * DM);
                const float ccoef = (sub == 8) ? 1.0f : 0.5f;
                const int nrows = (sub == 8 && !with_ctx) ? SEQ : MT;
                modulate_phase(xsrc, xcopy, csrc, xc, part, nsplit, cgate, ccoef, a.in[I_NORMG] + (size_t)(layer * 3 + k) * DM,
                               mL + (3 * k) * DM, mL + (3 * k + 1) * DM, mC + (3 * k) * DM, mC + (3 * k + 1) * DM, H, nrows, G);
            } else if (sub == 1 || sub == 9) {
                const int f = sub == 1 ? 0 : 1; const int nM = (f == 1 && !with_ctx) ? SEQ / 256 : MT / 256;
                pg8::Gemm g{H, (const bf16_t*)(a.ws + WS_WGU) + (size_t)(layer * 2 + f) * WGU_ELEMS, DM};
                pg8::Sched S; S.init(nM, 2 * FF / 256, DM, G, BID(), 0, 0, 0);
                pg8::EpiSwiGLU E{A, FF};
                pg8::gemm_phase<pg8::EpiSwiGLU, true, true>(lds3, g, S, E);
                if (REPMASK & 2) pg8::gemm_phase<pg8::EpiSwiGLU, true, true>(lds3, g, S, E);
            } else if (sub == 2 || sub == 10) {
                const int f = sub == 2 ? 0 : 1; const bool ctxrows = !(f == 1 && !with_ctx);
                pg8::Gemm g{A, (const bf16_t*)(a.ws + WS_WD) + (size_t)(layer * 2 + f) * WD_ELEMS, FF};
                pg8::Sched S; S.init(SEQ / 256, DM / 256, FF, G, BID(), ctxrows ? NSPLIT_DOWN : 0, NT_SPLIT_DOWN, SEQ / 256);
                pg8::EpiResid E{a.out, mL + (f == 0 ? 2 : 8) * DM, 0.5f, part};
                pg8::gemm_phase<pg8::EpiResid, true, true>(lds3, g, S, E);
            } else if (sub == 4) {
                const int N = layer == 0 ? AB_IN : C_IN;
                pg8::Gemm g{H, (const bf16_t*)(a.ws + (layer == 0 ? WS_WABIN : WS_WGIN)), DM};
                pg8::Sched S; S.init(MT / 256, N / 256, DM, G, BID(), 0, 0, 0);
                pg8::EpiBf16 E{P, N};
                pg8::gemm_phase<pg8::EpiBf16, true, true>(lds3, g, S, E);
                if (REPMASK & 16) pg8::gemm_phase<pg8::EpiBf16, true, true>(lds3, g, S, E);
            } else if (sub == 5) { qknorm_phase(a, layer, G); }
            else if (sub == 6) { if (layer == 0) { attn_phase0(a, lds, G); if (REPMASK & 32) attn_phase0(a, lds, G); } else { attn_phase1(a, lds, G); if (REPMASK & 4) attn_phase1(a, lds, G); } }
            else if (sub == 7) {
                pg8::Gemm g{O, (const bf16_t*)(a.ws + (layer == 0 ? WS_WABOUT : WS_WGOUT)), DM};
                pg8::Sched S; S.init(SEQ / 256, DM / 256, DM, G, BID(), with_ctx ? NSPLIT_OUT : 0, NT_SPLIT_OUT, SEQ / 256);
                pg8::EpiResid E{a.out, mL + 5 * DM, 1.0f, part};
                pg8::gemm_phase<pg8::EpiResid, true, true>(lds3, g, S, E);
            }
        }
        if (ph + 1 < a.ph_hi) {
            if (ph == a.ph_lo) grid.sync(); else xcd_barrier(bar);
            if (REPMASK & 8) xcd_barrier(bar); }
    }
}

extern "C" void kernel_launch(void* const* d_in, const int* in_sizes, int n_in, void* d_out, int out_size, void* d_ws, size_t ws_size, hipStream_t stream) {
    static int grid = 0;
    if (grid == 0) {
        if (n_in != 22 || out_size != SEQ * DM || ws_size < WS_END) { fprintf(stderr, "kernel_launch: unexpected shapes (n_in %d out %d ws %zu)\n", n_in, out_size, ws_size); grid = -1; return; }
        int dev = 0, cus = 0, per_cu = 0;
        hipGetDevice(&dev); hipDeviceGetAttribute(&cus, hipDeviceAttributeMultiprocessorCount, dev);
        if (hipFuncSetAttribute((const void*)mk_fwd, hipFuncAttributeMaxDynamicSharedMemorySize, LDS_BYTES) != hipSuccess) { fprintf(stderr, "kernel_launch: hipFuncSetAttribute failed\n"); grid = -1; return; }
        if (hipOccupancyMaxActiveBlocksPerMultiprocessor(&per_cu, (const void*)mk_fwd, 512, LDS_BYTES) != hipSuccess || per_cu < 1) { fprintf(stderr, "kernel_launch: occupancy query gave %d\n", per_cu); per_cu = 1; }
        (void)hipGetLastError();
        grid = cus * per_cu;
        if (grid > 256) grid = 256;
    }
    if (grid < 0) return;
    if (hipMemsetAsync((char*)d_ws + WS_BAR, 0, BAR_BYTES, stream) != hipSuccess) { fprintf(stderr, "kernel_launch: memset failed\n"); return; }
    Args a{};
    for (int i = 0; i < 22; ++i) a.in[i] = (const float*)d_in[i];
    a.out = (float*)d_out; a.ws = (unsigned char*)d_ws;
#if MK_MULTI
    for (int p = 0; p < NPHASE; ++p) { a.ph_lo = p; a.ph_hi = p + 1; hipLaunchKernelGGL(mk_fwd, dim3(grid), dim3(512), LDS_BYTES, stream, a); }
#else
    a.ph_lo = 0; a.ph_hi = NPHASE;
    void* args[] = {&a};
    hipError_t e = hipLaunchCooperativeKernel((const void*)mk_fwd, dim3(grid), dim3(512), args, LDS_BYTES, stream);
    if (e != hipSuccess) fprintf(stderr, "cooperative launch failed: %s (grid %d)\n", hipGetErrorString(e), grid);
#endif
}
```

```cpp
#include <hip/hip_runtime.h>
#include <hip/hip_cooperative_groups.h>
#include <cstdio>
#include <cstdint>
namespace cg = cooperative_groups;

#ifndef REPMASK
#define REPMASK 0
#endif
#ifndef MK_MULTI
#define MK_MULTI 0
#endif

constexpr int SEQ = 8192, CTXL = 256, MT = SEQ + CTXL, DM = 2048, FF = 5632, NMODV = 9 * DM;
constexpr int AB_IN = 4608, C_IN = 3072, GRIDW = 64;
constexpr float EPS = 1e-6f;
constexpr int NPHASE = 23;
constexpr int NSPLIT_DOWN = 22, NT_SPLIT_DOWN = 4;
constexpr int NSPLIT_OUT = 16, NT_SPLIT_OUT = 2;

constexpr size_t MiB = 1u << 20;
constexpr size_t WS_MOD = 0;
constexpr size_t WS_BAR = 512 * 1024, BAR_BYTES = 16384;
constexpr size_t WS_XC = 1 * MiB;
constexpr size_t WS_PART = 4 * MiB;
constexpr size_t WS_H = 52 * MiB;
constexpr size_t WS_O = 88 * MiB;
constexpr size_t WS_P = 124 * MiB;
constexpr size_t WS_A = 200 * MiB;
constexpr size_t WS_WGU = 292 * MiB;
constexpr size_t WS_WD = 468 * MiB;
constexpr size_t WS_WABIN = 556 * MiB;
constexpr size_t WS_WABOUT = 574 * MiB;
constexpr size_t WS_WGIN = 582 * MiB;
constexpr size_t WS_WGOUT = 594 * MiB;
constexpr size_t WS_END = 602 * MiB;
constexpr size_t WGU_ELEMS = (size_t)2 * FF * DM, WD_ELEMS = (size_t)DM * FF;

constexpr int LDS_BYTES = 143360;
constexpr int MISC_OFF = 135168;

typedef unsigned short bf16_t;
typedef short bf16x8 __attribute__((ext_vector_type(8)));
typedef short s16x4 __attribute__((ext_vector_type(4)));
typedef float f32x4 __attribute__((ext_vector_type(4)));
typedef float f32x2 __attribute__((ext_vector_type(2)));
typedef float f32x16 __attribute__((ext_vector_type(16)));
typedef unsigned u32x4 __attribute__((ext_vector_type(4)));
typedef unsigned u32x2 __attribute__((ext_vector_type(2)));
#define LAS __attribute__((address_space(3)))

__device__ __forceinline__ unsigned cvt_pk_bf16(float lo, float hi) { unsigned r; asm volatile("v_cvt_pk_bf16_f32 %0, %1, %2" : "=v"(r) : "v"(lo), "v"(hi)); return r; }
__device__ __forceinline__ int TID() { int t = threadIdx.x; asm volatile("" : "+v"(t)); return t; }
__device__ __forceinline__ int BID() { int b = blockIdx.x; asm volatile("" : "+s"(b)); return b; }
__device__ __forceinline__ float bf2f(unsigned short b) { return __uint_as_float(((unsigned)b) << 16); }
__device__ __forceinline__ float wave_sum(float v) {
#pragma unroll
    for (int o = 1; o < 64; o <<= 1) v += __shfl_xor(v, o);
    return v;
}

namespace pg8 {
constexpr int BM = 256, BK = 64, HALF = 128, HTB = HALF * BK * 2, STAGE_BYTES = 8 * HTB, NXCD = 8, WGM = 8;
__host__ __device__ __forceinline__ int lds_byte(int r, int c) { const int st = (r >> 4) * 2 + (c >> 5), rr = r & 15, cc = c & 31, ob = rr * 64 + cc * 2; return st * 1024 + (ob ^ (((ob >> 9) & 1) << 5)); }
__host__ __device__ __forceinline__ void stage_rc(int b, int& R, int& C) { const int st = b / 1024, sb = b % 1024, swz = sb ^ (((sb >> 9) & 1) << 5); R = (st >> 1) * 16 + swz / 64; C = (st & 1) * 32 + (swz % 64) / 2; }
__host__ __device__ __forceinline__ int perm32(int rho) { const int n = rho >> 4, i = rho & 15; return 8 * (i >> 2) + 4 * n + (i & 3); }

struct Unit { int pm, pn, k0, nt, split; };
struct Gemm { const bf16_t* A; const bf16_t* Bt; int K; };

struct Sched {
    int nM, nN, nwg, G, c, nt_full, nsplit_units, split_nt, split_pm;
    __device__ __forceinline__ void init(int nM_, int nN_, int K, int G_, int c_, int nsplit, int snt, int spm) {
        nM = nM_; nN = nN_; nwg = nM * nN; G = G_; c = c_; nt_full = K / BK; nsplit_units = nsplit * nN_; split_nt = snt; split_pm = spm; }
    __device__ __forceinline__ bool next(int i, Unit& u) const {
        const long L = (long)i * G + c;
        const bool reg = L < nwg; const int s = reg ? 0 : (int)(L - nwg);
        if (!reg && s >= nsplit_units) return false;
        int wgid = reg ? (int)L : 0; { const int q = nwg / NXCD, r = nwg % NXCD, xcd = wgid % NXCD, off = wgid / NXCD; wgid = (xcd < r ? xcd * (q + 1) : r * (q + 1) + (xcd - r) * q) + off; }
        const int nig = WGM * nN, gid = wgid / nig, fm = gid * WGM, gsz = (nM - fm) < WGM ? (nM - fm) : WGM;
        const int pm_r = fm + ((wgid % nig) % gsz), pn_r = (wgid % nig) / gsz;
        const int pn_s = s % nN, sp_s = s / nN;
        u.pm = __builtin_amdgcn_readfirstlane(reg ? pm_r : split_pm); u.pn = __builtin_amdgcn_readfirstlane(reg ? pn_r : pn_s);
        u.split = __builtin_amdgcn_readfirstlane(reg ? -1 : sp_s); u.k0 = __builtin_amdgcn_readfirstlane(reg ? 0 : sp_s * split_nt); u.nt = __builtin_amdgcn_readfirstlane(reg ? nt_full : split_nt);
        return true;
    }
};

struct EpiBf16 {
    static constexpr bool PERM = true;
    bf16_t* O; int ldc;
    __device__ __forceinline__ void operator()(const f32x4 (&acc)[2][2][4][2], const Unit& u, int wr, int wc, int fr, int fq) const {
        asm volatile("" : "+v"(fr), "+v"(fq));
        const int row0 = u.pm * BM + wr * 64 + fr; const int col0 = u.pn * BM + wc * 32 + 8 * fq;
#pragma unroll
        for (int ai = 0; ai < 2; ++ai)
#pragma unroll
            for (int m = 0; m < 4; ++m) { bf16_t* rowp = O + (size_t)(row0 + ai * HALF + m * 16) * ldc + col0;
#pragma unroll
                for (int bj = 0; bj < 2; ++bj) { const f32x4 v0 = acc[ai][bj][m][0], v1 = acc[ai][bj][m][1];
                    u32x4 w; w.x = cvt_pk_bf16(v0[0], v0[1]); w.y = cvt_pk_bf16(v0[2], v0[3]); w.z = cvt_pk_bf16(v1[0], v1[1]); w.w = cvt_pk_bf16(v1[2], v1[3]);
                    *(u32x4*)(rowp + bj * HALF) = w; } }
    }
};
__device__ __forceinline__ float silu_mul(float g, float u) { const float e = __builtin_amdgcn_exp2f(-g * 1.4426950408889634f); return g * __builtin_amdgcn_rcpf(1.0f + e) * u; }
struct EpiSwiGLU {
    static constexpr bool PERM = true;
    bf16_t* O; int ldc;
    __device__ __forceinline__ void operator()(const f32x4 (&acc)[2][2][4][2], const Unit& u, int wr, int wc, int fr, int fq) const {
        asm volatile("" : "+v"(fr), "+v"(fq));
        const int row0 = u.pm * BM + wr * 64 + fr; const int col0 = u.pn * HALF + wc * 32 + 8 * fq;
#pragma unroll
        for (int ai = 0; ai < 2; ++ai)
#pragma unroll
            for (int m = 0; m < 4; ++m) { bf16_t* rowp = O + (size_t)(row0 + ai * HALF + m * 16) * ldc + col0;
                const f32x4 g0 = acc[ai][0][m][0], g1 = acc[ai][0][m][1], u0 = acc[ai][1][m][0], u1 = acc[ai][1][m][1];
                u32x4 w; w.x = cvt_pk_bf16(silu_mul(g0[0], u0[0]), silu_mul(g0[1], u0[1])); w.y = cvt_pk_bf16(silu_mul(g0[2], u0[2]), silu_mul(g0[3], u0[3]));
                w.z = cvt_pk_bf16(silu_mul(g1[0], u1[0]), silu_mul(g1[1], u1[1])); w.w = cvt_pk_bf16(silu_mul(g1[2], u1[2]), silu_mul(g1[3], u1[3]));
                *(u32x4*)rowp = w; }
    }
};
struct EpiResid {
    static constexpr bool PERM = false;
    const float* Xs; float* X; const float* gate; float coef; float* part;
    __device__ __forceinline__ void operator()(const f32x4 (&acc)[2][2][4][2], const Unit& u, int wr, int wc, int fr, int fq) const {
        asm volatile("" : "+v"(fr), "+v"(fq));
        const int col0 = u.pn * BM + wc * 32 + 4 * fq;
        if (u.split < 0) {
            f32x4 gv[2][2];
#pragma unroll
            for (int bj = 0; bj < 2; ++bj)
#pragma unroll
                for (int n = 0; n < 2; ++n) gv[bj][n] = *(const f32x4*)(gate + col0 + bj * HALF + n * 16) * coef;
#pragma unroll
            for (int ai = 0; ai < 2; ++ai)
#pragma unroll
                for (int m = 0; m < 4; ++m) { const size_t roff = (size_t)(u.pm * BM + ai * HALF + wr * 64 + m * 16 + fr) * DM + col0; float* rowp = X + roff; const float* rows = Xs + roff;
#pragma unroll
                    for (int bj = 0; bj < 2; ++bj)
#pragma unroll
                        for (int n = 0; n < 2; ++n) { *(f32x4*)(rowp + bj * HALF + n * 16) = *(const f32x4*)(rows + bj * HALF + n * 16) + gv[bj][n] * acc[ai][bj][m][n]; }
                    asm volatile("" ::: "memory"); }
        } else {
            float* base = part + (size_t)u.split * 256 * DM;
#pragma unroll
            for (int ai = 0; ai < 2; ++ai)
#pragma unroll
                for (int m = 0; m < 4; ++m) { float* rowp = base + (size_t)(ai * HALF + wr * 64 + m * 16 + fr) * DM + col0;
#pragma unroll
                    for (int bj = 0; bj < 2; ++bj)
#pragma unroll
                        for (int n = 0; n < 2; ++n) *(f32x4*)(rowp + bj * HALF + n * 16) = acc[ai][bj][m][n]; }
        }
    }
};

template <class Epi, bool ALIGN_EPI, bool SP2>
__device__ __forceinline__ void gemm_phase(LAS unsigned char* lds, const Gemm g, const Sched& S, const Epi& E) {
    const int tid = TID(), wid = __builtin_amdgcn_readfirstlane(tid >> 6), lane = tid & 63, wr = wid >> 2, wc = wid & 3, fr = lane & 15, fq = lane >> 4;
    const int K = g.K;
    unsigned voffA[2], voffB[2];
#pragma unroll
    for (int i = 0; i < 2; ++i) { int R, C; stage_rc(tid * 16 + i * 8192, R, C); const int Rb = Epi::PERM ? ((R & ~31) + perm32(R & 31)) : R;
        voffA[i] = (unsigned)(R * K + C) * 2u; voffB[i] = (unsigned)(Rb * K + C) * 2u; }
    const size_t kstep = (size_t)(BK * 2);
    const size_t hstep = (size_t)HALF * K * 2;
    const size_t tstep = 2 * hstep;
    const unsigned ldsw = (unsigned)wid * 1024u;
    const int aoff = lds_byte(wr * 64 + fr, fq * 8), boff = lds_byte(wc * 32 + fr, fq * 8);
#define PG8_SA(b, h) (((b) * 2 + (h)) * HTB)
#define PG8_SB(b, h) ((4 + (b) * 2 + (h)) * HTB)
#define PG8_STAGE(bufoff, gbase, voff) do { _Pragma("unroll") for (int _i = 0; _i < 2; ++_i) \
        __builtin_amdgcn_global_load_lds((const unsigned*)((const char*)(gbase) + (voff)[_i]), (LAS unsigned*)(lds + (bufoff) + ldsw + _i * 8192), 16, 0, 0); } while (0)
#define PG8_LDA(dst, b, h) do { _Pragma("unroll") for (int m = 0; m < 4; ++m) _Pragma("unroll") for (int k = 0; k < 2; ++k) dst[m][k] = *(const LAS bf16x8*)(lds + PG8_SA(b, h) + aoff + m * 2048 + k * 1024); } while (0)
#define PG8_LDB(dst, b, h) do { _Pragma("unroll") for (int n = 0; n < 2; ++n) _Pragma("unroll") for (int k = 0; k < 2; ++k) dst[n][k] = *(const LAS bf16x8*)(lds + PG8_SB(b, h) + boff + n * 2048 + k * 1024); } while (0)
#define PG8_MMA(ai, bj, At, Bt) do { __builtin_amdgcn_s_setprio(1); _Pragma("unroll") for (int m = 0; m < 4; ++m) _Pragma("unroll") for (int n = 0; n < 2; ++n) _Pragma("unroll") for (int k = 0; k < 2; ++k) \
        acc[ai][bj][m][n] = __builtin_amdgcn_mfma_f32_16x16x32_bf16(Bt[n][k], At[m][k], acc[ai][bj][m][n], 0, 0, 0); __builtin_amdgcn_s_setprio(0); } while (0)
#define PG8_WAIT_V(n) asm volatile("s_waitcnt vmcnt(" #n ")" ::: "memory")
#define PG8_WAIT_L(n) asm volatile("s_waitcnt lgkmcnt(" #n ")" ::: "memory")
#define PG8_BAR __builtin_amdgcn_s_barrier()
#define PG8_SCHED __builtin_amdgcn_sched_barrier(0)
    Unit cur, nxt; int ui = 0;
    if (!S.next(0, cur)) return;
    f32x4 acc[2][2][4][2];
#pragma unroll
    for (int a = 0; a < 2; ++a)
#pragma unroll
        for (int b = 0; b < 2; ++b)
#pragma unroll
            for (int m = 0; m < 4; ++m)
#pragma unroll
                for (int n = 0; n < 2; ++n) acc[a][b][m][n] = (f32x4){0.f, 0.f, 0.f, 0.f};
    bf16x8 At[4][2], B0[2][2], B1[2][2];
    const char* cA = (const char*)g.A + (size_t)cur.pm * tstep + (size_t)cur.k0 * kstep; const char* cB = (const char*)g.Bt + (size_t)cur.pn * tstep + (size_t)cur.k0 * kstep;
    if constexpr (SP2) {
        PG8_STAGE(PG8_SB(0, 0), cB, voffB); PG8_STAGE(PG8_SB(0, 1), cB + hstep, voffB); PG8_STAGE(PG8_SA(0, 0), cA, voffA); PG8_STAGE(PG8_SA(0, 1), cA + hstep, voffA);
        if (wr == 1) PG8_BAR;
        PG8_WAIT_V(2); PG8_BAR;
        PG8_STAGE(PG8_SB(1, 0), cB + kstep, voffB); PG8_STAGE(PG8_SA(1, 0), cA + kstep, voffA); PG8_STAGE(PG8_SB(1, 1), cB + hstep + kstep, voffB);
        PG8_WAIT_V(6); PG8_BAR;
    } else {
        PG8_STAGE(PG8_SB(0, 0), cB, voffB); PG8_STAGE(PG8_SA(0, 0), cA, voffA); PG8_STAGE(PG8_SB(0, 1), cB + hstep, voffB); PG8_STAGE(PG8_SA(0, 1), cA + hstep, voffA);
        if (wr == 1) PG8_BAR;
        PG8_WAIT_V(4); PG8_BAR;
        PG8_STAGE(PG8_SB(1, 0), cB + kstep, voffB); PG8_STAGE(PG8_SA(1, 0), cA + kstep, voffA); PG8_STAGE(PG8_SB(1, 1), cB + hstep + kstep, voffB);
        PG8_WAIT_V(6); PG8_BAR;
    }
    for (;;) {
        const bool has_next = S.next(ui + 1, nxt);
        const int nt = cur.nt;
        const char* nA = has_next ? (const char*)g.A + (size_t)nxt.pm * tstep + (size_t)nxt.k0 * kstep : cA; const char* nB = has_next ? (const char*)g.Bt + (size_t)nxt.pn * tstep + (size_t)nxt.k0 * kstep : cB;
        for (int t = 0; t < nt; t += 2) {
            const bool last = (t == nt - 2);
            const char* a1 = cA + (size_t)(t + 1) * kstep;
            const char* a2 = last ? nA : cA + (size_t)(t + 2) * kstep; const char* b2 = last ? nB : cB + (size_t)(t + 2) * kstep;
            const char* a3 = a2 + kstep; const char* b3 = b2 + kstep;
            if constexpr (SP2) {
            PG8_LDB(B0, 0, 0); PG8_LDB(B1, 0, 1); PG8_SCHED; PG8_LDA(At, 0, 0); PG8_STAGE(PG8_SA(1, 1), a1 + hstep, voffA);
            PG8_WAIT_V(8); PG8_WAIT_L(0); PG8_BAR; PG8_MMA(0, 0, At, B0); PG8_MMA(0, 1, At, B1); PG8_BAR; PG8_SCHED;
            PG8_LDA(At, 0, 1); PG8_STAGE(PG8_SB(0, 0), b2, voffB); PG8_STAGE(PG8_SB(0, 1), b2 + hstep, voffB); PG8_STAGE(PG8_SA(0, 0), a2, voffA);
            PG8_WAIT_V(8); PG8_WAIT_L(0); PG8_BAR; PG8_MMA(1, 0, At, B0); PG8_MMA(1, 1, At, B1); PG8_BAR; PG8_SCHED;
            PG8_LDB(B0, 1, 0); PG8_LDB(B1, 1, 1); PG8_SCHED; PG8_LDA(At, 1, 0); PG8_STAGE(PG8_SA(0, 1), a2 + hstep, voffA);
            PG8_WAIT_V(8); PG8_WAIT_L(0); PG8_BAR; PG8_MMA(0, 0, At, B0); PG8_MMA(0, 1, At, B1); PG8_BAR; PG8_SCHED;
            PG8_LDA(At, 1, 1); PG8_STAGE(PG8_SB(1, 0), b3, voffB); PG8_STAGE(PG8_SB(1, 1), b3 + hstep, voffB); PG8_STAGE(PG8_SA(1, 0), a3, voffA);
            PG8_WAIT_V(8); PG8_WAIT_L(0); PG8_BAR; PG8_MMA(1, 0, At, B0); PG8_MMA(1, 1, At, B1); PG8_BAR; PG8_SCHED;
            } else {
            PG8_LDB(B0, 0, 0); PG8_SCHED; PG8_LDA(At, 0, 0); PG8_STAGE(PG8_SA(1, 1), a1 + hstep, voffA);
            PG8_WAIT_L(8); PG8_BAR; PG8_WAIT_L(0); PG8_MMA(0, 0, At, B0); PG8_BAR; PG8_SCHED;
            PG8_LDB(B1, 0, 1); PG8_STAGE(PG8_SB(0, 0), b2, voffB);
            PG8_BAR; PG8_WAIT_L(0); PG8_MMA(0, 1, At, B1); PG8_BAR;
            PG8_LDA(At, 0, 1); PG8_STAGE(PG8_SA(0, 0), a2, voffA);
            PG8_BAR; PG8_WAIT_L(0); PG8_MMA(1, 0, At, B0); PG8_BAR; PG8_SCHED;
            PG8_STAGE(PG8_SB(0, 1), b2 + hstep, voffB);
            PG8_WAIT_V(6); PG8_BAR; PG8_MMA(1, 1, At, B1); PG8_BAR;
            PG8_LDB(B0, 1, 0); PG8_SCHED; PG8_LDA(At, 1, 0); PG8_STAGE(PG8_SA(0, 1), a2 + hstep, voffA);
            PG8_WAIT_L(8); PG8_BAR; PG8_WAIT_L(0); PG8_MMA(0, 0, At, B0); PG8_BAR; PG8_SCHED;
            PG8_LDB(B1, 1, 1); PG8_STAGE(PG8_SB(1, 0), b3, voffB);
            PG8_BAR; PG8_WAIT_L(0); PG8_MMA(0, 1, At, B1); PG8_BAR;
            PG8_LDA(At, 1, 1); PG8_STAGE(PG8_SA(1, 0), a3, voffA);
            PG8_BAR; PG8_WAIT_L(0); PG8_MMA(1, 0, At, B0); PG8_BAR; PG8_SCHED;
            PG8_STAGE(PG8_SB(1, 1), b3 + hstep, voffB);
            PG8_WAIT_V(6); PG8_BAR; PG8_MMA(1, 1, At, B1); PG8_BAR;
            }
        }
        if constexpr (ALIGN_EPI) { if (wr == 0) PG8_BAR; }
        E(acc, cur, wr, wc, fr, fq);
        if (!has_next) break;
#pragma unroll
        for (int a = 0; a < 2; ++a)
#pragma unroll
            for (int b = 0; b < 2; ++b)
#pragma unroll
                for (int m = 0; m < 4; ++m)
#pragma unroll
                    for (int n = 0; n < 2; ++n) acc[a][b][m][n] = (f32x4){0.f, 0.f, 0.f, 0.f};
        cur = nxt; cA = nA; cB = nB; ++ui;
        if constexpr (ALIGN_EPI) { if (wr == 1) PG8_BAR; }
    }
    PG8_WAIT_V(0);
    if constexpr (!ALIGN_EPI) { if (wr == 0) PG8_BAR; }
    PG8_BAR;
#undef PG8_SA
#undef PG8_SB
#undef PG8_STAGE
#undef PG8_LDA
#undef PG8_LDB
#undef PG8_MMA
#undef PG8_WAIT_V
#undef PG8_WAIT_L
#undef PG8_BAR
#undef PG8_SCHED
}
}

namespace att {
constexpr int D = 128, NW = 8, QBLK = 32, KVBLK = 64;
constexpr float SCALE = 0.088388347648318440f;
constexpr float INV_SCALE = 11.313708498984761f;
constexpr float THR = 8.f;
constexpr float NEG = -1e30f;
constexpr size_t SHM_V = KVBLK * D * 2, SHM_K = KVBLK * D * 2, SHM_ATTN = 2 * SHM_V + 2 * SHM_K + NW * 64 * 4;
constexpr int BIAS_OFF = (int)SHM_ATTN;
enum { DENSE = 0, NA = 1, SW = 2 };
#define KSWZ(row, colB) ((row) * 256 + ((colB) ^ (((row) & 7) << 4)))
#define SBAR() __builtin_amdgcn_sched_barrier(0)
__device__ __forceinline__ int crow(int r, int hi) { return (r & 3) + 8 * (r >> 2) + 4 * hi; }

__device__ __forceinline__ void partialSM(f32x16& p0, f32x16& p1, float& m_reg, float& mn, float& alpha) {
  constexpr float C = SCALE * 1.4426950408889634f;
  float pmax = p0[0];
#pragma unroll
  for (int r = 1; r < 16; ++r) pmax = fmaxf(pmax, p0[r]);
#pragma unroll
  for (int r = 0; r < 16; ++r) pmax = fmaxf(pmax, p1[r]);
  { auto rr = __builtin_amdgcn_permlane32_swap(__float_as_uint(pmax), __float_as_uint(pmax), false, false);
    pmax = fmaxf(__uint_as_float(rr[0]), __uint_as_float(rr[1])); }
  if (__builtin_expect(__all(pmax - m_reg <= THR / SCALE), 1)) { mn = m_reg; alpha = 1.f; }
  else { mn = fmaxf(m_reg, pmax); alpha = __builtin_amdgcn_exp2f((m_reg - mn) * C); m_reg = mn; }
  float mnC = -mn * C;
#pragma unroll
  for (int r = 0; r < 16; ++r) p0[r] = fmaf(p0[r], C, mnC);
#pragma unroll
  for (int r = 0; r < 16; ++r) p1[r] = fmaf(p1[r], C, mnC);
#pragma unroll
  for (int r = 0; r < 16; ++r) p0[r] = __builtin_amdgcn_exp2f(p0[r]);
}
__device__ __forceinline__ void finishSM(f32x16& p0, f32x16& p1, float alpha, float& l_reg, bf16x8& pa0, bf16x8& pa1, bf16x8& pa2, bf16x8& pa3) {
#pragma unroll
  for (int r = 0; r < 16; ++r) p1[r] = __builtin_amdgcn_exp2f(p1[r]);
  float ps = 0;
#pragma unroll
  for (int r = 0; r < 16; ++r) ps += p0[r];
#pragma unroll
  for (int r = 0; r < 16; ++r) ps += p1[r];
  { auto rr = __builtin_amdgcn_permlane32_swap(__float_as_uint(ps), __float_as_uint(ps), false, false);
    ps = __uint_as_float(rr[0]) + __uint_as_float(rr[1]); }
  l_reg = l_reg * alpha + ps;
#define PK4(P, BASE, OUT) do { unsigned a0 = cvt_pk_bf16(P[BASE + 0], P[BASE + 1]), a1 = cvt_pk_bf16(P[BASE + 2], P[BASE + 3]);   \
    unsigned b0 = cvt_pk_bf16(P[BASE + 4], P[BASE + 5]), b1 = cvt_pk_bf16(P[BASE + 6], P[BASE + 7]);                              \
    auto r0 = __builtin_amdgcn_permlane32_swap(a0, b0, false, false); auto r1 = __builtin_amdgcn_permlane32_swap(a1, b1, false, false); \
    u32x4 w = {r0[0], r1[0], r0[1], r1[1]}; OUT = *reinterpret_cast<bf16x8*>(&w); } while (0)
  PK4(p0, 0, pa0); PK4(p0, 8, pa1); PK4(p1, 0, pa2); PK4(p1, 8, pa3);
#undef PK4
}
__device__ __forceinline__ void qkt(f32x16& p0, f32x16& p1, const bf16_t* Ks, const bf16x8* qr, int r32, int hi) {
  p0 = f32x16{}; p1 = f32x16{};
#pragma unroll
  for (int d0 = 0; d0 < 8; ++d0) { int cb = (d0 * 16 + hi * 8) * 2;
    bf16x8 b0 = *reinterpret_cast<const bf16x8*>((const char*)Ks + KSWZ(r32, cb));
    bf16x8 b1 = *reinterpret_cast<const bf16x8*>((const char*)Ks + KSWZ(32 + r32, cb));
    p0 = __builtin_amdgcn_mfma_f32_32x32x16_bf16(b0, qr[d0], p0, 0, 0, 0);
    p1 = __builtin_amdgcn_mfma_f32_32x32x16_bf16(b1, qr[d0], p1, 0, 0, 0); }
}
__device__ __forceinline__ int v_st(int k, int c) { const int kk = (k & ~0xC) | ((k & 4) << 1) | ((k & 8) >> 1); return ((kk >> 3) * 4 + (c >> 5)) * 512 + ((kk & 7) * 32 + (c & 31)) * 2; }
__device__ __forceinline__ int v_rd_base(int lane) { return ((lane & 3) << 3) | (((lane >> 2) & 3) << 6) | (((lane >> 4) & 1) << 5) | (((lane >> 5) & 1) << 8); }
constexpr int v_rd_off(int d0, int ks, int half) { return d0 * 512 + ks * 4096 + half * 2048; }
template <int OFF> __device__ __forceinline__ s16x4 tr_read(int vb) {
  s16x4 r; asm volatile("ds_read_b64_tr_b16 %0, %1 offset:%2" : "=&v"(r) : "v"(vb), "i"(OFF) : "memory"); return r;
}
template <int D0> __device__ __forceinline__ void pv_one(f32x16& od, int vb, bf16x8 pa0, bf16x8 pa1, bf16x8 pa2, bf16x8 pa3) {
  const s16x4 l0 = tr_read<v_rd_off(D0, 0, 0)>(vb), h0 = tr_read<v_rd_off(D0, 0, 1)>(vb), l1 = tr_read<v_rd_off(D0, 1, 0)>(vb), h1 = tr_read<v_rd_off(D0, 1, 1)>(vb);
  const s16x4 l2 = tr_read<v_rd_off(D0, 2, 0)>(vb), h2 = tr_read<v_rd_off(D0, 2, 1)>(vb), l3 = tr_read<v_rd_off(D0, 3, 0)>(vb), h3 = tr_read<v_rd_off(D0, 3, 1)>(vb);
  asm volatile("s_waitcnt lgkmcnt(0)" ::: "memory"); SBAR();
#define PK(L, H) (bf16x8){L[0], L[1], L[2], L[3], H[0], H[1], H[2], H[3]}
  od = __builtin_amdgcn_mfma_f32_32x32x16_bf16(pa0, PK(l0, h0), od, 0, 0, 0);
  od = __builtin_amdgcn_mfma_f32_32x32x16_bf16(pa1, PK(l1, h1), od, 0, 0, 0);
  od = __builtin_amdgcn_mfma_f32_32x32x16_bf16(pa2, PK(l2, h2), od, 0, 0, 0);
  od = __builtin_amdgcn_mfma_f32_32x32x16_bf16(pa3, PK(l3, h3), od, 0, 0, 0);
#undef PK
}
__device__ __forceinline__ void pv_d0(f32x16* o, int vb, bf16x8 pa0, bf16x8 pa1, bf16x8 pa2, bf16x8 pa3) {
  pv_one<0>(o[0], vb, pa0, pa1, pa2, pa3); pv_one<1>(o[1], vb, pa0, pa1, pa2, pa3); pv_one<2>(o[2], vb, pa0, pa1, pa2, pa3); pv_one<3>(o[3], vb, pa0, pa1, pa2, pa3);
}

struct UnitP { const bf16_t* Q; const bf16_t* K; const bf16_t* V; bf16_t* O; int ldq, ldk, ldo, NT, base_row, qb; float sink_l2e; };

template <int MODE> __device__ __forceinline__ int tile_row0(const UnitP& u, int t) {
  if (MODE == DENSE) return u.base_row + KVBLK * t;
  if (t < 4) return SEQ + KVBLK * t;
  if (MODE == NA) { int R0 = 4 * u.qb - 4; R0 = R0 < 0 ? 0 : (R0 > 120 ? 120 : R0); int kr = R0 + t - 4; kr = kr > 127 ? 127 : kr; return kr * 64; }
  int k0 = 256 * u.qb - 128 + 64 * (t - 4); k0 = k0 < 0 ? 0 : (k0 > SEQ - 64 ? SEQ - 64 : k0); return k0;
}
template <int MODE> __device__ __forceinline__ void mask_tile(f32x16& p0, f32x16& p1, const UnitP& u, int t, int wid, int r32, int hi, const float* biasL) {
  if (MODE == DENSE) return;
  if (t < 4) return;
  if (MODE == SW) {
    const int kpos0 = 256 * u.qb - 128 + 64 * (t - 4); int qpos = 256 * u.qb + wid * 32 + r32; int hi_ = hi;
    asm volatile("" : "+v"(qpos), "+v"(hi_));
#pragma unroll
    for (int r = 0; r < 16; ++r) { const int k0 = kpos0 + crow(r, hi_), k1 = k0 + 32; const int d0 = k0 - qpos, d1 = k1 - qpos;
      const bool v0 = (k0 >= 0) && (k0 < SEQ) && (d0 <= 128) && (d0 >= -128); const bool v1 = (k1 >= 0) && (k1 < SEQ) && (d1 <= 128) && (d1 >= -128);
      p0[r] = v0 ? p0[r] : NEG; p1[r] = v1 ? p1[r] : NEG; }
  } else {
    int R0 = 4 * u.qb - 4; R0 = R0 < 0 ? 0 : (R0 > 120 ? 120 : R0); const int kr = R0 + t - 4;
    const int rq = 4 * u.qb + (wid >> 1); int rs = rq - 4; rs = rs < 0 ? 0 : (rs > 120 ? 120 : rs);
    const bool rowvalid = (kr >= rs) && (kr < rs + 8);
    if (!rowvalid) {
#pragma unroll
      for (int r = 0; r < 16; ++r) { p0[r] = NEG; p1[r] = NEG; }
      return; }
    int cq = (wid & 1) * 32 + r32; int hi_ = hi;
    asm volatile("" : "+v"(cq), "+v"(hi_));
    int cs = cq - 8; cs = cs < 0 ? 0 : (cs > 48 ? 48 : cs);
    int brow = kr - rq + 7; brow = brow < 0 ? 0 : (brow > 14 ? 14 : brow);
    const float* bl = biasL + brow * 31 + 15 - cq;
#pragma unroll
    for (int r = 0; r < 16; ++r) { const int k0 = crow(r, hi_), k1 = k0 + 32;
      const bool v0 = rowvalid && (k0 >= cs) && (k0 < cs + 16); const bool v1 = rowvalid && (k1 >= cs) && (k1 < cs + 16);
      int i0 = k0 - cq; i0 = i0 < -15 ? -15 : (i0 > 15 ? 15 : i0); int i1 = k1 - cq; i1 = i1 < -15 ? -15 : (i1 > 15 ? 15 : i1);
      const float b0 = bl[cq + i0], b1 = bl[cq + i1];
      p0[r] = v0 ? p0[r] + b0 : NEG; p1[r] = v1 ? p1[r] + b1 : NEG;
      SBAR(); }
  }
}

template <int MODE, int SDEPTH>
__device__ __forceinline__ void attn_unit(const UnitP& u, char* lds) {
  const int tid = TID(), wid = tid >> 6, lane = tid & 63, r32 = lane & 31, hi = lane >> 5;
  bf16_t* V_lds = (bf16_t*)lds; bf16_t* K_lds = (bf16_t*)(lds + 2 * SHM_V);
  float* ws = (float*)(lds + 2 * SHM_V + 2 * SHM_K) + wid * 64; float* li_l = ws; float* al_l = ws + 32;
  const float* biasL = (const float*)(lds + BIAS_OFF);
  const bf16_t* __restrict__ Kh = u.K; const bf16_t* __restrict__ Vh = u.V; const int LDK = u.ldk;
  float m_reg = -1e30f, l_reg = 0; f32x16 o[4] = {}; bf16x8 qr[8];
  const bf16_t* Qw = u.Q + (long)(wid * QBLK + r32) * u.ldq + hi * 8;
#pragma unroll
  for (int d0 = 0; d0 < 8; ++d0) qr[d0] = *reinterpret_cast<const bf16x8*>(Qw + d0 * 16);
  const int vb0 = (int)(uintptr_t)V_lds + v_rd_base(lane);
  struct { bf16x8 vs0, vs1, ks0, ks1; } sr_[SDEPTH];
#define SLOAD(i, k0) do { int t_ = tid; if (MODE != DENSE) asm volatile("" : "+v"(t_)); const int sr = t_ >> 4, sc = (t_ & 15) * 8; \
    const long _r0 = (long)((k0) + sr) * LDK + sc, _r1 = (long)((k0) + 32 + sr) * LDK + sc; \
    sr_[i].vs0 = *reinterpret_cast<const bf16x8*>(&Vh[_r0]); sr_[i].vs1 = *reinterpret_cast<const bf16x8*>(&Vh[_r1]); \
    sr_[i].ks0 = *reinterpret_cast<const bf16x8*>(&Kh[_r0]); sr_[i].ks1 = *reinterpret_cast<const bf16x8*>(&Kh[_r1]); } while (0)
#define SWRITE(b, i) do { int t_ = tid; if (MODE != DENSE) asm volatile("" : "+v"(t_)); const int sr = t_ >> 4, sc = (t_ & 15) * 8, vst0 = v_st(sr, sc), vst1 = v_st(32 + sr, sc); \
    *(bf16x8*)((char*)V_lds + (b) * SHM_V + vst0) = sr_[i].vs0;          \
    *(bf16x8*)((char*)V_lds + (b) * SHM_V + vst1) = sr_[i].vs1; int kc = sc * 2;               \
    *(bf16x8*)((char*)K_lds + (b) * SHM_K + KSWZ(sr, kc)) = sr_[i].ks0;                       \
    *(bf16x8*)((char*)K_lds + (b) * SHM_K + KSWZ(32 + sr, kc)) = sr_[i].ks1; } while (0)
#define SWAIT() do { if constexpr (SDEPTH == 2) asm volatile("s_waitcnt vmcnt(4)" ::: "memory"); else asm volatile("s_waitcnt vmcnt(0)" ::: "memory"); } while (0)
#define RESC(a) do { if (__any((a) < 1.f)) { if (hi == 0) al_l[r32] = (a); asm volatile("s_waitcnt lgkmcnt(0)" ::: "memory"); \
    _Pragma("unroll") for (int d = 0; d < 4; ++d) _Pragma("unroll") for (int r = 0; r < 16; ++r) o[d][r] *= al_l[crow(r, hi)]; } } while (0)
#define ROW0(t) tile_row0<MODE>(u, (t))
  f32x16 pA0, pA1, pB0, pB1; float mnA, mnB, alA, alB; bf16x8 pa0, pa1, pa2, pa3; const int NT = u.NT;
  constexpr int SE = 0, SO = SDEPTH - 1;
  SLOAD(SE, ROW0(0)); asm volatile("s_waitcnt vmcnt(0)" ::: "memory"); SWRITE(0, SE); __syncthreads();
  qkt(pA0, pA1, K_lds, qr, r32, hi); mask_tile<MODE>(pA0, pA1, u, 0, wid, r32, hi, biasL); partialSM(pA0, pA1, m_reg, mnA, alA);
  SLOAD(SO, ROW0(1)); if constexpr (SDEPTH == 2) { if (2 < NT) SLOAD(SE, ROW0(2)); }
  SWAIT(); SWRITE(1, SO); __syncthreads();
  for (int j = 1; j + 1 < NT; j += 2) {
    SBAR(); qkt(pB0, pB1, (bf16_t*)((char*)K_lds + SHM_K), qr, r32, hi);
    finishSM(pA0, pA1, alA, l_reg, pa0, pa1, pa2, pa3); SBAR();
    SLOAD(SO, ROW0(j + SDEPTH)); SBAR();
    pv_d0(o, vb0, pa0, pa1, pa2, pa3); mask_tile<MODE>(pB0, pB1, u, j, wid, r32, hi, biasL); partialSM(pB0, pB1, m_reg, mnB, alB);
    __syncthreads(); SWAIT(); SWRITE(0, SE);
    RESC(alB); __syncthreads();
    SBAR(); qkt(pA0, pA1, K_lds, qr, r32, hi);
    finishSM(pB0, pB1, alB, l_reg, pa0, pa1, pa2, pa3); SBAR();
    if (SDEPTH == 1 || j + 3 < NT) SLOAD(SE, ROW0(j + 1 + SDEPTH)); SBAR();
    pv_d0(o, vb0 + (int)SHM_V, pa0, pa1, pa2, pa3); mask_tile<MODE>(pA0, pA1, u, j + 1, wid, r32, hi, biasL); partialSM(pA0, pA1, m_reg, mnA, alA);
    __syncthreads(); SWAIT(); SWRITE(1, SO);
    RESC(alA); __syncthreads();
  }
  SBAR(); qkt(pB0, pB1, (bf16_t*)((char*)K_lds + SHM_K), qr, r32, hi);
  finishSM(pA0, pA1, alA, l_reg, pa0, pa1, pa2, pa3); SBAR();
  pv_d0(o, vb0, pa0, pa1, pa2, pa3); mask_tile<MODE>(pB0, pB1, u, NT - 1, wid, r32, hi, biasL); partialSM(pB0, pB1, m_reg, mnB, alB);
  __syncthreads(); RESC(alB);
  finishSM(pB0, pB1, alB, l_reg, pa0, pa1, pa2, pa3); SBAR();
  pv_d0(o, vb0 + (int)SHM_V, pa0, pa1, pa2, pa3);
  l_reg += __builtin_amdgcn_exp2f(u.sink_l2e - m_reg * (SCALE * 1.4426950408889634f));
  if (hi == 0) li_l[r32] = l_reg; asm volatile("s_waitcnt lgkmcnt(0)" ::: "memory");
  float rli[16];
#pragma unroll
  for (int r = 0; r < 16; ++r) rli[r] = __builtin_amdgcn_rcpf(li_l[crow(r, hi)]);
  bf16_t* Ow = u.O + (long)(wid * QBLK) * u.ldo;
#pragma unroll
  for (int r = 0; r < 16; ++r) { int orow = crow(r, hi);
#pragma unroll
    for (int d0 = 0; d0 < 4; ++d0) { const float v = o[d0][r] * rli[r]; Ow[(long)orow * u.ldo + d0 * 32 + r32] = (bf16_t)(cvt_pk_bf16(v, v) & 0xffffu); } }
  __syncthreads();
#undef SLOAD
#undef SWRITE
#undef SWAIT
#undef RESC
#undef ROW0
}
#undef KSWZ
#undef SBAR
}

struct Args { const float* in[22]; float* out; unsigned char* ws; int ph_lo, ph_hi; };
enum { I_X = 0, I_C, I_CTX, I_CCTX, I_ADAW, I_ADAB, I_NORMG, I_WG, I_WU, I_WD, I_ABIN, I_ABOUT, I_NAQG, I_NAKG, I_NABIAS, I_SWQG, I_SWKG, I_SINK, I_GIN, I_GOUT, I_GQG, I_GKG };

__device__ __forceinline__ unsigned f2bf(float f) { unsigned u = __builtin_bit_cast(unsigned, f); return (u + 0x7fffu + ((u >> 16) & 1u)) >> 16; }
__device__ __forceinline__ unsigned pk2(float lo, float hi) { return f2bf(lo) | (f2bf(hi) << 16); }
__device__ __forceinline__ void transpose_item(const float* __restrict__ W, int K, int N, bf16_t* WT, int mode, LAS float* scr, int item, int lane) {
    const int nblk = N / 32, kb = item / nblk, nb = item % nblk, k0 = 64 * kb, n0 = 32 * nb;
#pragma unroll 8
    for (int i = 0; i < 32; ++i) { const int kk = 2 * i + (lane >> 5); scr[kk * 33 + (lane & 31)] = W[(size_t)(k0 + kk) * N + n0 + (lane & 31)]; }
    asm volatile("s_waitcnt lgkmcnt(0)" ::: "memory");
    const int c = lane & 7;
    const int rbase = (mode == 0) ? n0 : ((n0 >> 7) * 256 + (n0 & 127) + (mode == 2 ? 128 : 0));
#pragma unroll
    for (int j = 0; j < 4; ++j) { const int n = (lane >> 3) + 8 * j; const LAS float* s = scr + (8 * c) * 33 + n;
        u32x4 o; o.x = pk2(s[0 * 33], s[1 * 33]); o.y = pk2(s[2 * 33], s[3 * 33]); o.z = pk2(s[4 * 33], s[5 * 33]); o.w = pk2(s[6 * 33], s[7 * 33]);
        *(u32x4*)(WT + (size_t)(rbase + n) * K + k0 + 8 * c) = o; }
    asm volatile("s_waitcnt lgkmcnt(0)" ::: "memory");
}
__device__ __forceinline__ void phase0(const Args& a, unsigned char* lds_g, int G) {
    const int tid = TID(), lane = tid & 63, wave = tid >> 6; const int bid = BID();
    float* sc = (float*)lds_g;
    float* red = sc + 4096;
    for (int i = tid; i < DM; i += 512) { const float c = a.in[I_C][i]; sc[i] = c / (1.0f + __expf(-c)); const float cc = a.in[I_CCTX][i]; sc[DM + i] = cc / (1.0f + __expf(-cc)); }
    __syncthreads();
    float* mod = (float*)(a.ws + WS_MOD);
    for (int unit = bid; unit < 256; unit += G) {
        const int layer = unit >> 7, col0 = (unit & 127) * 144;
        f32x4 a1 = {0.f, 0.f, 0.f, 0.f}, a2 = {0.f, 0.f, 0.f, 0.f};
        if (lane < 36) {
            const float* W = a.in[I_ADAW] + (size_t)layer * DM * NMODV + col0 + 4 * lane;
            for (int k = wave * 256; k < wave * 256 + 256; k += 8) {
                f32x4 w[8];
#pragma unroll
                for (int q = 0; q < 8; ++q) w[q] = __builtin_nontemporal_load((const f32x4*)(W + (size_t)(k + q) * NMODV));
#pragma unroll
                for (int q = 0; q < 8; ++q) { a1 += w[q] * sc[k + q]; a2 += w[q] * sc[DM + k + q]; }
            }
#pragma unroll
            for (int e = 0; e < 4; ++e) { red[(wave * 2 + 0) * 144 + 4 * lane + e] = a1[e]; red[(wave * 2 + 1) * 144 + 4 * lane + e] = a2[e]; }
        }
        __syncthreads();
        if (tid < 288) { const int v = tid / 144, j = tid % 144; float s = a.in[I_ADAB][layer * NMODV + col0 + j];
#pragma unroll
            for (int w = 0; w < 8; ++w) s += red[(w * 2 + v) * 144 + j];
            mod[(size_t)(layer * 2 + v) * NMODV + col0 + j] = s; }
        __syncthreads();
    }
    LAS float* scr = (LAS float*)((LAS unsigned char*)lds_g + wave * 16384);
    const int gw = bid * 8 + wave, NGW = G * 8;
    constexpr int I_GU1 = (DM / 64) * (FF / 32);
    constexpr int I_D1 = (FF / 64) * (DM / 32);
    constexpr int I_GU = 8 * I_GU1, I_D = 4 * I_D1, I_ABI = (DM / 64) * (AB_IN / 32), I_SQ = (DM / 64) * (DM / 32), I_GI = (DM / 64) * (C_IN / 32);
    constexpr int NITEMS = I_GU + I_D + I_ABI + I_SQ + I_GI + I_SQ;
    bf16_t* wgu = (bf16_t*)(a.ws + WS_WGU); bf16_t* wd = (bf16_t*)(a.ws + WS_WD);
    for (int it = gw; it < NITEMS; it += NGW) {
        int r = it;
        if (r < I_GU) { const int q = r / I_GU1, lf = q >> 1, gu = q & 1; r -= q * I_GU1;
            transpose_item((gu ? a.in[I_WU] : a.in[I_WG]) + (size_t)lf * DM * FF, DM, FF, wgu + (size_t)lf * WGU_ELEMS, 1 + gu, scr, r, lane); continue; }
        r -= I_GU;
        if (r < I_D) { const int lf = r / I_D1; r -= lf * I_D1; transpose_item(a.in[I_WD] + (size_t)lf * FF * DM, FF, DM, wd + (size_t)lf * WD_ELEMS, 0, scr, r, lane); continue; }
        r -= I_D;
        if (r < I_ABI) { transpose_item(a.in[I_ABIN], DM, AB_IN, (bf16_t*)(a.ws + WS_WABIN), 0, scr, r, lane); continue; }
        r -= I_ABI;
        if (r < I_SQ) { transpose_item(a.in[I_ABOUT], DM, DM, (bf16_t*)(a.ws + WS_WABOUT), 0, scr, r, lane); continue; }
        r -= I_SQ;
        if (r < I_GI) { transpose_item(a.in[I_GIN], DM, C_IN, (bf16_t*)(a.ws + WS_WGIN), 0, scr, r, lane); continue; }
        r -= I_GI;
        transpose_item(a.in[I_GOUT], DM, DM, (bf16_t*)(a.ws + WS_WGOUT), 0, scr, r, lane);
    }
}

__device__ __forceinline__ void modulate_phase(const float* xsrc, float* xcopy, const float* csrc, float* cdst, const float* part, int nsplit, const float* cgate, float ccoef,
                                               const float* g, const float* shift_l, const float* scale_l, const float* shift_c, const float* scale_c, bf16_t* h, int nrows, int G) {
    const int tid = TID(), lane = tid & 63, wave = tid >> 6;
    const int gw = BID() * 8 + wave, NGW = G * 8;
    for (int row = gw; row < nrows; row += NGW) {
        const bool isctx = row >= SEQ;
        f32x4 v[8];
        if (!isctx) {
            const f32x4* xr = (const f32x4*)(xsrc + (size_t)row * DM) + lane;
#pragma unroll
            for (int j = 0; j < 8; ++j) v[j] = xr[64 * j];
            if (xcopy) { f32x4* xo = (f32x4*)(xcopy + (size_t)row * DM) + lane;
#pragma unroll
                for (int j = 0; j < 8; ++j) xo[64 * j] = v[j]; }
        } else {
            const int r = row - SEQ;
            const f32x4* xr = (const f32x4*)(csrc + (size_t)r * DM) + lane;
#pragma unroll
            for (int j = 0; j < 8; ++j) v[j] = xr[64 * j];
            if (nsplit > 0) {
                f32x4 s[8];
#pragma unroll
                for (int j = 0; j < 8; ++j) s[j] = (f32x4){0.f, 0.f, 0.f, 0.f};
                for (int sp = 0; sp < nsplit; ++sp) { const f32x4* pr = (const f32x4*)(part + ((size_t)sp * 256 + r) * DM) + lane;
#pragma unroll
                    for (int j = 0; j < 8; ++j) s[j] += pr[64 * j]; }
#pragma unroll
                for (int j = 0; j < 8; ++j) { const f32x4 gt = *((const f32x4*)cgate + lane + 64 * j); v[j] += ccoef * gt * s[j]; }
            }
            if (cdst) { f32x4* xo = (f32x4*)(cdst + (size_t)r * DM) + lane;
#pragma unroll
                for (int j = 0; j < 8; ++j) xo[64 * j] = v[j]; }
        }
        float ss = 0.f;
#pragma unroll
        for (int j = 0; j < 8; ++j) ss += (v[j].x * v[j].x + v[j].y * v[j].y) + (v[j].z * v[j].z + v[j].w * v[j].w);
        const float rstd = 1.0f / sqrtf(wave_sum(ss) * (1.0f / DM) + EPS);
        const f32x4* sh = (const f32x4*)(isctx ? shift_c : shift_l) + lane; const f32x4* scl = (const f32x4*)(isctx ? scale_c : scale_l) + lane;
        const f32x4* gg = (const f32x4*)g + lane;
        u32x2* ho = (u32x2*)(h + (size_t)row * DM) + lane;
#pragma unroll
        for (int j = 0; j < 8; ++j) { const f32x4 y = (v[j] * rstd) * gg[64 * j]; const f32x4 z = y * (scl[64 * j] + 1.0f) + sh[64 * j];
            u32x2 w; w.x = cvt_pk_bf16(z.x, z.y); w.y = cvt_pk_bf16(z.z, z.w); ho[64 * j] = w; }
    }
}

__device__ __forceinline__ void qknorm_phase(const Args& a, int layer, int G, bf16_t* Pout) {
    const int tid = TID(), lane = tid & 63, wave = tid >> 6, hw = lane >> 5, l5 = lane & 31;
    const int gw = BID() * 8 + wave, NGW = G * 8;
    bf16_t* P = (bf16_t*)(a.ws + WS_P); const int ld = layer == 0 ? AB_IN : C_IN;
    const int npairs = layer == 0 ? 13 : 10;
    const int d0 = 2 * l5, d1 = d0 + 1;
    const float inv0 = exp2f(-(float)(d0 & 31) * (13.287712379549449f / 32.0f)), inv1 = exp2f(-(float)(d1 & 31) * (13.287712379549449f / 32.0f));
    for (int row = gw; row < MT; row += NGW) {
        const bool isctx = row >= SEQ;
        const float pos = (l5 < 16) ? (float)(row >> 6) : (float)(row & 63);
        float c0 = 1.f, s0 = 0.f, c1 = 1.f, s1 = 0.f;
        if (!isctx) { float rv0 = pos * inv0 * 0.15915494309189535f, rv1 = pos * inv1 * 0.15915494309189535f; rv0 -= floorf(rv0); rv1 -= floorf(rv1);
            s0 = __builtin_amdgcn_sinf(rv0); c0 = __builtin_amdgcn_cosf(rv0); s1 = __builtin_amdgcn_sinf(rv1); c1 = __builtin_amdgcn_cosf(rv1); }
        bf16_t* prow = P + (size_t)row * ld; bf16_t* orow = Pout + (size_t)row * ld;
        for (int it = 0; it < npairs; ++it) {
            int slot = 2 * it + hw; const float* gain; bool rope;
            if (layer == 0) { if (slot >= 24) slot += 8;
                if (slot < 8) { gain = a.in[I_NAQG]; rope = false; } else if (slot < 16) { gain = a.in[I_SWQG]; rope = true; }
                else if (slot < 24) { gain = a.in[I_NAKG]; rope = false; } else { gain = a.in[I_SWKG]; rope = true; } }
            else { if (slot < 16) gain = a.in[I_GQG]; else gain = a.in[I_GKG]; rope = true; }
            unsigned* p1 = (unsigned*)(prow + slot * 128 + d0); unsigned* p2 = (unsigned*)(prow + slot * 128 + 64 + d0);
            const unsigned w1 = *p1, w2 = *p2;
            float x10 = __uint_as_float(w1 << 16), x11 = __uint_as_float(w1 & 0xffff0000u), x20 = __uint_as_float(w2 << 16), x21 = __uint_as_float(w2 & 0xffff0000u);
            float ss = x10 * x10 + x11 * x11 + x20 * x20 + x21 * x21;
#pragma unroll
            for (int o = 1; o < 32; o <<= 1) ss += __shfl_xor(ss, o);
            const float rstd = 1.0f / sqrtf(ss * (1.0f / 128.0f) + EPS);
            x10 = x10 * rstd * gain[d0]; x11 = x11 * rstd * gain[d1]; x20 = x20 * rstd * gain[64 + d0]; x21 = x21 * rstd * gain[64 + d1];
            float y10 = x10, y11 = x11, y20 = x20, y21 = x21;
            if (rope && !isctx) { y10 = x10 * c0 - x20 * s0; y20 = x10 * s0 + x20 * c0; y11 = x11 * c1 - x21 * s1; y21 = x11 * s1 + x21 * c1; }
            *(unsigned*)(orow + slot * 128 + d0) = cvt_pk_bf16(y10, y11); *(unsigned*)(orow + slot * 128 + 64 + d0) = cvt_pk_bf16(y20, y21);
        }
    }
}

__device__ __forceinline__ void attn_phase0(const Args& a, unsigned char* lds_g, int G) {
    bf16_t* P = (bf16_t*)(a.ws + WS_P); bf16_t* O = (bf16_t*)(a.ws + WS_O);
    float* biasL = (float*)(lds_g + att::BIAS_OFF);
    const int tid0 = TID();
    for (int un = BID(); un < 528; un += G) {
        att::UnitP u; u.ldq = AB_IN; u.ldk = AB_IN; u.ldo = DM; u.sink_l2e = -INFINITY;
        if (un < 256) {
            const int h = un & 7, qb = un >> 3;
            for (int i = tid0; i < 465; i += 512) biasL[i] = a.in[I_NABIAS][h * 465 + i] * att::INV_SCALE;
            __syncthreads();
            u.Q = P + (size_t)(256 * qb) * AB_IN + h * 128; u.K = P + (16 + h) * 128; u.V = P + (24 + h) * 128; u.O = O + (size_t)(256 * qb) * DM + h * 128;
            u.NT = 16; u.base_row = 0; u.qb = qb;
            att::attn_unit<att::NA, 1>(u, (char*)lds_g);
        } else if (un < 512) {
            const int hq = (un - 256) & 7, qb = (un - 256) >> 3, kvh = hq >> 2;
            u.Q = P + (size_t)(256 * qb) * AB_IN + (8 + hq) * 128; u.K = P + (32 + kvh) * 128; u.V = P + (34 + kvh) * 128; u.O = O + (size_t)(256 * qb) * DM + (8 + hq) * 128;
            u.NT = 12; u.base_row = 0; u.qb = qb; u.sink_l2e = a.in[I_SINK][hq] * 1.4426950408889634f;
            att::attn_unit<att::SW, 1>(u, (char*)lds_g);
        } else {
            const int hh = un - 512;
            u.Q = P + (size_t)SEQ * AB_IN + hh * 128; u.O = O + (size_t)SEQ * DM + hh * 128;
            const bool nah = hh < 8; const int hq = nah ? 0 : hh - 8, kvh = hq >> 2;
            const int kslot = nah ? 16 + hh : 32 + kvh, vslot = nah ? 24 + hh : 34 + kvh;
            u.K = P + kslot * 128; u.V = P + vslot * 128;
            const float sk = a.in[I_SINK][hq] * 1.4426950408889634f; u.sink_l2e = nah ? -INFINITY : sk;
            u.NT = 4; u.base_row = SEQ; u.qb = 0;
            att::attn_unit<att::DENSE, 2>(u, (char*)lds_g);
        }
    }
}
__device__ __forceinline__ void attn_phase1(const Args& a, unsigned char* lds_g, int G) {
    bf16_t* P = (bf16_t*)(a.ws + WS_P); bf16_t* O = (bf16_t*)(a.ws + WS_O);
    const int bid = BID();
    for (int i = 0;; ++i) {
        int un;
        if ((G & 7) == 0) { const int x = bid & 7, j = (bid >> 3) + i * (G >> 3); if (j >= 64) break; un = x * 64 + j; }
        else { un = bid + i * G; if (un >= 512) break; }
        const int h = un >> 5, qb = un & 31, kvh = h >> 2;
        att::UnitP u; u.ldq = C_IN; u.ldk = C_IN; u.ldo = DM; u.sink_l2e = -INFINITY;
        u.Q = P + (size_t)(256 * qb) * C_IN + h * 128; u.K = P + (16 + kvh) * 128; u.V = P + (20 + kvh) * 128; u.O = O + (size_t)(256 * qb) * DM + h * 128;
        u.NT = MT / 64; u.base_row = 0; u.qb = qb;
        att::attn_unit<att::DENSE, 2>(u, (char*)lds_g);
    }
}

#define XB_TMO      128
#define XB_XCNT(j)  (256  + 64 * (j))
#define XB_XSUB(j)  (1280 + 64 * (j))
#define XB_XGEN(j)  (2304 + 64 * (j))
#define XB_TOP      3328
#define XB_TOPGEN   3392
#define XCD_BAR_WORDS 3456
#define XB_SPIN_CAP (1u << 18)
__device__ __forceinline__ unsigned xb_ld(unsigned* p)              { return __hip_atomic_load(p, __ATOMIC_RELAXED, __HIP_MEMORY_SCOPE_AGENT); }
__device__ __forceinline__ unsigned xb_add(unsigned* p, unsigned v) { return __hip_atomic_fetch_add(p, v, __ATOMIC_RELAXED, __HIP_MEMORY_SCOPE_AGENT); }
__device__ __forceinline__ unsigned xb_xcc_id() { return (unsigned)__builtin_amdgcn_s_getreg((3 << 11) | 20) & 0xFu; }
#define XB_SPIN(cond, bar) do { unsigned _sp = 0; while (cond) { __builtin_amdgcn_s_sleep(1); \
    if ((++_sp & 255u) == 0u) { if (xb_ld(&(bar)[XB_TMO])) break; if (_sp > XB_SPIN_CAP) { atomicAdd(&(bar)[XB_TMO], 1u); break; } } } } while (0)
struct XcdBarrier { unsigned* bar; unsigned x; volatile LAS unsigned* st; };
__device__ __forceinline__ XcdBarrier xcd_barrier_post(unsigned* bar, volatile LAS unsigned* st) {
    XcdBarrier b; b.bar = bar; b.x = xb_xcc_id(); b.st = st;
    if (threadIdx.x == 0) (void)xb_add(&bar[XB_XCNT(b.x)], 1u);
    return b;
}
__device__ __forceinline__ void xcd_barrier_complete(unsigned* bar, unsigned x, unsigned& nloc, unsigned& nx) {
    const unsigned G = gridDim.x * gridDim.y * gridDim.z;
    unsigned sum, cnt, mine, sp = 0u;
    for (;;) {
        sum = 0u; cnt = 0u; mine = 0u;
#pragma unroll
        for (unsigned j = 0; j < 16; ++j) { const unsigned c = xb_ld(&bar[XB_XCNT(j)]); sum += c; cnt += (c > 0u) ? 1u : 0u; mine = (j == x) ? c : mine; }
        if (sum == G) break;
        __builtin_amdgcn_s_sleep(1);
        if ((++sp & 255u) == 0u) { if (xb_ld(&bar[XB_TMO])) break; if (sp > XB_SPIN_CAP) { atomicAdd(&bar[XB_TMO], 1u); break; } }
    }
    nloc = mine > 0u ? mine : 1u; nx = cnt > 0u ? cnt : 1u;
}
__device__ __forceinline__ void xcd_barrier(const XcdBarrier& b) {
    asm volatile("s_waitcnt vmcnt(0)" ::: "memory");
    __syncthreads();
    if (threadIdx.x == 0) {
        unsigned* bar = b.bar;
        __builtin_amdgcn_s_waitcnt(0);
        unsigned nloc = b.st[0], nx = b.st[1];
        if (nloc == 0u) { xcd_barrier_complete(bar, b.x, nloc, nx); b.st[0] = nloc; b.st[1] = nx; }
        const unsigned old = xb_add(&bar[XB_XSUB(b.x)], 1u);
        const unsigned gen = old / nloc;
        if (old + 1u == (gen + 1u) * nloc) {
            __builtin_amdgcn_fence(__ATOMIC_RELEASE, "agent");
            asm volatile("s_waitcnt vmcnt(0)" ::: "memory");
            const unsigned og = xb_add(&bar[XB_TOP], 1u);
            const unsigned tg = og / nx;
            if (og + 1u == (tg + 1u) * nx) xb_add(&bar[XB_TOPGEN], 1u);
            else XB_SPIN(xb_ld(&bar[XB_TOPGEN]) == tg, bar);
            __builtin_amdgcn_fence(__ATOMIC_ACQUIRE, "agent");
            xb_add(&bar[XB_XGEN(b.x)], 1u);
            asm volatile("s_waitcnt vmcnt(0)" ::: "memory");
        } else {
            XB_SPIN(xb_ld(&bar[XB_XGEN(b.x)]) == gen, bar);
            __builtin_amdgcn_fence(__ATOMIC_ACQUIRE, "agent");
            asm volatile("s_waitcnt vmcnt(0)" ::: "memory");
        }
    }
    __syncthreads();
}

__global__ void __launch_bounds__(512, 2) mk_fwd(Args a) {
    extern __shared__ __attribute__((aligned(16))) unsigned char lds[];
    cg::grid_group grid = cg::this_grid();
    const int G = gridDim.x;
    LAS unsigned char* lds3 = (LAS unsigned char*)lds;
    volatile LAS unsigned* misc = (volatile LAS unsigned*)(lds3 + MISC_OFF);
    if (threadIdx.x < 2) misc[threadIdx.x] = 0u;
    __syncthreads();
    XcdBarrier bar = xcd_barrier_post((unsigned*)(a.ws + WS_BAR), misc);
    float* mod = (float*)(a.ws + WS_MOD);
    float* xc = (float*)(a.ws + WS_XC); float* part = (float*)(a.ws + WS_PART);
    bf16_t* H = (bf16_t*)(a.ws + WS_H); bf16_t* O = (bf16_t*)(a.ws + WS_O); bf16_t* P = (bf16_t*)(a.ws + WS_P); bf16_t* A = (bf16_t*)(a.ws + WS_A);
    for (int ph = a.ph_lo; ph < a.ph_hi; ++ph) {
        if (ph == 0) { phase0(a, lds, G); if (REPMASK & 1) { __syncthreads(); phase0(a, lds, G); } }
        else {
            const int layer = (ph - 1) / 11, sub = (ph - 1) % 11;
            const float* mL = mod + (size_t)(layer * 2 + 0) * NMODV; const float* mC = mod + (size_t)(layer * 2 + 1) * NMODV;
            const bool with_ctx = layer == 0;
            if (sub == 0 || sub == 3 || sub == 8) {
                const int k = sub == 0 ? 0 : (sub == 3 ? 1 : 2);
                const bool first = (ph == 1);
                const float* xsrc = (ph <= 3) ? a.in[I_X] : a.out; float* xcopy = nullptr;
                const float* csrc = first ? a.in[I_CTX] : xc;
                const bool upd_prev = (sub == 0 && layer == 1);
                const int nsplit = (upd_prev || sub == 3) ? NSPLIT_DOWN : ((sub == 8) ? NSPLIT_OUT : 0);
                const float* cgate = upd_prev ? (mod + (size_t)(0 * 2 + 1) * NMODV + 8 * DM) : (sub == 3 ? mC + 2 * DM : mC + 5 * DM);
                const float ccoef = (sub == 8) ? 1.0f : 0.5f;
                const int nrows = (sub == 8 && !with_ctx) ? SEQ : MT;
                modulate_phase(xsrc, xcopy, csrc, xc, part, nsplit, cgate, ccoef, a.in[I_NORMG] + (size_t)(layer * 3 + k) * DM,
                               mL + (3 * k) * DM, mL + (3 * k + 1) * DM, mC + (3 * k) * DM, mC + (3 * k + 1) * DM, H, nrows, G);
                if (REPMASK & 64) modulate_phase(xsrc, nullptr, xc, nullptr, part, 0, cgate, ccoef, a.in[I_NORMG] + (size_t)(layer * 3 + k) * DM,
                               mL + (3 * k) * DM, mL + (3 * k + 1) * DM, mC + (3 * k) * DM, mC + (3 * k + 1) * DM, H, nrows, G);
            } else if (sub == 1 || sub == 9) {
                const int f = sub == 1 ? 0 : 1; const int nM = (f == 1 && !with_ctx) ? SEQ / 256 : MT / 256;
                pg8::Gemm g{H, (const bf16_t*)(a.ws + WS_WGU) + (size_t)(layer * 2 + f) * WGU_ELEMS, DM};
                pg8::Sched S; S.init(nM, 2 * FF / 256, DM, G, BID(), 0, 0, 0);
                pg8::EpiSwiGLU E{A, FF};
                pg8::gemm_phase<pg8::EpiSwiGLU, true, true>(lds3, g, S, E);
                if (REPMASK & 2) pg8::gemm_phase<pg8::EpiSwiGLU, true, true>(lds3, g, S, E);
            } else if (sub == 2 || sub == 10) {
                const int f = sub == 2 ? 0 : 1; const bool ctxrows = !(f == 1 && !with_ctx);
                pg8::Gemm g{A, (const bf16_t*)(a.ws + WS_WD) + (size_t)(layer * 2 + f) * WD_ELEMS, FF};
                pg8::Sched S; S.init(SEQ / 256, DM / 256, FF, G, BID(), ctxrows ? NSPLIT_DOWN : 0, NT_SPLIT_DOWN, SEQ / 256);
                pg8::EpiResid E{(ph == 3) ? a.in[I_X] : (const float*)a.out, a.out, mL + (f == 0 ? 2 : 8) * DM, 0.5f, part};
                pg8::gemm_phase<pg8::EpiResid, true, true>(lds3, g, S, E);
                if (REPMASK & 256) { pg8::EpiResid E2{(const float*)P, (float*)P, mL + (f == 0 ? 2 : 8) * DM, 0.5f, part}; pg8::gemm_phase<pg8::EpiResid, true, true>(lds3, g, S, E2); }
            } else if (sub == 4) {
                const int N = layer == 0 ? AB_IN : C_IN;
                pg8::Gemm g{H, (const bf16_t*)(a.ws + (layer == 0 ? WS_WABIN : WS_WGIN)), DM};
                pg8::Sched S; S.init(MT / 256, N / 256, DM, G, BID(), 0, 0, 0);
                pg8::EpiBf16 E{P, N};
                pg8::gemm_phase<pg8::EpiBf16, true, true>(lds3, g, S, E);
                if (REPMASK & 16) pg8::gemm_phase<pg8::EpiBf16, true, true>(lds3, g, S, E);
            } else if (sub == 5) { qknorm_phase(a, layer, G, P); if (REPMASK & 128) qknorm_phase(a, layer, G, A); }
            else if (sub == 6) { if (layer == 0) { attn_phase0(a, lds, G); if (REPMASK & 32) attn_phase0(a, lds, G); } else { attn_phase1(a, lds, G); if (REPMASK & 4) attn_phase1(a, lds, G); } }
            else if (sub == 7) {
                pg8::Gemm g{O, (const bf16_t*)(a.ws + (layer == 0 ? WS_WABOUT : WS_WGOUT)), DM};
                pg8::Sched S; S.init(SEQ / 256, DM / 256, DM, G, BID(), with_ctx ? NSPLIT_OUT : 0, NT_SPLIT_OUT, SEQ / 256);
                pg8::EpiResid E{a.out, a.out, mL + 5 * DM, 1.0f, part};
                pg8::gemm_phase<pg8::EpiResid, true, true>(lds3, g, S, E);
                if (REPMASK & 512) { pg8::EpiResid E2{(const float*)A, (float*)A, mL + 5 * DM, 1.0f, part}; pg8::gemm_phase<pg8::EpiResid, true, true>(lds3, g, S, E2); }
            }
        }
        if (ph + 1 < a.ph_hi) {
            if (a.ph_lo < 0) grid.sync(); else xcd_barrier(bar);
            if (REPMASK & 8) xcd_barrier(bar); }
    }
}

extern "C" void kernel_launch(void* const* d_in, const int* in_sizes, int n_in, void* d_out, int out_size, void* d_ws, size_t ws_size, hipStream_t stream) {
    static int grid = 0;
    if (grid == 0) {
        if (n_in != 22 || out_size != SEQ * DM || ws_size < WS_END) { fprintf(stderr, "kernel_launch: unexpected shapes (n_in %d out %d ws %zu)\n", n_in, out_size, ws_size); grid = -1; return; }
        int dev = 0, cus = 0, per_cu = 0;
        hipGetDevice(&dev); hipDeviceGetAttribute(&cus, hipDeviceAttributeMultiprocessorCount, dev);
        if (hipFuncSetAttribute((const void*)mk_fwd, hipFuncAttributeMaxDynamicSharedMemorySize, LDS_BYTES) != hipSuccess) { fprintf(stderr, "kernel_launch: hipFuncSetAttribute failed\n"); grid = -1; return; }
        if (hipOccupancyMaxActiveBlocksPerMultiprocessor(&per_cu, (const void*)mk_fwd, 512, LDS_BYTES) != hipSuccess || per_cu < 1) { fprintf(stderr, "kernel_launch: occupancy query gave %d\n", per_cu); per_cu = 1; }
        (void)hipGetLastError();
        grid = cus * per_cu;
        if (grid > 256) grid = 256;
    }
    if (grid < 0) return;
    if (hipMemsetAsync((char*)d_ws + WS_BAR, 0, BAR_BYTES, stream) != hipSuccess) { fprintf(stderr, "kernel_launch: memset failed\n"); return; }
    Args a{};
    for (int i = 0; i < 22; ++i) a.in[i] = (const float*)d_in[i];
    a.out = (float*)d_out; a.ws = (unsigned char*)d_ws;
#if MK_MULTI
    for (int p = 0; p < NPHASE; ++p) { a.ph_lo = p; a.ph_hi = p + 1; hipLaunchKernelGGL(mk_fwd, dim3(grid), dim3(512), LDS_BYTES, stream, a); }
#else
    a.ph_lo = 0; a.ph_hi = NPHASE;
    void* args[] = {&a};
    hipError_t e = hipLaunchCooperativeKernel((const void*)mk_fwd, dim3(grid), dim3(512), args, LDS_BYTES, stream);
    if (e != hipSuccess) fprintf(stderr, "cooperative launch failed: %s (grid %d)\n", hipGetErrorString(e), grid);
#endif
}
```

```cpp
#include <hip/hip_runtime.h>
#include <hip/hip_cooperative_groups.h>
#include <cstdio>
#include <cstdint>
namespace cg = cooperative_groups;

#ifndef REPMASK
#define REPMASK 0
#endif
#ifndef MK_MULTI
#define MK_MULTI 0
#endif

constexpr int SEQ = 8192, CTXL = 256, MT = SEQ + CTXL, DM = 2048, FF = 5632, NMODV = 9 * DM;
constexpr int AB_IN = 4608, C_IN = 3072, GRIDW = 64;
constexpr float EPS = 1e-6f;
constexpr int NPHASE = 21;
constexpr int NSPLIT_DOWN = 22, NT_SPLIT_DOWN = 4;
constexpr int NSPLIT_OUT = 16, NT_SPLIT_OUT = 2;

constexpr size_t MiB = 1u << 20;
constexpr size_t WS_MOD = 0;
constexpr size_t WS_BAR = 512 * 1024, BAR_BYTES = 16384;
constexpr size_t WS_XC = 1 * MiB;
constexpr size_t WS_PART = 4 * MiB;
constexpr size_t WS_H = 52 * MiB;
constexpr size_t WS_O = 88 * MiB;
constexpr size_t WS_P = 124 * MiB;
constexpr size_t WS_A = 200 * MiB;
constexpr size_t WS_WGU = 292 * MiB;
constexpr size_t WS_WD = 468 * MiB;
constexpr size_t WS_WABIN = 556 * MiB;
constexpr size_t WS_WABOUT = 574 * MiB;
constexpr size_t WS_WGIN = 582 * MiB;
constexpr size_t WS_WGOUT = 594 * MiB;
constexpr size_t WS_END = 602 * MiB;
constexpr size_t WGU_ELEMS = (size_t)2 * FF * DM, WD_ELEMS = (size_t)DM * FF;

constexpr int LDS_BYTES = 143360;
constexpr int XCH_OFF = 131072;
constexpr int MISC_OFF = 141312;

typedef unsigned short bf16_t;
typedef short bf16x8 __attribute__((ext_vector_type(8)));
typedef short s16x4 __attribute__((ext_vector_type(4)));
typedef float f32x4 __attribute__((ext_vector_type(4)));
typedef float f32x2 __attribute__((ext_vector_type(2)));
typedef float f32x16 __attribute__((ext_vector_type(16)));
typedef unsigned u32x4 __attribute__((ext_vector_type(4)));
typedef unsigned u32x2 __attribute__((ext_vector_type(2)));
#define LAS __attribute__((address_space(3)))

__device__ __forceinline__ unsigned cvt_pk_bf16(float lo, float hi) { unsigned r; asm volatile("v_cvt_pk_bf16_f32 %0, %1, %2" : "=v"(r) : "v"(lo), "v"(hi)); return r; }
__device__ __forceinline__ int TID() { int t = threadIdx.x; asm volatile("" : "+v"(t)); return t; }
__device__ __forceinline__ int BID() { int b = blockIdx.x; asm volatile("" : "+s"(b)); return b; }
__device__ __forceinline__ float bf2f(unsigned short b) { return __uint_as_float(((unsigned)b) << 16); }
__device__ __forceinline__ float wave_sum(float v) {
#pragma unroll
    for (int o = 1; o < 64; o <<= 1) v += __shfl_xor(v, o);
    return v;
}

namespace pg8 {
constexpr int BM = 256, BK = 64, HALF = 128, HTB = HALF * BK * 2, STAGE_BYTES = 8 * HTB, NXCD = 8, WGM = 8;
__host__ __device__ __forceinline__ int lds_byte(int r, int c) { const int st = (r >> 4) * 2 + (c >> 5), rr = r & 15, cc = c & 31, ob = rr * 64 + cc * 2; return st * 1024 + (ob ^ (((ob >> 9) & 1) << 5)); }
__host__ __device__ __forceinline__ void stage_rc(int b, int& R, int& C) { const int st = b / 1024, sb = b % 1024, swz = sb ^ (((sb >> 9) & 1) << 5); R = (st >> 1) * 16 + swz / 64; C = (st & 1) * 32 + (swz % 64) / 2; }
__host__ __device__ __forceinline__ int perm32(int rho) { const int n = rho >> 4, i = rho & 15; return 8 * (i >> 2) + 4 * n + (i & 3); }

__host__ __device__ __forceinline__ int permrope(int s) { return 64 * ((s >> 4) & 1) + 16 * (s >> 5) + (s & 15); }
struct Unit { int pm, pn, k0, nt, split; };
struct Gemm { const bf16_t* A; const bf16_t* Bt; int K; };

struct Sched {
    int nM, nN, nwg, G, c, nt_full, nsplit_units, split_nt, split_pm;
    __device__ __forceinline__ void init(int nM_, int nN_, int K, int G_, int c_, int nsplit, int snt, int spm) {
        nM = nM_; nN = nN_; nwg = nM * nN; G = G_; c = c_; nt_full = K / BK; nsplit_units = nsplit * nN_; split_nt = snt; split_pm = spm; }
    __device__ __forceinline__ bool next(int i, Unit& u) const {
        const long L = (long)i * G + c;
        const bool reg = L < nwg; const int s = reg ? 0 : (int)(L - nwg);
        if (!reg && s >= nsplit_units) return false;
        int wgid = reg ? (int)L : 0; { const int q = nwg / NXCD, r = nwg % NXCD, xcd = wgid % NXCD, off = wgid / NXCD; wgid = (xcd < r ? xcd * (q + 1) : r * (q + 1) + (xcd - r) * q) + off; }
        const int nig = WGM * nN, gid = wgid / nig, fm = gid * WGM, gsz = (nM - fm) < WGM ? (nM - fm) : WGM;
        const int pm_r = fm + ((wgid % nig) % gsz), pn_r = (wgid % nig) / gsz;
        const int pn_s = s % nN, sp_s = s / nN;
        u.pm = __builtin_amdgcn_readfirstlane(reg ? pm_r : split_pm); u.pn = __builtin_amdgcn_readfirstlane(reg ? pn_r : pn_s);
        u.split = __builtin_amdgcn_readfirstlane(reg ? -1 : sp_s); u.k0 = __builtin_amdgcn_readfirstlane(reg ? 0 : sp_s * split_nt); u.nt = __builtin_amdgcn_readfirstlane(reg ? nt_full : split_nt);
        return true;
    }
};

__device__ __forceinline__ float silu_mul(float g, float u) { const float e = __builtin_amdgcn_exp2f(-g * 1.4426950408889634f); return g * __builtin_amdgcn_rcpf(1.0f + e) * u; }
struct EpiSwiGLU {
    static constexpr int PERM = 1;
    bf16_t* O; int ldc;
    __device__ __forceinline__ void operator()(const f32x4 (&acc)[2][2][4][2], const Unit& u, int wr, int wc, int fr, int fq) const {
        asm volatile("" : "+v"(fr), "+v"(fq));
        const int row0 = u.pm * BM + wr * 64 + fr; const int col0 = u.pn * HALF + wc * 32 + 8 * fq;
#pragma unroll
        for (int ai = 0; ai < 2; ++ai)
#pragma unroll
            for (int m = 0; m < 4; ++m) { bf16_t* rowp = O + (size_t)(row0 + ai * HALF + m * 16) * ldc + col0;
                const f32x4 g0 = acc[ai][0][m][0], g1 = acc[ai][0][m][1], u0 = acc[ai][1][m][0], u1 = acc[ai][1][m][1];
                u32x4 w; w.x = cvt_pk_bf16(silu_mul(g0[0], u0[0]), silu_mul(g0[1], u0[1])); w.y = cvt_pk_bf16(silu_mul(g0[2], u0[2]), silu_mul(g0[3], u0[3]));
                w.z = cvt_pk_bf16(silu_mul(g1[0], u1[0]), silu_mul(g1[1], u1[1])); w.w = cvt_pk_bf16(silu_mul(g1[2], u1[2]), silu_mul(g1[3], u1[3]));
                *(u32x4*)rowp = w; }
    }
};
struct EpiResid {
    static constexpr int PERM = 0;
    const float* Xs; float* X; const float* gate; float coef; float* part;
    __device__ __forceinline__ void operator()(const f32x4 (&acc)[2][2][4][2], const Unit& u, int wr, int wc, int fr, int fq) const {
        asm volatile("" : "+v"(fr), "+v"(fq));
        const int col0 = u.pn * BM + wc * 32 + 4 * fq;
        if (u.split < 0) {
            f32x4 gv[2][2];
#pragma unroll
            for (int bj = 0; bj < 2; ++bj)
#pragma unroll
                for (int n = 0; n < 2; ++n) gv[bj][n] = *(const f32x4*)(gate + col0 + bj * HALF + n * 16) * coef;
#pragma unroll
            for (int ai = 0; ai < 2; ++ai)
#pragma unroll
                for (int m = 0; m < 4; ++m) { const size_t roff = (size_t)(u.pm * BM + ai * HALF + wr * 64 + m * 16 + fr) * DM + col0; float* rowp = X + roff; const float* rows = Xs + roff;
#pragma unroll
                    for (int bj = 0; bj < 2; ++bj)
#pragma unroll
                        for (int n = 0; n < 2; ++n) { *(f32x4*)(rowp + bj * HALF + n * 16) = *(const f32x4*)(rows + bj * HALF + n * 16) + gv[bj][n] * acc[ai][bj][m][n]; }
                    asm volatile("" ::: "memory"); }
        } else {
            float* base = part + (size_t)u.split * 256 * DM;
#pragma unroll
            for (int ai = 0; ai < 2; ++ai)
#pragma unroll
                for (int m = 0; m < 4; ++m) { float* rowp = base + (size_t)(ai * HALF + wr * 64 + m * 16 + fr) * DM + col0;
#pragma unroll
                    for (int bj = 0; bj < 2; ++bj)
#pragma unroll
                        for (int n = 0; n < 2; ++n) *(f32x4*)(rowp + bj * HALF + n * 16) = acc[ai][bj][m][n]; }
        }
    }
};

struct EpiQK {
    static constexpr int PERM = 2;
    bf16_t* O; int ldc; int layer; const float* g0; const float* g1; const float* g2; const float* g3; LAS float* xch;
    __device__ __forceinline__ void operator()(const f32x4 (&acc)[2][2][4][2], const Unit& u, int wr, int wc, int fr, int fq) const {
        asm volatile("" : "+v"(fr), "+v"(fq));
        const int pn = u.pn;
        const float* const q0 = g0; const float* const q1 = g1; const float* const q2 = g2; const float* const q3 = g3; const int lay = layer;
        const int kind0 = (pn < 4) ? 1 : ((pn < 8) ? 2 : ((pn < 12) ? 1 : ((pn == 16) ? 2 : 0))), kind1 = (pn < 10) ? 2 : 0;
        const float* const gain0 = (pn < 4) ? q0 : ((pn < 8) ? q1 : ((pn < 12) ? q2 : q3)); const float* const gain1 = (pn < 8) ? q0 : q1;
        const int kind = lay == 0 ? kind0 : kind1; const float* const gain = lay == 0 ? gain0 : gain1;
        const bool latent = u.pm < SEQ / 256;
        const int dl = 16 * wc + 4 * fq;
        bf16_t* obase = O + (size_t)(u.pm * BM + wr * 64 + fr) * ldc + pn * BM + dl;
        if (kind == 0) {
#pragma unroll
            for (int ai = 0; ai < 2; ++ai)
#pragma unroll
                for (int m = 0; m < 4; ++m)
#pragma unroll
                    for (int bj = 0; bj < 2; ++bj) { bf16_t* p = obase + (size_t)(ai * HALF + m * 16) * ldc + bj * HALF; const f32x4 x1 = acc[ai][bj][m][0], x2 = acc[ai][bj][m][1];
                        u32x2 w1, w2; w1.x = cvt_pk_bf16(x1[0], x1[1]); w1.y = cvt_pk_bf16(x1[2], x1[3]); w2.x = cvt_pk_bf16(x2[0], x2[1]); w2.y = cvt_pk_bf16(x2[2], x2[3]);
                        *(u32x2*)p = w1; *(u32x2*)(p + 64) = w2; }
            return;
        }
        LAS float* xr = xch + ((wr * 128 + fr) * 8 + wc);
#pragma unroll
        for (int ai = 0; ai < 2; ++ai)
#pragma unroll
            for (int m = 0; m < 4; ++m)
#pragma unroll
                for (int bj = 0; bj < 2; ++bj) { const f32x4 x1 = acc[ai][bj][m][0], x2 = acc[ai][bj][m][1];
                    float s = (x1[0] * x1[0] + x1[1] * x1[1]) + (x1[2] * x1[2] + x1[3] * x1[3]) + (x2[0] * x2[0] + x2[1] * x2[1]) + (x2[2] * x2[2] + x2[3] * x2[3]);
                    s += __shfl_xor(s, 16); s += __shfl_xor(s, 32);
                    if (fq == 0) xr[(ai * 64 + m * 16) * 8 + bj * 4] = s; }
        asm volatile("s_waitcnt lgkmcnt(0)" ::: "memory"); __builtin_amdgcn_s_barrier(); asm volatile("" ::: "memory");
        const f32x4 ga = *(const f32x4*)(gain + dl), gb = *(const f32x4*)(gain + 64 + dl);
        const bool rope = (kind == 2) && latent;
        float inv[4];
#pragma unroll
        for (int j = 0; j < 4; ++j) inv[j] = exp2f(-(float)((dl + j) & 31) * (13.287712379549449f / 32.0f)) * 0.15915494309189535f;
#pragma unroll
        for (int ai = 0; ai < 2; ++ai)
#pragma unroll
            for (int m = 0; m < 4; ++m) {
                const int row = u.pm * BM + ai * HALF + wr * 64 + m * 16 + fr;
                float cs[4], sn[4];
#pragma unroll
                for (int j = 0; j < 4; ++j) { cs[j] = 1.f; sn[j] = 0.f; }
                if (rope) { const float pos = (wc < 2) ? (float)(row >> 6) : (float)(row & 63);
#pragma unroll
                    for (int j = 0; j < 4; ++j) { float rv = pos * inv[j]; rv -= floorf(rv); sn[j] = __builtin_amdgcn_sinf(rv); cs[j] = __builtin_amdgcn_cosf(rv); } }
#pragma unroll
                for (int bj = 0; bj < 2; ++bj) {
                    const f32x4 pr = *(const LAS f32x4*)(xch + ((wr * 128 + ai * 64 + m * 16 + fr) * 8 + bj * 4));
                    const float rstd = 1.0f / sqrtf(((pr[0] + pr[1]) + (pr[2] + pr[3])) * (1.0f / 128.0f) + EPS);
                    const f32x4 x1 = acc[ai][bj][m][0] * rstd * ga, x2 = acc[ai][bj][m][1] * rstd * gb;
                    float y1[4], y2[4];
#pragma unroll
                    for (int j = 0; j < 4; ++j) { y1[j] = x1[j] * cs[j] - x2[j] * sn[j]; y2[j] = x1[j] * sn[j] + x2[j] * cs[j]; }
                    bf16_t* p = obase + (size_t)(ai * HALF + m * 16) * ldc + bj * HALF;
                    u32x2 w1, w2; w1.x = cvt_pk_bf16(y1[0], y1[1]); w1.y = cvt_pk_bf16(y1[2], y1[3]); w2.x = cvt_pk_bf16(y2[0], y2[1]); w2.y = cvt_pk_bf16(y2[2], y2[3]);
                    *(u32x2*)p = w1; *(u32x2*)(p + 64) = w2; }
            }
    }
};

template <class Epi, bool ALIGN_EPI, bool SP2>
__device__ __forceinline__ void gemm_phase(LAS unsigned char* lds, const Gemm g, const Sched& S, const Epi& E) {
    const int tid = TID(), wid = __builtin_amdgcn_readfirstlane(tid >> 6), lane = tid & 63, wr = wid >> 2, wc = wid & 3, fr = lane & 15, fq = lane >> 4;
    const int K = g.K;
    unsigned voffA[2], voffB[2];
#pragma unroll
    for (int i = 0; i < 2; ++i) { int R, C; stage_rc(tid * 16 + i * 8192, R, C); const int Rb = Epi::PERM == 1 ? ((R & ~31) + perm32(R & 31)) : (Epi::PERM == 2 ? ((R & ~127) + permrope(R & 127)) : R);
        voffA[i] = (unsigned)(R * K + C) * 2u; voffB[i] = (unsigned)(Rb * K + C) * 2u; }
    const size_t kstep = (size_t)(BK * 2);
    const size_t hstep = (size_t)HALF * K * 2;
    const size_t tstep = 2 * hstep;
    const unsigned ldsw = (unsigned)wid * 1024u;
    const int aoff = lds_byte(wr * 64 + fr, fq * 8), boff = lds_byte(wc * 32 + fr, fq * 8);
#define PG8_SA(b, h) (((b) * 2 + (h)) * HTB)
#define PG8_SB(b, h) ((4 + (b) * 2 + (h)) * HTB)
#define PG8_STAGE(bufoff, gbase, voff) do { _Pragma("unroll") for (int _i = 0; _i < 2; ++_i) \
        __builtin_amdgcn_global_load_lds((const unsigned*)((const char*)(gbase) + (voff)[_i]), (LAS unsigned*)(lds + (bufoff) + ldsw + _i * 8192), 16, 0, 0); } while (0)
#define PG8_LDA(dst, b, h) do { _Pragma("unroll") for (int m = 0; m < 4; ++m) _Pragma("unroll") for (int k = 0; k < 2; ++k) dst[m][k] = *(const LAS bf16x8*)(lds + PG8_SA(b, h) + aoff + m * 2048 + k * 1024); } while (0)
#define PG8_LDB(dst, b, h) do { _Pragma("unroll") for (int n = 0; n < 2; ++n) _Pragma("unroll") for (int k = 0; k < 2; ++k) dst[n][k] = *(const LAS bf16x8*)(lds + PG8_SB(b, h) + boff + n * 2048 + k * 1024); } while (0)
#define PG8_MMA(ai, bj, At, Bt) do { __builtin_amdgcn_s_setprio(1); _Pragma("unroll") for (int m = 0; m < 4; ++m) _Pragma("unroll") for (int n = 0; n < 2; ++n) _Pragma("unroll") for (int k = 0; k < 2; ++k) \
        acc[ai][bj][m][n] = __builtin_amdgcn_mfma_f32_16x16x32_bf16(Bt[n][k], At[m][k], acc[ai][bj][m][n], 0, 0, 0); __builtin_amdgcn_s_setprio(0); } while (0)
#define PG8_WAIT_V(n) asm volatile("s_waitcnt vmcnt(" #n ")" ::: "memory")
#define PG8_WAIT_L(n) asm volatile("s_waitcnt lgkmcnt(" #n ")" ::: "memory")
#define PG8_BAR __builtin_amdgcn_s_barrier()
#define PG8_SCHED __builtin_amdgcn_sched_barrier(0)
    Unit cur, nxt; int ui = 0;
    if (!S.next(0, cur)) return;
    f32x4 acc[2][2][4][2];
#pragma unroll
    for (int a = 0; a < 2; ++a)
#pragma unroll
        for (int b = 0; b < 2; ++b)
#pragma unroll
            for (int m = 0; m < 4; ++m)
#pragma unroll
                for (int n = 0; n < 2; ++n) acc[a][b][m][n] = (f32x4){0.f, 0.f, 0.f, 0.f};
    bf16x8 At[4][2], B0[2][2], B1[2][2];
    const char* cA = (const char*)g.A + (size_t)cur.pm * tstep + (size_t)cur.k0 * kstep; const char* cB = (const char*)g.Bt + (size_t)cur.pn * tstep + (size_t)cur.k0 * kstep;
    if constexpr (SP2) {
        PG8_STAGE(PG8_SB(0, 0), cB, voffB); PG8_STAGE(PG8_SB(0, 1), cB + hstep, voffB); PG8_STAGE(PG8_SA(0, 0), cA, voffA); PG8_STAGE(PG8_SA(0, 1), cA + hstep, voffA);
        if (wr == 1) PG8_BAR;
        PG8_WAIT_V(2); PG8_BAR;
        PG8_STAGE(PG8_SB(1, 0), cB + kstep, voffB); PG8_STAGE(PG8_SA(1, 0), cA + kstep, voffA); PG8_STAGE(PG8_SB(1, 1), cB + hstep + kstep, voffB);
        PG8_WAIT_V(6); PG8_BAR;
    } else {
        PG8_STAGE(PG8_SB(0, 0), cB, voffB); PG8_STAGE(PG8_SA(0, 0), cA, voffA); PG8_STAGE(PG8_SB(0, 1), cB + hstep, voffB); PG8_STAGE(PG8_SA(0, 1), cA + hstep, voffA);
        if (wr == 1) PG8_BAR;
        PG8_WAIT_V(4); PG8_BAR;
        PG8_STAGE(PG8_SB(1, 0), cB + kstep, voffB); PG8_STAGE(PG8_SA(1, 0), cA + kstep, voffA); PG8_STAGE(PG8_SB(1, 1), cB + hstep + kstep, voffB);
        PG8_WAIT_V(6); PG8_BAR;
    }
    for (;;) {
        const bool has_next = S.next(ui + 1, nxt);
        const int nt = cur.nt;
        const char* nA = has_next ? (const char*)g.A + (size_t)nxt.pm * tstep + (size_t)nxt.k0 * kstep : cA; const char* nB = has_next ? (const char*)g.Bt + (size_t)nxt.pn * tstep + (size_t)nxt.k0 * kstep : cB;
        for (int t = 0; t < nt; t += 2) {
            const bool last = (t == nt - 2);
            const char* a1 = cA + (size_t)(t + 1) * kstep;
            const char* a2 = last ? nA : cA + (size_t)(t + 2) * kstep; const char* b2 = last ? nB : cB + (size_t)(t + 2) * kstep;
            const char* a3 = a2 + kstep; const char* b3 = b2 + kstep;
            if constexpr (SP2) {
            PG8_LDB(B0, 0, 0); PG8_LDB(B1, 0, 1); PG8_SCHED; PG8_LDA(At, 0, 0); PG8_STAGE(PG8_SA(1, 1), a1 + hstep, voffA);
            PG8_WAIT_V(8); PG8_WAIT_L(0); PG8_BAR; PG8_MMA(0, 0, At, B0); PG8_MMA(0, 1, At, B1); PG8_BAR; PG8_SCHED;
            PG8_LDA(At, 0, 1); PG8_STAGE(PG8_SB(0, 0), b2, voffB); PG8_STAGE(PG8_SB(0, 1), b2 + hstep, voffB); PG8_STAGE(PG8_SA(0, 0), a2, voffA);
            PG8_WAIT_V(8); PG8_WAIT_L(0); PG8_BAR; PG8_MMA(1, 0, At, B0); PG8_MMA(1, 1, At, B1); PG8_BAR; PG8_SCHED;
            PG8_LDB(B0, 1, 0); PG8_LDB(B1, 1, 1); PG8_SCHED; PG8_LDA(At, 1, 0); PG8_STAGE(PG8_SA(0, 1), a2 + hstep, voffA);
            PG8_WAIT_V(8); PG8_WAIT_L(0); PG8_BAR; PG8_MMA(0, 0, At, B0); PG8_MMA(0, 1, At, B1); PG8_BAR; PG8_SCHED;
            PG8_LDA(At, 1, 1); PG8_STAGE(PG8_SB(1, 0), b3, voffB); PG8_STAGE(PG8_SB(1, 1), b3 + hstep, voffB); PG8_STAGE(PG8_SA(1, 0), a3, voffA);
            PG8_WAIT_V(8); PG8_WAIT_L(0); PG8_BAR; PG8_MMA(1, 0, At, B0); PG8_MMA(1, 1, At, B1); PG8_BAR; PG8_SCHED;
            } else {
            PG8_LDB(B0, 0, 0); PG8_SCHED; PG8_LDA(At, 0, 0); PG8_STAGE(PG8_SA(1, 1), a1 + hstep, voffA);
            PG8_WAIT_L(8); PG8_BAR; PG8_WAIT_L(0); PG8_MMA(0, 0, At, B0); PG8_BAR; PG8_SCHED;
            PG8_LDB(B1, 0, 1); PG8_STAGE(PG8_SB(0, 0), b2, voffB);
            PG8_BAR; PG8_WAIT_L(0); PG8_MMA(0, 1, At, B1); PG8_BAR;
            PG8_LDA(At, 0, 1); PG8_STAGE(PG8_SA(0, 0), a2, voffA);
            PG8_BAR; PG8_WAIT_L(0); PG8_MMA(1, 0, At, B0); PG8_BAR; PG8_SCHED;
            PG8_STAGE(PG8_SB(0, 1), b2 + hstep, voffB);
            PG8_WAIT_V(6); PG8_BAR; PG8_MMA(1, 1, At, B1); PG8_BAR;
            PG8_LDB(B0, 1, 0); PG8_SCHED; PG8_LDA(At, 1, 0); PG8_STAGE(PG8_SA(0, 1), a2 + hstep, voffA);
            PG8_WAIT_L(8); PG8_BAR; PG8_WAIT_L(0); PG8_MMA(0, 0, At, B0); PG8_BAR; PG8_SCHED;
            PG8_LDB(B1, 1, 1); PG8_STAGE(PG8_SB(1, 0), b3, voffB);
            PG8_BAR; PG8_WAIT_L(0); PG8_MMA(0, 1, At, B1); PG8_BAR;
            PG8_LDA(At, 1, 1); PG8_STAGE(PG8_SA(1, 0), a3, voffA);
            PG8_BAR; PG8_WAIT_L(0); PG8_MMA(1, 0, At, B0); PG8_BAR; PG8_SCHED;
            PG8_STAGE(PG8_SB(1, 1), b3 + hstep, voffB);
            PG8_WAIT_V(6); PG8_BAR; PG8_MMA(1, 1, At, B1); PG8_BAR;
            }
        }
        if constexpr (ALIGN_EPI) { if (wr == 0) PG8_BAR; }
        E(acc, cur, wr, wc, fr, fq);
        if (!has_next) break;
#pragma unroll
        for (int a = 0; a < 2; ++a)
#pragma unroll
            for (int b = 0; b < 2; ++b)
#pragma unroll
                for (int m = 0; m < 4; ++m)
#pragma unroll
                    for (int n = 0; n < 2; ++n) acc[a][b][m][n] = (f32x4){0.f, 0.f, 0.f, 0.f};
        cur = nxt; cA = nA; cB = nB; ++ui;
        if constexpr (ALIGN_EPI) { if (wr == 1) PG8_BAR; }
    }
    PG8_WAIT_V(0);
    if constexpr (!ALIGN_EPI) { if (wr == 0) PG8_BAR; }
    PG8_BAR;
#undef PG8_SA
#undef PG8_SB
#undef PG8_STAGE
#undef PG8_LDA
#undef PG8_LDB
#undef PG8_MMA
#undef PG8_WAIT_V
#undef PG8_WAIT_L
#undef PG8_BAR
#undef PG8_SCHED
}
}

namespace att {
constexpr int D = 128, NW = 8, QBLK = 32, KVBLK = 64;
constexpr float SCALE = 0.088388347648318440f;
constexpr float INV_SCALE = 11.313708498984761f;
constexpr float THR = 8.f;
constexpr float NEG = -1e30f;
constexpr size_t SHM_V = KVBLK * D * 2, SHM_K = KVBLK * D * 2, SHM_ATTN = 2 * SHM_V + 2 * SHM_K + NW * 64 * 4;
constexpr int BIAS_OFF = (int)SHM_ATTN;
enum { DENSE = 0, NA = 1, SW = 2 };
#define KSWZ(row, colB) ((row) * 256 + ((colB) ^ (((row) & 7) << 4)))
#define SBAR() __builtin_amdgcn_sched_barrier(0)
__device__ __forceinline__ int crow(int r, int hi) { return (r & 3) + 8 * (r >> 2) + 4 * hi; }

__device__ __forceinline__ void partialSM(f32x16& p0, f32x16& p1, float& m_reg, float& mn, float& alpha) {
  constexpr float C = SCALE * 1.4426950408889634f;
  float pmax = p0[0];
#pragma unroll
  for (int r = 1; r < 16; ++r) pmax = fmaxf(pmax, p0[r]);
#pragma unroll
  for (int r = 0; r < 16; ++r) pmax = fmaxf(pmax, p1[r]);
  { auto rr = __builtin_amdgcn_permlane32_swap(__float_as_uint(pmax), __float_as_uint(pmax), false, false);
    pmax = fmaxf(__uint_as_float(rr[0]), __uint_as_float(rr[1])); }
  if (__builtin_expect(__all(pmax - m_reg <= THR / SCALE), 1)) { mn = m_reg; alpha = 1.f; }
  else { mn = fmaxf(m_reg, pmax); alpha = __builtin_amdgcn_exp2f((m_reg - mn) * C); m_reg = mn; }
  float mnC = -mn * C;
#pragma unroll
  for (int r = 0; r < 16; ++r) p0[r] = fmaf(p0[r], C, mnC);
#pragma unroll
  for (int r = 0; r < 16; ++r) p1[r] = fmaf(p1[r], C, mnC);
#pragma unroll
  for (int r = 0; r < 16; ++r) p0[r] = __builtin_amdgcn_exp2f(p0[r]);
}
__device__ __forceinline__ void finishSM(f32x16& p0, f32x16& p1, float alpha, float& l_reg, bf16x8& pa0, bf16x8& pa1, bf16x8& pa2, bf16x8& pa3) {
#pragma unroll
  for (int r = 0; r < 16; ++r) p1[r] = __builtin_amdgcn_exp2f(p1[r]);
  float ps = 0;
#pragma unroll
  for (int r = 0; r < 16; ++r) ps += p0[r];
#pragma unroll
  for (int r = 0; r < 16; ++r) ps += p1[r];
  { auto rr = __builtin_amdgcn_permlane32_swap(__float_as_uint(ps), __float_as_uint(ps), false, false);
    ps = __uint_as_float(rr[0]) + __uint_as_float(rr[1]); }
  l_reg = l_reg * alpha + ps;
#define PK4(P, BASE, OUT) do { unsigned a0 = cvt_pk_bf16(P[BASE + 0], P[BASE + 1]), a1 = cvt_pk_bf16(P[BASE + 2], P[BASE + 3]);   \
    unsigned b0 = cvt_pk_bf16(P[BASE + 4], P[BASE + 5]), b1 = cvt_pk_bf16(P[BASE + 6], P[BASE + 7]);                              \
    auto r0 = __builtin_amdgcn_permlane32_swap(a0, b0, false, false); auto r1 = __builtin_amdgcn_permlane32_swap(a1, b1, false, false); \
    u32x4 w = {r0[0], r1[0], r0[1], r1[1]}; OUT = *reinterpret_cast<bf16x8*>(&w); } while (0)
  PK4(p0, 0, pa0); PK4(p0, 8, pa1); PK4(p1, 0, pa2); PK4(p1, 8, pa3);
#undef PK4
}
__device__ __forceinline__ void qkt(f32x16& p0, f32x16& p1, const bf16_t* Ks, const bf16x8* qr, int r32, int hi) {
  p0 = f32x16{}; p1 = f32x16{};
#pragma unroll
  for (int d0 = 0; d0 < 8; ++d0) { int cb = (d0 * 16 + hi * 8) * 2;
    bf16x8 b0 = *reinterpret_cast<const bf16x8*>((const char*)Ks + KSWZ(r32, cb));
    bf16x8 b1 = *reinterpret_cast<const bf16x8*>((const char*)Ks + KSWZ(32 + r32, cb));
    p0 = __builtin_amdgcn_mfma_f32_32x32x16_bf16(b0, qr[d0], p0, 0, 0, 0);
    p1 = __builtin_amdgcn_mfma_f32_32x32x16_bf16(b1, qr[d0], p1, 0, 0, 0); }
}
__device__ __forceinline__ int v_st(int k, int c) { const int kk = (k & ~0xC) | ((k & 4) << 1) | ((k & 8) >> 1); return ((kk >> 3) * 4 + (c >> 5)) * 512 + ((kk & 7) * 32 + (c & 31)) * 2; }
__device__ __forceinline__ int v_rd_base(int lane) { return ((lane & 3) << 3) | (((lane >> 2) & 3) << 6) | (((lane >> 4) & 1) << 5) | (((lane >> 5) & 1) << 8); }
constexpr int v_rd_off(int d0, int ks, int half) { return d0 * 512 + ks * 4096 + half * 2048; }
template <int OFF> __device__ __forceinline__ s16x4 tr_read(int vb) {
  s16x4 r; asm volatile("ds_read_b64_tr_b16 %0, %1 offset:%2" : "=&v"(r) : "v"(vb), "i"(OFF) : "memory"); return r;
}
template <int D0> __device__ __forceinline__ void pv_one(f32x16& od, int vb, bf16x8 pa0, bf16x8 pa1, bf16x8 pa2, bf16x8 pa3) {
  const s16x4 l0 = tr_read<v_rd_off(D0, 0, 0)>(vb), h0 = tr_read<v_rd_off(D0, 0, 1)>(vb), l1 = tr_read<v_rd_off(D0, 1, 0)>(vb), h1 = tr_read<v_rd_off(D0, 1, 1)>(vb);
  const s16x4 l2 = tr_read<v_rd_off(D0, 2, 0)>(vb), h2 = tr_read<v_rd_off(D0, 2, 1)>(vb), l3 = tr_read<v_rd_off(D0, 3, 0)>(vb), h3 = tr_read<v_rd_off(D0, 3, 1)>(vb);
  asm volatile("s_waitcnt lgkmcnt(0)" ::: "memory"); SBAR();
#define PK(L, H) (bf16x8){L[0], L[1], L[2], L[3], H[0], H[1], H[2], H[3]}
  od = __builtin_amdgcn_mfma_f32_32x32x16_bf16(pa0, PK(l0, h0), od, 0, 0, 0);
  od = __builtin_amdgcn_mfma_f32_32x32x16_bf16(pa1, PK(l1, h1), od, 0, 0, 0);
  od = __builtin_amdgcn_mfma_f32_32x32x16_bf16(pa2, PK(l2, h2), od, 0, 0, 0);
  od = __builtin_amdgcn_mfma_f32_32x32x16_bf16(pa3, PK(l3, h3), od, 0, 0, 0);
#undef PK
}
__device__ __forceinline__ void pv_d0(f32x16* o, int vb, bf16x8 pa0, bf16x8 pa1, bf16x8 pa2, bf16x8 pa3) {
  pv_one<0>(o[0], vb, pa0, pa1, pa2, pa3); pv_one<1>(o[1], vb, pa0, pa1, pa2, pa3); pv_one<2>(o[2], vb, pa0, pa1, pa2, pa3); pv_one<3>(o[3], vb, pa0, pa1, pa2, pa3);
}

struct UnitP { const bf16_t* Q; const bf16_t* K; const bf16_t* V; bf16_t* O; int ldq, ldk, ldo, NT, base_row, qb; float sink_l2e; };

template <int MODE> __device__ __forceinline__ int tile_row0(const UnitP& u, int t) {
  if (MODE == DENSE) return u.base_row + KVBLK * t;
  if (t < 4) return SEQ + KVBLK * t;
  if (MODE == NA) { int R0 = 4 * u.qb - 4; R0 = R0 < 0 ? 0 : (R0 > 120 ? 120 : R0); int kr = R0 + t - 4; kr = kr > 127 ? 127 : kr; return kr * 64; }
  int k0 = 256 * u.qb - 128 + 64 * (t - 4); k0 = k0 < 0 ? 0 : (k0 > SEQ - 64 ? SEQ - 64 : k0); return k0;
}
template <int MODE> __device__ __forceinline__ void mask_tile(f32x16& p0, f32x16& p1, const UnitP& u, int t, int wid, int r32, int hi, const float* biasL) {
  if (MODE == DENSE) return;
  if (t < 4) return;
  if (MODE == SW) {
    const int kpos0 = 256 * u.qb - 128 + 64 * (t - 4); int qpos = 256 * u.qb + wid * 32 + r32; int hi_ = hi;
    asm volatile("" : "+v"(qpos), "+v"(hi_));
#pragma unroll
    for (int r = 0; r < 16; ++r) { const int k0 = kpos0 + crow(r, hi_), k1 = k0 + 32; const int d0 = k0 - qpos, d1 = k1 - qpos;
      const bool v0 = (k0 >= 0) && (k0 < SEQ) && (d0 <= 128) && (d0 >= -128); const bool v1 = (k1 >= 0) && (k1 < SEQ) && (d1 <= 128) && (d1 >= -128);
      p0[r] = v0 ? p0[r] : NEG; p1[r] = v1 ? p1[r] : NEG; }
  } else {
    int R0 = 4 * u.qb - 4; R0 = R0 < 0 ? 0 : (R0 > 120 ? 120 : R0); const int kr = R0 + t - 4;
    const int rq = 4 * u.qb + (wid >> 1); int rs = rq - 4; rs = rs < 0 ? 0 : (rs > 120 ? 120 : rs);
    const bool rowvalid = (kr >= rs) && (kr < rs + 8);
    if (!rowvalid) {
#pragma unroll
      for (int r = 0; r < 16; ++r) { p0[r] = NEG; p1[r] = NEG; }
      return; }
    int cq = (wid & 1) * 32 + r32; int hi_ = hi;
    asm volatile("" : "+v"(cq), "+v"(hi_));
    int cs = cq - 8; cs = cs < 0 ? 0 : (cs > 48 ? 48 : cs);
    int brow = kr - rq + 7; brow = brow < 0 ? 0 : (brow > 14 ? 14 : brow);
    const float* bl = biasL + brow * 31 + 15 - cq;
#pragma unroll
    for (int r = 0; r < 16; ++r) { const int k0 = crow(r, hi_), k1 = k0 + 32;
      const bool v0 = rowvalid && (k0 >= cs) && (k0 < cs + 16); const bool v1 = rowvalid && (k1 >= cs) && (k1 < cs + 16);
      int i0 = k0 - cq; i0 = i0 < -15 ? -15 : (i0 > 15 ? 15 : i0); int i1 = k1 - cq; i1 = i1 < -15 ? -15 : (i1 > 15 ? 15 : i1);
      const float b0 = bl[cq + i0], b1 = bl[cq + i1];
      p0[r] = v0 ? p0[r] + b0 : NEG; p1[r] = v1 ? p1[r] + b1 : NEG;
      SBAR(); }
  }
}

template <int MODE, int SDEPTH>
__device__ __forceinline__ void attn_unit(const UnitP& u, char* lds) {
  const int tid = TID(), wid = tid >> 6, lane = tid & 63, r32 = lane & 31, hi = lane >> 5;
  bf16_t* V_lds = (bf16_t*)lds; bf16_t* K_lds = (bf16_t*)(lds + 2 * SHM_V);
  float* ws = (float*)(lds + 2 * SHM_V + 2 * SHM_K) + wid * 64; float* li_l = ws; float* al_l = ws + 32;
  const float* biasL = (const float*)(lds + BIAS_OFF);
  const bf16_t* __restrict__ Kh = u.K; const bf16_t* __restrict__ Vh = u.V; const int LDK = u.ldk;
  float m_reg = -1e30f, l_reg = 0; f32x16 o[4] = {}; bf16x8 qr[8];
  const bf16_t* Qw = u.Q + (long)(wid * QBLK + r32) * u.ldq + hi * 8;
#pragma unroll
  for (int d0 = 0; d0 < 8; ++d0) qr[d0] = *reinterpret_cast<const bf16x8*>(Qw + d0 * 16);
  const int vb0 = (int)(uintptr_t)V_lds + v_rd_base(lane);
  struct { bf16x8 vs0, vs1, ks0, ks1; } sr_[SDEPTH];
#define SLOAD(i, k0) do { int t_ = tid; if (MODE != DENSE) asm volatile("" : "+v"(t_)); const int sr = t_ >> 4, sc = (t_ & 15) * 8; \
    const long _r0 = (long)((k0) + sr) * LDK + sc, _r1 = (long)((k0) + 32 + sr) * LDK + sc; \
    sr_[i].vs0 = *reinterpret_cast<const bf16x8*>(&Vh[_r0]); sr_[i].vs1 = *reinterpret_cast<const bf16x8*>(&Vh[_r1]); \
    sr_[i].ks0 = *reinterpret_cast<const bf16x8*>(&Kh[_r0]); sr_[i].ks1 = *reinterpret_cast<const bf16x8*>(&Kh[_r1]); } while (0)
#define SWRITE(b, i) do { int t_ = tid; if (MODE != DENSE) asm volatile("" : "+v"(t_)); const int sr = t_ >> 4, sc = (t_ & 15) * 8, vst0 = v_st(sr, sc), vst1 = v_st(32 + sr, sc); \
    *(bf16x8*)((char*)V_lds + (b) * SHM_V + vst0) = sr_[i].vs0;          \
    *(bf16x8*)((char*)V_lds + (b) * SHM_V + vst1) = sr_[i].vs1; int kc = sc * 2;               \
    *(bf16x8*)((char*)K_lds + (b) * SHM_K + KSWZ(sr, kc)) = sr_[i].ks0;                       \
    *(bf16x8*)((char*)K_lds + (b) * SHM_K + KSWZ(32 + sr, kc)) = sr_[i].ks1; } while (0)
#define SWAIT() do { if constexpr (SDEPTH == 2) asm volatile("s_waitcnt vmcnt(4)" ::: "memory"); else asm volatile("s_waitcnt vmcnt(0)" ::: "memory"); } while (0)
#define RESC(a) do { if (__any((a) < 1.f)) { if (hi == 0) al_l[r32] = (a); asm volatile("s_waitcnt lgkmcnt(0)" ::: "memory"); \
    _Pragma("unroll") for (int d = 0; d < 4; ++d) _Pragma("unroll") for (int r = 0; r < 16; ++r) o[d][r] *= al_l[crow(r, hi)]; } } while (0)
#define ROW0(t) tile_row0<MODE>(u, (t))
  f32x16 pA0, pA1, pB0, pB1; float mnA, mnB, alA, alB; bf16x8 pa0, pa1, pa2, pa3; const int NT = u.NT;
  constexpr int SE = 0, SO = SDEPTH - 1;
  SLOAD(SE, ROW0(0)); asm volatile("s_waitcnt vmcnt(0)" ::: "memory"); SWRITE(0, SE); __syncthreads();
  qkt(pA0, pA1, K_lds, qr, r32, hi); mask_tile<MODE>(pA0, pA1, u, 0, wid, r32, hi, biasL); partialSM(pA0, pA1, m_reg, mnA, alA);
  SLOAD(SO, ROW0(1)); if constexpr (SDEPTH == 2) { if (2 < NT) SLOAD(SE, ROW0(2)); }
  SWAIT(); SWRITE(1, SO); __syncthreads();
  for (int j = 1; j + 1 < NT; j += 2) {
    SBAR(); qkt(pB0, pB1, (bf16_t*)((char*)K_lds + SHM_K), qr, r32, hi);
    finishSM(pA0, pA1, alA, l_reg, pa0, pa1, pa2, pa3); SBAR();
    SLOAD(SO, ROW0(j + SDEPTH)); SBAR();
    pv_d0(o, vb0, pa0, pa1, pa2, pa3); mask_tile<MODE>(pB0, pB1, u, j, wid, r32, hi, biasL); partialSM(pB0, pB1, m_reg, mnB, alB);
    __syncthreads(); SWAIT(); SWRITE(0, SE);
    RESC(alB); __syncthreads();
    SBAR(); qkt(pA0, pA1, K_lds, qr, r32, hi);
    finishSM(pB0, pB1, alB, l_reg, pa0, pa1, pa2, pa3); SBAR();
    if (SDEPTH == 1 || j + 3 < NT) SLOAD(SE, ROW0(j + 1 + SDEPTH)); SBAR();
    pv_d0(o, vb0 + (int)SHM_V, pa0, pa1, pa2, pa3); mask_tile<MODE>(pA0, pA1, u, j + 1, wid, r32, hi, biasL); partialSM(pA0, pA1, m_reg, mnA, alA);
    __syncthreads(); SWAIT(); SWRITE(1, SO);
    RESC(alA); __syncthreads();
  }
  SBAR(); qkt(pB0, pB1, (bf16_t*)((char*)K_lds + SHM_K), qr, r32, hi);
  finishSM(pA0, pA1, alA, l_reg, pa0, pa1, pa2, pa3); SBAR();
  pv_d0(o, vb0, pa0, pa1, pa2, pa3); mask_tile<MODE>(pB0, pB1, u, NT - 1, wid, r32, hi, biasL); partialSM(pB0, pB1, m_reg, mnB, alB);
  __syncthreads(); RESC(alB);
  finishSM(pB0, pB1, alB, l_reg, pa0, pa1, pa2, pa3); SBAR();
  pv_d0(o, vb0 + (int)SHM_V, pa0, pa1, pa2, pa3);
  l_reg += __builtin_amdgcn_exp2f(u.sink_l2e - m_reg * (SCALE * 1.4426950408889634f));
  if (hi == 0) li_l[r32] = l_reg; asm volatile("s_waitcnt lgkmcnt(0)" ::: "memory");
  float rli[16];
#pragma unroll
  for (int r = 0; r < 16; ++r) rli[r] = __builtin_amdgcn_rcpf(li_l[crow(r, hi)]);
  bf16_t* Ow = u.O + (long)(wid * QBLK) * u.ldo;
#pragma unroll
  for (int r = 0; r < 16; ++r) { int orow = crow(r, hi);
#pragma unroll
    for (int d0 = 0; d0 < 4; ++d0) { const float v = o[d0][r] * rli[r]; Ow[(long)orow * u.ldo + d0 * 32 + r32] = (bf16_t)(cvt_pk_bf16(v, v) & 0xffffu); } }
  __syncthreads();
#undef SLOAD
#undef SWRITE
#undef SWAIT
#undef RESC
#undef ROW0
}
#undef KSWZ
#undef SBAR
}

struct Args { const float* in[22]; float* out; unsigned char* ws; int ph_lo, ph_hi; };
#define CAS __attribute__((address_space(4)))
__device__ __forceinline__ const float* INP(int i) { const CAS char* k = (const CAS char*)__builtin_amdgcn_kernarg_segment_ptr(); asm volatile("" : "+s"(k)); return *(const float* const CAS*)(k + 8 * i); }
__device__ __forceinline__ float* OUTP() { const CAS char* k = (const CAS char*)__builtin_amdgcn_kernarg_segment_ptr(); asm volatile("" : "+s"(k)); return *(float* const CAS*)(k + 8 * 22); }
__device__ __forceinline__ unsigned char* WSP() { const CAS char* k = (const CAS char*)__builtin_amdgcn_kernarg_segment_ptr(); asm volatile("" : "+s"(k)); return *(unsigned char* const CAS*)(k + 8 * 23); }
enum { I_X = 0, I_C, I_CTX, I_CCTX, I_ADAW, I_ADAB, I_NORMG, I_WG, I_WU, I_WD, I_ABIN, I_ABOUT, I_NAQG, I_NAKG, I_NABIAS, I_SWQG, I_SWKG, I_SINK, I_GIN, I_GOUT, I_GQG, I_GKG };

__device__ __forceinline__ unsigned f2bf(float f) { unsigned u = __builtin_bit_cast(unsigned, f); return (u + 0x7fffu + ((u >> 16) & 1u)) >> 16; }
__device__ __forceinline__ unsigned pk2(float lo, float hi) { return f2bf(lo) | (f2bf(hi) << 16); }
__device__ __forceinline__ void transpose_item(const float* __restrict__ W, int K, int N, bf16_t* WT, int mode, LAS float* scr, int item, int lane) {
    const int nblk = N / 32, kb = item / nblk, nb = item % nblk, k0 = 64 * kb, n0 = 32 * nb;
#pragma unroll 8
    for (int i = 0; i < 32; ++i) { const int kk = 2 * i + (lane >> 5); scr[kk * 33 + (lane & 31)] = W[(size_t)(k0 + kk) * N + n0 + (lane & 31)]; }
    asm volatile("s_waitcnt lgkmcnt(0)" ::: "memory");
    const int c = lane & 7;
    const int rbase = (mode == 0) ? n0 : ((n0 >> 7) * 256 + (n0 & 127) + (mode == 2 ? 128 : 0));
#pragma unroll
    for (int j = 0; j < 4; ++j) { const int n = (lane >> 3) + 8 * j; const LAS float* s = scr + (8 * c) * 33 + n;
        u32x4 o; o.x = pk2(s[0 * 33], s[1 * 33]); o.y = pk2(s[2 * 33], s[3 * 33]); o.z = pk2(s[4 * 33], s[5 * 33]); o.w = pk2(s[6 * 33], s[7 * 33]);
        *(u32x4*)(WT + (size_t)(rbase + n) * K + k0 + 8 * c) = o; }
    asm volatile("s_waitcnt lgkmcnt(0)" ::: "memory");
}
__device__ __forceinline__ void phase0(const Args& a, unsigned char* lds_g, int G) {
    const int tid = TID(), lane = tid & 63, wave = tid >> 6; const int bid = BID();
    float* sc = (float*)lds_g;
    float* red = sc + 4096;
    for (int i = tid; i < DM; i += 512) { const float c = INP(I_C)[i]; sc[i] = c / (1.0f + __expf(-c)); const float cc = INP(I_CCTX)[i]; sc[DM + i] = cc / (1.0f + __expf(-cc)); }
    __syncthreads();
    float* mod = (float*)(WSP() + WS_MOD);
    for (int unit = bid; unit < 256; unit += G) {
        const int layer = unit >> 7, col0 = (unit & 127) * 144;
        f32x4 a1 = {0.f, 0.f, 0.f, 0.f}, a2 = {0.f, 0.f, 0.f, 0.f};
        if (lane < 36) {
            const float* W = INP(I_ADAW) + (size_t)layer * DM * NMODV + col0 + 4 * lane;
            for (int k = wave * 256; k < wave * 256 + 256; k += 8) {
                f32x4 w[8];
#pragma unroll
                for (int q = 0; q < 8; ++q) w[q] = __builtin_nontemporal_load((const f32x4*)(W + (size_t)(k + q) * NMODV));
#pragma unroll
                for (int q = 0; q < 8; ++q) { a1 += w[q] * sc[k + q]; a2 += w[q] * sc[DM + k + q]; }
            }
#pragma unroll
            for (int e = 0; e < 4; ++e) { red[(wave * 2 + 0) * 144 + 4 * lane + e] = a1[e]; red[(wave * 2 + 1) * 144 + 4 * lane + e] = a2[e]; }
        }
        __syncthreads();
        if (tid < 288) { const int v = tid / 144, j = tid % 144; float s = INP(I_ADAB)[layer * NMODV + col0 + j];
#pragma unroll
            for (int w = 0; w < 8; ++w) s += red[(w * 2 + v) * 144 + j];
            mod[(size_t)(layer * 2 + v) * NMODV + col0 + j] = s; }
        __syncthreads();
    }
    LAS float* scr = (LAS float*)((LAS unsigned char*)lds_g + wave * 16384);
    const int gw = bid * 8 + wave, NGW = G * 8;
    constexpr int I_GU1 = (DM / 64) * (FF / 32);
    constexpr int I_D1 = (FF / 64) * (DM / 32);
    constexpr int I_GU = 8 * I_GU1, I_D = 4 * I_D1, I_ABI = (DM / 64) * (AB_IN / 32), I_SQ = (DM / 64) * (DM / 32), I_GI = (DM / 64) * (C_IN / 32);
    constexpr int NITEMS = I_GU + I_D + I_ABI + I_SQ + I_GI + I_SQ;
    bf16_t* wgu = (bf16_t*)(WSP() + WS_WGU); bf16_t* wd = (bf16_t*)(WSP() + WS_WD);
    for (int it = gw; it < NITEMS; it += NGW) {
        int r = it;
        if (r < I_GU) { const int q = r / I_GU1, lf = q >> 1, gu = q & 1; r -= q * I_GU1;
            transpose_item((gu ? INP(I_WU) : INP(I_WG)) + (size_t)lf * DM * FF, DM, FF, wgu + (size_t)lf * WGU_ELEMS, 1 + gu, scr, r, lane); continue; }
        r -= I_GU;
        if (r < I_D) { const int lf = r / I_D1; r -= lf * I_D1; transpose_item(INP(I_WD) + (size_t)lf * FF * DM, FF, DM, wd + (size_t)lf * WD_ELEMS, 0, scr, r, lane); continue; }
        r -= I_D;
        if (r < I_ABI) { transpose_item(INP(I_ABIN), DM, AB_IN, (bf16_t*)(WSP() + WS_WABIN), 0, scr, r, lane); continue; }
        r -= I_ABI;
        if (r < I_SQ) { transpose_item(INP(I_ABOUT), DM, DM, (bf16_t*)(WSP() + WS_WABOUT), 0, scr, r, lane); continue; }
        r -= I_SQ;
        if (r < I_GI) { transpose_item(INP(I_GIN), DM, C_IN, (bf16_t*)(WSP() + WS_WGIN), 0, scr, r, lane); continue; }
        r -= I_GI;
        transpose_item(INP(I_GOUT), DM, DM, (bf16_t*)(WSP() + WS_WGOUT), 0, scr, r, lane);
    }
}

__device__ __forceinline__ void modulate_phase(const float* xsrc, float* xcopy, const float* csrc, float* cdst, const float* part, int nsplit, const float* cgate, float ccoef,
                                               const float* g, const float* shift_l, const float* scale_l, const float* shift_c, const float* scale_c, bf16_t* h, int nrows, int G) {
    const int tid = TID(), lane = tid & 63, wave = tid >> 6;
    const int gw = BID() * 8 + wave, NGW = G * 8;
    for (int row = gw; row < nrows; row += NGW) {
        const bool isctx = row >= SEQ;
        f32x4 v[8];
        if (!isctx) {
            const f32x4* xr = (const f32x4*)(xsrc + (size_t)row * DM) + lane;
#pragma unroll
            for (int j = 0; j < 8; ++j) v[j] = xr[64 * j];
            if (xcopy) { f32x4* xo = (f32x4*)(xcopy + (size_t)row * DM) + lane;
#pragma unroll
                for (int j = 0; j < 8; ++j) xo[64 * j] = v[j]; }
        } else {
            const int r = row - SEQ;
            const f32x4* xr = (const f32x4*)(csrc + (size_t)r * DM) + lane;
#pragma unroll
            for (int j = 0; j < 8; ++j) v[j] = xr[64 * j];
            if (nsplit > 0) {
                f32x4 s[8];
#pragma unroll
                for (int j = 0; j < 8; ++j) s[j] = (f32x4){0.f, 0.f, 0.f, 0.f};
                for (int sp = 0; sp < nsplit; ++sp) { const f32x4* pr = (const f32x4*)(part + ((size_t)sp * 256 + r) * DM) + lane;
#pragma unroll
                    for (int j = 0; j < 8; ++j) s[j] += pr[64 * j]; }
#pragma unroll
                for (int j = 0; j < 8; ++j) { const f32x4 gt = *((const f32x4*)cgate + lane + 64 * j); v[j] += ccoef * gt * s[j]; }
            }
            if (cdst) { f32x4* xo = (f32x4*)(cdst + (size_t)r * DM) + lane;
#pragma unroll
                for (int j = 0; j < 8; ++j) xo[64 * j] = v[j]; }
        }
        float ss = 0.f;
#pragma unroll
        for (int j = 0; j < 8; ++j) ss += (v[j].x * v[j].x + v[j].y * v[j].y) + (v[j].z * v[j].z + v[j].w * v[j].w);
        const float rstd = 1.0f / sqrtf(wave_sum(ss) * (1.0f / DM) + EPS);
        const f32x4* sh = (const f32x4*)(isctx ? shift_c : shift_l) + lane; const f32x4* scl = (const f32x4*)(isctx ? scale_c : scale_l) + lane;
        const f32x4* gg = (const f32x4*)g + lane;
        u32x2* ho = (u32x2*)(h + (size_t)row * DM) + lane;
#pragma unroll
        for (int j = 0; j < 8; ++j) { const f32x4 y = (v[j] * rstd) * gg[64 * j]; const f32x4 z = y * (scl[64 * j] + 1.0f) + sh[64 * j];
            u32x2 w; w.x = cvt_pk_bf16(z.x, z.y); w.y = cvt_pk_bf16(z.z, z.w); ho[64 * j] = w; }
    }
}

__device__ __forceinline__ void attn_phase0(const Args& a, unsigned char* lds_g, int G) {
    bf16_t* P = (bf16_t*)(WSP() + WS_P); bf16_t* O = (bf16_t*)(WSP() + WS_O);
    float* biasL = (float*)(lds_g + att::BIAS_OFF);
    const int tid0 = TID();
    for (int un = BID(); un < 528; un += G) {
        att::UnitP u; u.ldq = AB_IN; u.ldk = AB_IN; u.ldo = DM; u.sink_l2e = -INFINITY;
        if (un < 256) {
            const int h = un & 7, qb = un >> 3;
            for (int i = tid0; i < 465; i += 512) biasL[i] = INP(I_NABIAS)[h * 465 + i] * att::INV_SCALE;
            __syncthreads();
            u.Q = P + (size_t)(256 * qb) * AB_IN + h * 128; u.K = P + (16 + h) * 128; u.V = P + (24 + h) * 128; u.O = O + (size_t)(256 * qb) * DM + h * 128;
            u.NT = 16; u.base_row = 0; u.qb = qb;
            att::attn_unit<att::NA, 1>(u, (char*)lds_g);
        } else if (un < 512) {
            const int hq = (un - 256) & 7, qb = (un - 256) >> 3, kvh = hq >> 2;
            u.Q = P + (size_t)(256 * qb) * AB_IN + (8 + hq) * 128; u.K = P + (32 + kvh) * 128; u.V = P + (34 + kvh) * 128; u.O = O + (size_t)(256 * qb) * DM + (8 + hq) * 128;
            u.NT = 12; u.base_row = 0; u.qb = qb; u.sink_l2e = INP(I_SINK)[hq] * 1.4426950408889634f;
            att::attn_unit<att::SW, 1>(u, (char*)lds_g);
        } else {
            const int hh = un - 512;
            u.Q = P + (size_t)SEQ * AB_IN + hh * 128; u.O = O + (size_t)SEQ * DM + hh * 128;
            const bool nah = hh < 8; const int hq = nah ? 0 : hh - 8, kvh = hq >> 2;
            const int kslot = nah ? 16 + hh : 32 + kvh, vslot = nah ? 24 + hh : 34 + kvh;
            u.K = P + kslot * 128; u.V = P + vslot * 128;
            const float sk = INP(I_SINK)[hq] * 1.4426950408889634f; u.sink_l2e = nah ? -INFINITY : sk;
            u.NT = 4; u.base_row = SEQ; u.qb = 0;
            att::attn_unit<att::DENSE, 2>(u, (char*)lds_g);
        }
    }
}
__device__ __forceinline__ void attn_phase1(const Args& a, unsigned char* lds_g, int G) {
    bf16_t* P = (bf16_t*)(WSP() + WS_P); bf16_t* O = (bf16_t*)(WSP() + WS_O);
    const int bid = BID();
    for (int i = 0;; ++i) {
        int un;
        if ((G & 7) == 0) { const int x = bid & 7, j = (bid >> 3) + i * (G >> 3); if (j >= 64) break; un = x * 64 + j; }
        else { un = bid + i * G; if (un >= 512) break; }
        const int h = un >> 5, qb = un & 31, kvh = h >> 2;
        att::UnitP u; u.ldq = C_IN; u.ldk = C_IN; u.ldo = DM; u.sink_l2e = -INFINITY;
        u.Q = P + (size_t)(256 * qb) * C_IN + h * 128; u.K = P + (16 + kvh) * 128; u.V = P + (20 + kvh) * 128; u.O = O + (size_t)(256 * qb) * DM + h * 128;
        u.NT = MT / 64; u.base_row = 0; u.qb = qb;
        att::attn_unit<att::DENSE, 2>(u, (char*)lds_g);
    }
}

#define XB_TMO      128
#define XB_XCNT(j)  (256  + 64 * (j))
#define XB_XSUB(j)  (1280 + 64 * (j))
#define XB_XGEN(j)  (2304 + 64 * (j))
#define XB_TOP      3328
#define XB_TOPGEN   3392
#define XCD_BAR_WORDS 3456
#define XB_SPIN_CAP (1u << 18)
__device__ __forceinline__ unsigned xb_ld(unsigned* p)              { return __hip_atomic_load(p, __ATOMIC_RELAXED, __HIP_MEMORY_SCOPE_AGENT); }
__device__ __forceinline__ unsigned xb_add(unsigned* p, unsigned v) { return __hip_atomic_fetch_add(p, v, __ATOMIC_RELAXED, __HIP_MEMORY_SCOPE_AGENT); }
__device__ __forceinline__ unsigned xb_xcc_id() { return (unsigned)__builtin_amdgcn_s_getreg((3 << 11) | 20) & 0xFu; }
#define XB_SPIN(cond, bar) do { unsigned _sp = 0; while (cond) { __builtin_amdgcn_s_sleep(1); \
    if ((++_sp & 255u) == 0u) { if (xb_ld(&(bar)[XB_TMO])) break; if (_sp > XB_SPIN_CAP) { atomicAdd(&(bar)[XB_TMO], 1u); break; } } } } while (0)
struct XcdBarrier { unsigned* bar; unsigned x; volatile LAS unsigned* st; };
__device__ __forceinline__ XcdBarrier xcd_barrier_post(unsigned* bar, volatile LAS unsigned* st) {
    XcdBarrier b; b.bar = bar; b.x = xb_xcc_id(); b.st = st;
    if (threadIdx.x == 0) (void)xb_add(&bar[XB_XCNT(b.x)], 1u);
    return b;
}
__device__ __forceinline__ void xcd_barrier_complete(unsigned* bar, unsigned x, unsigned& nloc, unsigned& nx) {
    const unsigned G = gridDim.x * gridDim.y * gridDim.z;
    unsigned sum, cnt, mine, sp = 0u;
    for (;;) {
        sum = 0u; cnt = 0u; mine = 0u;
#pragma unroll
        for (unsigned j = 0; j < 16; ++j) { const unsigned c = xb_ld(&bar[XB_XCNT(j)]); sum += c; cnt += (c > 0u) ? 1u : 0u; mine = (j == x) ? c : mine; }
        if (sum == G) break;
        __builtin_amdgcn_s_sleep(1);
        if ((++sp & 255u) == 0u) { if (xb_ld(&bar[XB_TMO])) break; if (sp > XB_SPIN_CAP) { atomicAdd(&bar[XB_TMO], 1u); break; } }
    }
    nloc = mine > 0u ? mine : 1u; nx = cnt > 0u ? cnt : 1u;
}
__device__ __forceinline__ void xcd_barrier(const XcdBarrier& b) {
    asm volatile("s_waitcnt vmcnt(0)" ::: "memory");
    __syncthreads();
    if (threadIdx.x == 0) {
        unsigned* bar = b.bar;
        __builtin_amdgcn_s_waitcnt(0);
        unsigned nloc = b.st[0], nx = b.st[1];
        if (nloc == 0u) { xcd_barrier_complete(bar, b.x, nloc, nx); b.st[0] = nloc; b.st[1] = nx; }
        const unsigned old = xb_add(&bar[XB_XSUB(b.x)], 1u);
        const unsigned gen = old / nloc;
        if (old + 1u == (gen + 1u) * nloc) {
            __builtin_amdgcn_fence(__ATOMIC_RELEASE, "agent");
            asm volatile("s_waitcnt vmcnt(0)" ::: "memory");
            const unsigned og = xb_add(&bar[XB_TOP], 1u);
            const unsigned tg = og / nx;
            if (og + 1u == (tg + 1u) * nx) xb_add(&bar[XB_TOPGEN], 1u);
            else XB_SPIN(xb_ld(&bar[XB_TOPGEN]) == tg, bar);
            __builtin_amdgcn_fence(__ATOMIC_ACQUIRE, "agent");
            xb_add(&bar[XB_XGEN(b.x)], 1u);
            asm volatile("s_waitcnt vmcnt(0)" ::: "memory");
        } else {
            XB_SPIN(xb_ld(&bar[XB_XGEN(b.x)]) == gen, bar);
            __builtin_amdgcn_fence(__ATOMIC_ACQUIRE, "agent");
            asm volatile("s_waitcnt vmcnt(0)" ::: "memory");
        }
    }
    __syncthreads();
}

__global__ void __launch_bounds__(512, 2) mk_fwd(Args a) {
    extern __shared__ __attribute__((aligned(16))) unsigned char lds[];
    cg::grid_group grid = cg::this_grid();
    const int G = gridDim.x;
    LAS unsigned char* lds3 = (LAS unsigned char*)lds;
    volatile LAS unsigned* misc = (volatile LAS unsigned*)(lds3 + MISC_OFF);
    if (threadIdx.x < 2) misc[threadIdx.x] = 0u;
    __syncthreads();
    XcdBarrier bar = xcd_barrier_post((unsigned*)(WSP() + WS_BAR), misc);
    float* mod = (float*)(WSP() + WS_MOD);
    float* xc = (float*)(WSP() + WS_XC); float* part = (float*)(WSP() + WS_PART);
    bf16_t* H = (bf16_t*)(WSP() + WS_H); bf16_t* O = (bf16_t*)(WSP() + WS_O); bf16_t* P = (bf16_t*)(WSP() + WS_P); bf16_t* A = (bf16_t*)(WSP() + WS_A);
    for (int ph = a.ph_lo; ph < a.ph_hi; ++ph) {
        if (ph == 0) { phase0(a, lds, G); if (REPMASK & 1) { __syncthreads(); phase0(a, lds, G); } }
        else {
            const int layer = (ph - 1) / 10, sub = (ph - 1) % 10;
            const float* mL = mod + (size_t)(layer * 2 + 0) * NMODV; const float* mC = mod + (size_t)(layer * 2 + 1) * NMODV;
            const bool with_ctx = layer == 0;
            if (sub == 0 || sub == 3 || sub == 7) {
                const int k = sub == 0 ? 0 : (sub == 3 ? 1 : 2);
                const bool first = (ph == 1);
                const float* xsrc = (ph <= 3) ? INP(I_X) : OUTP(); float* xcopy = nullptr;
                const float* csrc = first ? INP(I_CTX) : xc;
                const bool upd_prev = (sub == 0 && layer == 1);
                const int nsplit = (upd_prev || sub == 3) ? NSPLIT_DOWN : ((sub == 7) ? NSPLIT_OUT : 0);
                const float* cgate = upd_prev ? (mod + (size_t)(0 * 2 + 1) * NMODV + 8 * DM) : (sub == 3 ? mC + 2 * DM : mC + 5 * DM);
                const float ccoef = (sub == 7) ? 1.0f : 0.5f;
                const int nrows = (sub == 7 && !with_ctx) ? SEQ : MT;
                modulate_phase(xsrc, xcopy, csrc, xc, part, nsplit, cgate, ccoef, INP(I_NORMG) + (size_t)(layer * 3 + k) * DM,
                               mL + (3 * k) * DM, mL + (3 * k + 1) * DM, mC + (3 * k) * DM, mC + (3 * k + 1) * DM, H, nrows, G);
                if (REPMASK & 64) modulate_phase(xsrc, nullptr, xc, nullptr, part, 0, cgate, ccoef, INP(I_NORMG) + (size_t)(layer * 3 + k) * DM,
                               mL + (3 * k) * DM, mL + (3 * k + 1) * DM, mC + (3 * k) * DM, mC + (3 * k + 1) * DM, H, nrows, G);
            } else if (sub == 1 || sub == 8) {
                const int f = sub == 1 ? 0 : 1; const int nM = (f == 1 && !with_ctx) ? SEQ / 256 : MT / 256;
                pg8::Gemm g{H, (const bf16_t*)(WSP() + WS_WGU) + (size_t)(layer * 2 + f) * WGU_ELEMS, DM};
                pg8::Sched S; S.init(nM, 2 * FF / 256, DM, G, BID(), 0, 0, 0);
                pg8::EpiSwiGLU E{A, FF};
                pg8::gemm_phase<pg8::EpiSwiGLU, true, true>(lds3, g, S, E);
                if (REPMASK & 2) pg8::gemm_phase<pg8::EpiSwiGLU, true, true>(lds3, g, S, E);
            } else if (sub == 2 || sub == 9) {
                const int f = sub == 2 ? 0 : 1; const bool ctxrows = !(f == 1 && !with_ctx);
                pg8::Gemm g{A, (const bf16_t*)(WSP() + WS_WD) + (size_t)(layer * 2 + f) * WD_ELEMS, FF};
                pg8::Sched S; S.init(SEQ / 256, DM / 256, FF, G, BID(), ctxrows ? NSPLIT_DOWN : 0, NT_SPLIT_DOWN, SEQ / 256);
                pg8::EpiResid E{(ph == 3) ? INP(I_X) : (const float*)OUTP(), OUTP(), mL + (f == 0 ? 2 : 8) * DM, 0.5f, part};
                pg8::gemm_phase<pg8::EpiResid, true, true>(lds3, g, S, E);
                if (REPMASK & 256) { pg8::EpiResid E2{(const float*)P, (float*)P, mL + (f == 0 ? 2 : 8) * DM, 0.5f, part}; pg8::gemm_phase<pg8::EpiResid, true, true>(lds3, g, S, E2); }
            } else if (sub == 4) {
                const int N = layer == 0 ? AB_IN : C_IN;
                pg8::Gemm g{H, (const bf16_t*)(WSP() + (layer == 0 ? WS_WABIN : WS_WGIN)), DM};
                pg8::Sched S; S.init(MT / 256, N / 256, DM, G, BID(), 0, 0, 0);
                pg8::EpiQK E{P, N, layer, layer == 0 ? INP(I_NAQG) : INP(I_GQG), layer == 0 ? INP(I_SWQG) : INP(I_GKG), INP(I_NAKG), INP(I_SWKG), (LAS float*)(lds3 + XCH_OFF)};
                pg8::gemm_phase<pg8::EpiQK, true, true>(lds3, g, S, E);
                if (REPMASK & 16) pg8::gemm_phase<pg8::EpiQK, true, true>(lds3, g, S, E);
            }
            else if (sub == 5) { if (layer == 0) { attn_phase0(a, lds, G); if (REPMASK & 32) attn_phase0(a, lds, G); } else { attn_phase1(a, lds, G); if (REPMASK & 4) attn_phase1(a, lds, G); } }
            else if (sub == 6) {
                pg8::Gemm g{O, (const bf16_t*)(WSP() + (layer == 0 ? WS_WABOUT : WS_WGOUT)), DM};
                pg8::Sched S; S.init(SEQ / 256, DM / 256, DM, G, BID(), with_ctx ? NSPLIT_OUT : 0, NT_SPLIT_OUT, SEQ / 256);
                pg8::EpiResid E{OUTP(), OUTP(), mL + 5 * DM, 1.0f, part};
                pg8::gemm_phase<pg8::EpiResid, true, true>(lds3, g, S, E);
                if (REPMASK & 512) { pg8::EpiResid E2{(const float*)A, (float*)A, mL + 5 * DM, 1.0f, part}; pg8::gemm_phase<pg8::EpiResid, true, true>(lds3, g, S, E2); }
            }
        }
        if (ph + 1 < a.ph_hi) {
            if (a.ph_lo < 0) grid.sync(); else xcd_barrier(bar);
            if (REPMASK & 8) xcd_barrier(bar); }
    }
}

extern "C" void kernel_launch(void* const* d_in, const int* in_sizes, int n_in, void* d_out, int out_size, void* d_ws, size_t ws_size, hipStream_t stream) {
    static int grid = 0;
    if (grid == 0) {
        if (n_in != 22 || out_size != SEQ * DM || ws_size < WS_END) { fprintf(stderr, "kernel_launch: unexpected shapes (n_in %d out %d ws %zu)\n", n_in, out_size, ws_size); grid = -1; return; }
        int dev = 0, cus = 0, per_cu = 0;
        hipGetDevice(&dev); hipDeviceGetAttribute(&cus, hipDeviceAttributeMultiprocessorCount, dev);
        if (hipFuncSetAttribute((const void*)mk_fwd, hipFuncAttributeMaxDynamicSharedMemorySize, LDS_BYTES) != hipSuccess) { fprintf(stderr, "kernel_launch: hipFuncSetAttribute failed\n"); grid = -1; return; }
        if (hipOccupancyMaxActiveBlocksPerMultiprocessor(&per_cu, (const void*)mk_fwd, 512, LDS_BYTES) != hipSuccess || per_cu < 1) { fprintf(stderr, "kernel_launch: occupancy query gave %d\n", per_cu); per_cu = 1; }
        (void)hipGetLastError();
        grid = cus * per_cu;
        if (grid > 256) grid = 256;
    }
    if (grid < 0) return;
    if (hipMemsetAsync((char*)d_ws + WS_BAR, 0, BAR_BYTES, stream) != hipSuccess) { fprintf(stderr, "kernel_launch: memset failed\n"); return; }
    Args a{};
    for (int i = 0; i < 22; ++i) a.in[i] = (const float*)d_in[i];
    a.out = (float*)d_out; a.ws = (unsigned char*)d_ws;
#if MK_MULTI
    for (int p = 0; p < NPHASE; ++p) { a.ph_lo = p; a.ph_hi = p + 1; hipLaunchKernelGGL(mk_fwd, dim3(grid), dim3(512), LDS_BYTES, stream, a); }
#else
    a.ph_lo = 0; a.ph_hi = NPHASE;
    void* args[] = {&a};
    hipError_t e = hipLaunchCooperativeKernel((const void*)mk_fwd, dim3(grid), dim3(512), args, LDS_BYTES, stream);
    if (e != hipSuccess) fprintf(stderr, "cooperative launch failed: %s (grid %d)\n", hipGetErrorString(e), grid);
#endif
}
```

```cpp
#include <hip/hip_runtime.h>
#include <hip/hip_cooperative_groups.h>
#include <cstdio>
#include <cstdint>
namespace cg = cooperative_groups;

#ifndef REPMASK
#define REPMASK 0
#endif
#ifndef MK_MULTI
#define MK_MULTI 0
#endif

constexpr int SEQ = 8192, CTXL = 256, MT = SEQ + CTXL, DM = 2048, FF = 5632, NMODV = 9 * DM;
constexpr int AB_IN = 4608, C_IN = 3072, GRIDW = 64;
constexpr float EPS = 1e-6f;
constexpr int NPHASE = 21;
constexpr int NSPLIT_DOWN = 22, NT_SPLIT_DOWN = 4;
constexpr int NSPLIT_OUT = 16, NT_SPLIT_OUT = 2;

constexpr size_t MiB = 1u << 20;
constexpr size_t WS_MOD = 0;
constexpr size_t WS_BAR = 512 * 1024, BAR_BYTES = 16384;
constexpr size_t WS_XC = 1 * MiB;
constexpr size_t WS_PART = 4 * MiB;
constexpr size_t WS_H = 52 * MiB;
constexpr size_t WS_O = 88 * MiB;
constexpr size_t WS_P = 124 * MiB;
constexpr size_t WS_A = 200 * MiB;
constexpr size_t WS_WGU = 292 * MiB;
constexpr size_t WS_WD = 468 * MiB;
constexpr size_t WS_WABIN = 556 * MiB;
constexpr size_t WS_WABOUT = 574 * MiB;
constexpr size_t WS_WGIN = 582 * MiB;
constexpr size_t WS_WGOUT = 594 * MiB;
constexpr size_t WS_END = 602 * MiB;
constexpr size_t WGU_ELEMS = (size_t)2 * FF * DM, WD_ELEMS = (size_t)DM * FF;

constexpr int LDS_BYTES = 143360;
constexpr int XCH_OFF = 131072;
constexpr int MISC_OFF = 141312;

typedef unsigned short bf16_t;
typedef short bf16x8 __attribute__((ext_vector_type(8)));
typedef short s16x4 __attribute__((ext_vector_type(4)));
typedef float f32x4 __attribute__((ext_vector_type(4)));
typedef float f32x2 __attribute__((ext_vector_type(2)));
typedef float f32x16 __attribute__((ext_vector_type(16)));
typedef unsigned u32x4 __attribute__((ext_vector_type(4)));
typedef unsigned u32x2 __attribute__((ext_vector_type(2)));
#define LAS __attribute__((address_space(3)))

__device__ __forceinline__ unsigned cvt_pk_bf16(float lo, float hi) { unsigned r; asm volatile("v_cvt_pk_bf16_f32 %0, %1, %2" : "=v"(r) : "v"(lo), "v"(hi)); return r; }
__device__ __forceinline__ int TID() { int t = threadIdx.x; asm volatile("" : "+v"(t)); return t; }
__device__ __forceinline__ int BID() { int b = blockIdx.x; asm volatile("" : "+s"(b)); return b; }
__device__ __forceinline__ float bf2f(unsigned short b) { return __uint_as_float(((unsigned)b) << 16); }
__device__ __forceinline__ float wave_sum(float v) {
#pragma unroll
    for (int o = 1; o < 64; o <<= 1) v += __shfl_xor(v, o);
    return v;
}

namespace pg8 {
constexpr int BM = 256, BK = 64, HALF = 128, HTB = HALF * BK * 2, STAGE_BYTES = 8 * HTB, NXCD = 8, WGM = 8;
__host__ __device__ __forceinline__ int lds_byte(int r, int c) { const int st = (r >> 4) * 2 + (c >> 5), rr = r & 15, cc = c & 31, ob = rr * 64 + cc * 2; return st * 1024 + (ob ^ (((ob >> 9) & 1) << 5)); }
__host__ __device__ __forceinline__ void stage_rc(int b, int& R, int& C) { const int st = b / 1024, sb = b % 1024, swz = sb ^ (((sb >> 9) & 1) << 5); R = (st >> 1) * 16 + swz / 64; C = (st & 1) * 32 + (swz % 64) / 2; }
__host__ __device__ __forceinline__ int perm32(int rho) { const int n = rho >> 4, i = rho & 15; return 8 * (i >> 2) + 4 * n + (i & 3); }

__host__ __device__ __forceinline__ int permrope(int s) { return 64 * ((s >> 4) & 1) + 16 * (s >> 5) + (s & 15); }
struct Unit { int pm, pn, k0, nt, split; };
struct Gemm { const bf16_t* A; const bf16_t* Bt; int K; };

struct Sched {
    int nM, nN, nwg, G, c, nt_full, nsplit_units, split_nt, split_pm;
    __device__ __forceinline__ void init(int nM_, int nN_, int K, int G_, int c_, int nsplit, int snt, int spm) {
        nM = nM_; nN = nN_; nwg = nM * nN; G = G_; c = c_; nt_full = K / BK; nsplit_units = nsplit * nN_; split_nt = snt; split_pm = spm; }
    __device__ __forceinline__ bool next(int i, Unit& u) const {
        const long L = (long)i * G + c;
        const bool reg = L < nwg; const int s = reg ? 0 : (int)(L - nwg);
        if (!reg && s >= nsplit_units) return false;
        int wgid = reg ? (int)L : 0; { const int q = nwg / NXCD, r = nwg % NXCD, xcd = wgid % NXCD, off = wgid / NXCD; wgid = (xcd < r ? xcd * (q + 1) : r * (q + 1) + (xcd - r) * q) + off; }
        const int nig = WGM * nN, gid = wgid / nig, fm = gid * WGM, gsz = (nM - fm) < WGM ? (nM - fm) : WGM;
        const int pm_r = fm + ((wgid % nig) % gsz), pn_r = (wgid % nig) / gsz;
        const int pn_s = s % nN, sp_s = s / nN;
        u.pm = __builtin_amdgcn_readfirstlane(reg ? pm_r : split_pm); u.pn = __builtin_amdgcn_readfirstlane(reg ? pn_r : pn_s);
        u.split = __builtin_amdgcn_readfirstlane(reg ? -1 : sp_s); u.k0 = __builtin_amdgcn_readfirstlane(reg ? 0 : sp_s * split_nt); u.nt = __builtin_amdgcn_readfirstlane(reg ? nt_full : split_nt);
        return true;
    }
};

__device__ __forceinline__ float silu_mul(float g, float u) { const float e = __builtin_amdgcn_exp2f(-g * 1.4426950408889634f); return g * __builtin_amdgcn_rcpf(1.0f + e) * u; }
struct EpiSwiGLU {
    static constexpr int PERM = 1;
    bf16_t* O; int ldc;
    __device__ __forceinline__ void operator()(const f32x4 (&acc)[2][2][4][2], const Unit& u, int wr, int wc, int fr, int fq) const {
        asm volatile("" : "+v"(fr), "+v"(fq));
        const int row0 = u.pm * BM + wr * 64 + fr; const int col0 = u.pn * HALF + wc * 32 + 8 * fq;
#pragma unroll
        for (int ai = 0; ai < 2; ++ai)
#pragma unroll
            for (int m = 0; m < 4; ++m) { bf16_t* rowp = O + (size_t)(row0 + ai * HALF + m * 16) * ldc + col0;
                const f32x4 g0 = acc[ai][0][m][0], g1 = acc[ai][0][m][1], u0 = acc[ai][1][m][0], u1 = acc[ai][1][m][1];
                u32x4 w; w.x = cvt_pk_bf16(silu_mul(g0[0], u0[0]), silu_mul(g0[1], u0[1])); w.y = cvt_pk_bf16(silu_mul(g0[2], u0[2]), silu_mul(g0[3], u0[3]));
                w.z = cvt_pk_bf16(silu_mul(g1[0], u1[0]), silu_mul(g1[1], u1[1])); w.w = cvt_pk_bf16(silu_mul(g1[2], u1[2]), silu_mul(g1[3], u1[3]));
                *(u32x4*)rowp = w; }
    }
};
struct EpiResid {
    static constexpr int PERM = 0;
    const float* Xs; float* X; const float* gate; float coef; float* part;
    __device__ __forceinline__ void operator()(const f32x4 (&acc)[2][2][4][2], const Unit& u, int wr, int wc, int fr, int fq) const {
        asm volatile("" : "+v"(fr), "+v"(fq));
        const int col0 = u.pn * BM + wc * 32 + 4 * fq;
        if (u.split < 0) {
            f32x4 gv[2][2];
#pragma unroll
            for (int bj = 0; bj < 2; ++bj)
#pragma unroll
                for (int n = 0; n < 2; ++n) gv[bj][n] = *(const f32x4*)(gate + col0 + bj * HALF + n * 16) * coef;
#pragma unroll
            for (int ai = 0; ai < 2; ++ai)
#pragma unroll
                for (int mh = 0; mh < 1; ++mh) {
                    f32x4 xv[4][2][2];
#pragma unroll
                    for (int mm = 0; mm < 4; ++mm) { const int m = mh * 4 + mm; const float* rows = Xs + (size_t)(u.pm * BM + ai * HALF + wr * 64 + m * 16 + fr) * DM + col0;
#pragma unroll
                        for (int bj = 0; bj < 2; ++bj)
#pragma unroll
                            for (int n = 0; n < 2; ++n) xv[mm][bj][n] = *(const f32x4*)(rows + bj * HALF + n * 16); }
#pragma unroll
                    for (int mm = 0; mm < 4; ++mm) { const int m = mh * 4 + mm; float* rowp = X + (size_t)(u.pm * BM + ai * HALF + wr * 64 + m * 16 + fr) * DM + col0;
#pragma unroll
                        for (int bj = 0; bj < 2; ++bj)
#pragma unroll
                            for (int n = 0; n < 2; ++n) *(f32x4*)(rowp + bj * HALF + n * 16) = xv[mm][bj][n] + gv[bj][n] * acc[ai][bj][m][n]; }
                    asm volatile("" ::: "memory"); }
        } else {
            float* base = part + (size_t)u.split * 256 * DM;
#pragma unroll
            for (int ai = 0; ai < 2; ++ai)
#pragma unroll
                for (int m = 0; m < 4; ++m) { float* rowp = base + (size_t)(ai * HALF + wr * 64 + m * 16 + fr) * DM + col0;
#pragma unroll
                    for (int bj = 0; bj < 2; ++bj)
#pragma unroll
                        for (int n = 0; n < 2; ++n) *(f32x4*)(rowp + bj * HALF + n * 16) = acc[ai][bj][m][n]; }
        }
    }
};

struct EpiQK {
    static constexpr int PERM = 2;
    bf16_t* O; int ldc; int layer; const float* g0; const float* g1; const float* g2; const float* g3; LAS float* xch;
    __device__ __forceinline__ void operator()(const f32x4 (&acc)[2][2][4][2], const Unit& u, int wr, int wc, int fr, int fq) const {
        asm volatile("" : "+v"(fr), "+v"(fq));
        const int pn = u.pn;
        const float* const q0 = g0; const float* const q1 = g1; const float* const q2 = g2; const float* const q3 = g3; const int lay = layer;
        const int kind0 = (pn < 4) ? 1 : ((pn < 8) ? 2 : ((pn < 12) ? 1 : ((pn == 16) ? 2 : 0))), kind1 = (pn < 10) ? 2 : 0;
        const float* const gain0 = (pn < 4) ? q0 : ((pn < 8) ? q1 : ((pn < 12) ? q2 : q3)); const float* const gain1 = (pn < 8) ? q0 : q1;
        const int kind = lay == 0 ? kind0 : kind1; const float* const gain = lay == 0 ? gain0 : gain1;
        const bool latent = u.pm < SEQ / 256;
        const int dl = 16 * wc + 4 * fq;
        bf16_t* obase = O + (size_t)(u.pm * BM + wr * 64 + fr) * ldc + pn * BM + dl;
        if (kind == 0) {
#pragma unroll
            for (int ai = 0; ai < 2; ++ai)
#pragma unroll
                for (int m = 0; m < 4; ++m)
#pragma unroll
                    for (int bj = 0; bj < 2; ++bj) { bf16_t* p = obase + (size_t)(ai * HALF + m * 16) * ldc + bj * HALF; const f32x4 x1 = acc[ai][bj][m][0], x2 = acc[ai][bj][m][1];
                        u32x2 w1, w2; w1.x = cvt_pk_bf16(x1[0], x1[1]); w1.y = cvt_pk_bf16(x1[2], x1[3]); w2.x = cvt_pk_bf16(x2[0], x2[1]); w2.y = cvt_pk_bf16(x2[2], x2[3]);
                        *(u32x2*)p = w1; *(u32x2*)(p + 64) = w2; }
            return;
        }
        LAS float* xr = xch + ((wr * 128 + fr) * 8 + wc);
#pragma unroll
        for (int ai = 0; ai < 2; ++ai)
#pragma unroll
            for (int m = 0; m < 4; ++m)
#pragma unroll
                for (int bj = 0; bj < 2; ++bj) { const f32x4 x1 = acc[ai][bj][m][0], x2 = acc[ai][bj][m][1];
                    float s = (x1[0] * x1[0] + x1[1] * x1[1]) + (x1[2] * x1[2] + x1[3] * x1[3]) + (x2[0] * x2[0] + x2[1] * x2[1]) + (x2[2] * x2[2] + x2[3] * x2[3]);
                    s += __shfl_xor(s, 16); s += __shfl_xor(s, 32);
                    if (fq == 0) xr[(ai * 64 + m * 16) * 8 + bj * 4] = s; }
        asm volatile("s_waitcnt lgkmcnt(0)" ::: "memory"); __builtin_amdgcn_s_barrier(); asm volatile("" ::: "memory");
        const f32x4 ga = *(const f32x4*)(gain + dl), gb = *(const f32x4*)(gain + 64 + dl);
        const bool rope = (kind == 2) && latent;
        float inv[4];
#pragma unroll
        for (int j = 0; j < 4; ++j) inv[j] = exp2f(-(float)((dl + j) & 31) * (13.287712379549449f / 32.0f)) * 0.15915494309189535f;
#pragma unroll
        for (int ai = 0; ai < 2; ++ai)
#pragma unroll
            for (int m = 0; m < 4; ++m) {
                const int row = u.pm * BM + ai * HALF + wr * 64 + m * 16 + fr;
                float cs[4], sn[4];
#pragma unroll
                for (int j = 0; j < 4; ++j) { cs[j] = 1.f; sn[j] = 0.f; }
                if (rope) { const float pos = (wc < 2) ? (float)(row >> 6) : (float)(row & 63);
#pragma unroll
                    for (int j = 0; j < 4; ++j) { float rv = pos * inv[j]; rv -= floorf(rv); sn[j] = __builtin_amdgcn_sinf(rv); cs[j] = __builtin_amdgcn_cosf(rv); } }
#pragma unroll
                for (int bj = 0; bj < 2; ++bj) {
                    const f32x4 pr = *(const LAS f32x4*)(xch + ((wr * 128 + ai * 64 + m * 16 + fr) * 8 + bj * 4));
                    const float rstd = 1.0f / sqrtf(((pr[0] + pr[1]) + (pr[2] + pr[3])) * (1.0f / 128.0f) + EPS);
                    const f32x4 x1 = acc[ai][bj][m][0] * rstd * ga, x2 = acc[ai][bj][m][1] * rstd * gb;
                    float y1[4], y2[4];
#pragma unroll
                    for (int j = 0; j < 4; ++j) { y1[j] = x1[j] * cs[j] - x2[j] * sn[j]; y2[j] = x1[j] * sn[j] + x2[j] * cs[j]; }
                    bf16_t* p = obase + (size_t)(ai * HALF + m * 16) * ldc + bj * HALF;
                    u32x2 w1, w2; w1.x = cvt_pk_bf16(y1[0], y1[1]); w1.y = cvt_pk_bf16(y1[2], y1[3]); w2.x = cvt_pk_bf16(y2[0], y2[1]); w2.y = cvt_pk_bf16(y2[2], y2[3]);
                    *(u32x2*)p = w1; *(u32x2*)(p + 64) = w2; }
            }
    }
};

template <class Epi, bool ALIGN_EPI, bool SP2>
__device__ __forceinline__ void gemm_phase(LAS unsigned char* lds, const Gemm g, const Sched& S, const Epi& E) {
    const int tid = TID(), wid = __builtin_amdgcn_readfirstlane(tid >> 6), lane = tid & 63, wr = wid >> 2, wc = wid & 3, fr = lane & 15, fq = lane >> 4;
    const int K = g.K;
    unsigned voffA[2], voffB[2];
#pragma unroll
    for (int i = 0; i < 2; ++i) { int R, C; stage_rc(tid * 16 + i * 8192, R, C); const int Rb = Epi::PERM == 1 ? ((R & ~31) + perm32(R & 31)) : (Epi::PERM == 2 ? ((R & ~127) + permrope(R & 127)) : R);
        voffA[i] = (unsigned)(R * K + C) * 2u; voffB[i] = (unsigned)(Rb * K + C) * 2u; }
    const size_t kstep = (size_t)(BK * 2);
    const size_t hstep = (size_t)HALF * K * 2;
    const size_t tstep = 2 * hstep;
    const unsigned ldsw = (unsigned)wid * 1024u;
    const int aoff = lds_byte(wr * 64 + fr, fq * 8), boff = lds_byte(wc * 32 + fr, fq * 8);
#define PG8_SA(b, h) (((b) * 2 + (h)) * HTB)
#define PG8_SB(b, h) ((4 + (b) * 2 + (h)) * HTB)
#define PG8_STAGE(bufoff, gbase, voff) do { _Pragma("unroll") for (int _i = 0; _i < 2; ++_i) \
        __builtin_amdgcn_global_load_lds((const unsigned*)((const char*)(gbase) + (voff)[_i]), (LAS unsigned*)(lds + (bufoff) + ldsw + _i * 8192), 16, 0, 0); } while (0)
#define PG8_LDA(dst, b, h) do { _Pragma("unroll") for (int m = 0; m < 4; ++m) _Pragma("unroll") for (int k = 0; k < 2; ++k) dst[m][k] = *(const LAS bf16x8*)(lds + PG8_SA(b, h) + aoff + m * 2048 + k * 1024); } while (0)
#define PG8_LDB(dst, b, h) do { _Pragma("unroll") for (int n = 0; n < 2; ++n) _Pragma("unroll") for (int k = 0; k < 2; ++k) dst[n][k] = *(const LAS bf16x8*)(lds + PG8_SB(b, h) + boff + n * 2048 + k * 1024); } while (0)
#define PG8_MMA(ai, bj, At, Bt) do { __builtin_amdgcn_s_setprio(1); _Pragma("unroll") for (int m = 0; m < 4; ++m) _Pragma("unroll") for (int n = 0; n < 2; ++n) _Pragma("unroll") for (int k = 0; k < 2; ++k) \
        acc[ai][bj][m][n] = __builtin_amdgcn_mfma_f32_16x16x32_bf16(Bt[n][k], At[m][k], acc[ai][bj][m][n], 0, 0, 0); __builtin_amdgcn_s_setprio(0); } while (0)
#define PG8_WAIT_V(n) asm volatile("s_waitcnt vmcnt(" #n ")" ::: "memory")
#define PG8_WAIT_L(n) asm volatile("s_waitcnt lgkmcnt(" #n ")" ::: "memory")
#define PG8_BAR __builtin_amdgcn_s_barrier()
#define PG8_SCHED __builtin_amdgcn_sched_barrier(0)
    Unit cur, nxt; int ui = 0;
    if (!S.next(0, cur)) return;
    f32x4 acc[2][2][4][2];
#pragma unroll
    for (int a = 0; a < 2; ++a)
#pragma unroll
        for (int b = 0; b < 2; ++b)
#pragma unroll
            for (int m = 0; m < 4; ++m)
#pragma unroll
                for (int n = 0; n < 2; ++n) acc[a][b][m][n] = (f32x4){0.f, 0.f, 0.f, 0.f};
    bf16x8 At[4][2], B0[2][2], B1[2][2];
    const char* cA = (const char*)g.A + (size_t)cur.pm * tstep + (size_t)cur.k0 * kstep; const char* cB = (const char*)g.Bt + (size_t)cur.pn * tstep + (size_t)cur.k0 * kstep;
    if constexpr (SP2) {
        PG8_STAGE(PG8_SB(0, 0), cB, voffB); PG8_STAGE(PG8_SB(0, 1), cB + hstep, voffB); PG8_STAGE(PG8_SA(0, 0), cA, voffA); PG8_STAGE(PG8_SA(0, 1), cA + hstep, voffA);
        if (wr == 1) PG8_BAR;
        PG8_WAIT_V(2); PG8_BAR;
        PG8_STAGE(PG8_SB(1, 0), cB + kstep, voffB); PG8_STAGE(PG8_SA(1, 0), cA + kstep, voffA); PG8_STAGE(PG8_SB(1, 1), cB + hstep + kstep, voffB);
        PG8_WAIT_V(6); PG8_BAR;
    } else {
        PG8_STAGE(PG8_SB(0, 0), cB, voffB); PG8_STAGE(PG8_SA(0, 0), cA, voffA); PG8_STAGE(PG8_SB(0, 1), cB + hstep, voffB); PG8_STAGE(PG8_SA(0, 1), cA + hstep, voffA);
        if (wr == 1) PG8_BAR;
        PG8_WAIT_V(4); PG8_BAR;
        PG8_STAGE(PG8_SB(1, 0), cB + kstep, voffB); PG8_STAGE(PG8_SA(1, 0), cA + kstep, voffA); PG8_STAGE(PG8_SB(1, 1), cB + hstep + kstep, voffB);
        PG8_WAIT_V(6); PG8_BAR;
    }
    for (;;) {
        const bool has_next = S.next(ui + 1, nxt);
        const int nt = cur.nt;
        const char* nA = has_next ? (const char*)g.A + (size_t)nxt.pm * tstep + (size_t)nxt.k0 * kstep : cA; const char* nB = has_next ? (const char*)g.Bt + (size_t)nxt.pn * tstep + (size_t)nxt.k0 * kstep : cB;
        for (int t = 0; t < nt; t += 2) {
            const bool last = (t == nt - 2);
            const char* a1 = cA + (size_t)(t + 1) * kstep;
            const char* a2 = last ? nA : cA + (size_t)(t + 2) * kstep; const char* b2 = last ? nB : cB + (size_t)(t + 2) * kstep;
            const char* a3 = a2 + kstep; const char* b3 = b2 + kstep;
            if constexpr (SP2) {
            PG8_LDB(B0, 0, 0); PG8_LDB(B1, 0, 1); PG8_SCHED; PG8_LDA(At, 0, 0); PG8_STAGE(PG8_SA(1, 1), a1 + hstep, voffA);
            PG8_WAIT_V(8); PG8_WAIT_L(0); PG8_BAR; PG8_MMA(0, 0, At, B0); PG8_MMA(0, 1, At, B1); PG8_BAR; PG8_SCHED;
            PG8_LDA(At, 0, 1); PG8_STAGE(PG8_SB(0, 0), b2, voffB); PG8_STAGE(PG8_SB(0, 1), b2 + hstep, voffB); PG8_STAGE(PG8_SA(0, 0), a2, voffA);
            PG8_WAIT_V(8); PG8_WAIT_L(0); PG8_BAR; PG8_MMA(1, 0, At, B0); PG8_MMA(1, 1, At, B1); PG8_BAR; PG8_SCHED;
            PG8_LDB(B0, 1, 0); PG8_LDB(B1, 1, 1); PG8_SCHED; PG8_LDA(At, 1, 0); PG8_STAGE(PG8_SA(0, 1), a2 + hstep, voffA);
            PG8_WAIT_V(8); PG8_WAIT_L(0); PG8_BAR; PG8_MMA(0, 0, At, B0); PG8_MMA(0, 1, At, B1); PG8_BAR; PG8_SCHED;
            PG8_LDA(At, 1, 1); PG8_STAGE(PG8_SB(1, 0), b3, voffB); PG8_STAGE(PG8_SB(1, 1), b3 + hstep, voffB); PG8_STAGE(PG8_SA(1, 0), a3, voffA);
            PG8_WAIT_V(8); PG8_WAIT_L(0); PG8_BAR; PG8_MMA(1, 0, At, B0); PG8_MMA(1, 1, At, B1); PG8_BAR; PG8_SCHED;
            } else {
            PG8_LDB(B0, 0, 0); PG8_SCHED; PG8_LDA(At, 0, 0); PG8_STAGE(PG8_SA(1, 1), a1 + hstep, voffA);
            PG8_WAIT_L(8); PG8_BAR; PG8_WAIT_L(0); PG8_MMA(0, 0, At, B0); PG8_BAR; PG8_SCHED;
            PG8_LDB(B1, 0, 1); PG8_STAGE(PG8_SB(0, 0), b2, voffB);
            PG8_BAR; PG8_WAIT_L(0); PG8_MMA(0, 1, At, B1); PG8_BAR;
            PG8_LDA(At, 0, 1); PG8_STAGE(PG8_SA(0, 0), a2, voffA);
            PG8_BAR; PG8_WAIT_L(0); PG8_MMA(1, 0, At, B0); PG8_BAR; PG8_SCHED;
            PG8_STAGE(PG8_SB(0, 1), b2 + hstep, voffB);
            PG8_WAIT_V(6); PG8_BAR; PG8_MMA(1, 1, At, B1); PG8_BAR;
            PG8_LDB(B0, 1, 0); PG8_SCHED; PG8_LDA(At, 1, 0); PG8_STAGE(PG8_SA(0, 1), a2 + hstep, voffA);
            PG8_WAIT_L(8); PG8_BAR; PG8_WAIT_L(0); PG8_MMA(0, 0, At, B0); PG8_BAR; PG8_SCHED;
            PG8_LDB(B1, 1, 1); PG8_STAGE(PG8_SB(1, 0), b3, voffB);
            PG8_BAR; PG8_WAIT_L(0); PG8_MMA(0, 1, At, B1); PG8_BAR;
            PG8_LDA(At, 1, 1); PG8_STAGE(PG8_SA(1, 0), a3, voffA);
            PG8_BAR; PG8_WAIT_L(0); PG8_MMA(1, 0, At, B0); PG8_BAR; PG8_SCHED;
            PG8_STAGE(PG8_SB(1, 1), b3 + hstep, voffB);
            PG8_WAIT_V(6); PG8_BAR; PG8_MMA(1, 1, At, B1); PG8_BAR;
            }
        }
        if constexpr (ALIGN_EPI) { if (wr == 0) PG8_BAR; }
        E(acc, cur, wr, wc, fr, fq);
        if (!has_next) break;
#pragma unroll
        for (int a = 0; a < 2; ++a)
#pragma unroll
            for (int b = 0; b < 2; ++b)
#pragma unroll
                for (int m = 0; m < 4; ++m)
#pragma unroll
                    for (int n = 0; n < 2; ++n) acc[a][b][m][n] = (f32x4){0.f, 0.f, 0.f, 0.f};
        cur = nxt; cA = nA; cB = nB; ++ui;
        if constexpr (ALIGN_EPI) { if (wr == 1) PG8_BAR; }
    }
    PG8_WAIT_V(0);
    if constexpr (!ALIGN_EPI) { if (wr == 0) PG8_BAR; }
    PG8_BAR;
#undef PG8_SA
#undef PG8_SB
#undef PG8_STAGE
#undef PG8_LDA
#undef PG8_LDB
#undef PG8_MMA
#undef PG8_WAIT_V
#undef PG8_WAIT_L
#undef PG8_BAR
#undef PG8_SCHED
}
}

namespace att {
constexpr int D = 128, NW = 8, QBLK = 32, KVBLK = 64;
constexpr float SCALE = 0.088388347648318440f;
constexpr float INV_SCALE = 11.313708498984761f;
constexpr float THR = 8.f;
constexpr float NEG = -1e30f;
constexpr size_t SHM_V = KVBLK * D * 2, SHM_K = KVBLK * D * 2, SHM_ATTN = 2 * SHM_V + 2 * SHM_K + NW * 64 * 4;
constexpr int BIAS_OFF = (int)SHM_ATTN;
enum { DENSE = 0, NA = 1, SW = 2 };
#define KSWZ(row, colB) ((row) * 256 + ((colB) ^ (((row) & 7) << 4)))
#define SBAR() __builtin_amdgcn_sched_barrier(0)
__device__ __forceinline__ int crow(int r, int hi) { return (r & 3) + 8 * (r >> 2) + 4 * hi; }

__device__ __forceinline__ void partialSM(f32x16& p0, f32x16& p1, float& m_reg, float& mn, float& alpha) {
  constexpr float C = SCALE * 1.4426950408889634f;
  float pmax = p0[0];
#pragma unroll
  for (int r = 1; r < 16; ++r) pmax = fmaxf(pmax, p0[r]);
#pragma unroll
  for (int r = 0; r < 16; ++r) pmax = fmaxf(pmax, p1[r]);
  { auto rr = __builtin_amdgcn_permlane32_swap(__float_as_uint(pmax), __float_as_uint(pmax), false, false);
    pmax = fmaxf(__uint_as_float(rr[0]), __uint_as_float(rr[1])); }
  if (__builtin_expect(__all(pmax - m_reg <= THR / SCALE), 1)) { mn = m_reg; alpha = 1.f; }
  else { mn = fmaxf(m_reg, pmax); alpha = __builtin_amdgcn_exp2f((m_reg - mn) * C); m_reg = mn; }
  float mnC = -mn * C;
#pragma unroll
  for (int r = 0; r < 16; ++r) p0[r] = fmaf(p0[r], C, mnC);
#pragma unroll
  for (int r = 0; r < 16; ++r) p1[r] = fmaf(p1[r], C, mnC);
#pragma unroll
  for (int r = 0; r < 16; ++r) p0[r] = __builtin_amdgcn_exp2f(p0[r]);
}
__device__ __forceinline__ void finishSM(f32x16& p0, f32x16& p1, float alpha, float& l_reg, bf16x8& pa0, bf16x8& pa1, bf16x8& pa2, bf16x8& pa3) {
#pragma unroll
  for (int r = 0; r < 16; ++r) p1[r] = __builtin_amdgcn_exp2f(p1[r]);
  float ps = 0;
#pragma unroll
  for (int r = 0; r < 16; ++r) ps += p0[r];
#pragma unroll
  for (int r = 0; r < 16; ++r) ps += p1[r];
  { auto rr = __builtin_amdgcn_permlane32_swap(__float_as_uint(ps), __float_as_uint(ps), false, false);
    ps = __uint_as_float(rr[0]) + __uint_as_float(rr[1]); }
  l_reg = l_reg * alpha + ps;
#define PK4(P, BASE, OUT) do { unsigned a0 = cvt_pk_bf16(P[BASE + 0], P[BASE + 1]), a1 = cvt_pk_bf16(P[BASE + 2], P[BASE + 3]);   \
    unsigned b0 = cvt_pk_bf16(P[BASE + 4], P[BASE + 5]), b1 = cvt_pk_bf16(P[BASE + 6], P[BASE + 7]);                              \
    auto r0 = __builtin_amdgcn_permlane32_swap(a0, b0, false, false); auto r1 = __builtin_amdgcn_permlane32_swap(a1, b1, false, false); \
    u32x4 w = {r0[0], r1[0], r0[1], r1[1]}; OUT = *reinterpret_cast<bf16x8*>(&w); } while (0)
  PK4(p0, 0, pa0); PK4(p0, 8, pa1); PK4(p1, 0, pa2); PK4(p1, 8, pa3);
#undef PK4
}
__device__ __forceinline__ void qkt(f32x16& p0, f32x16& p1, const bf16_t* Ks, const bf16x8* qr, int r32, int hi) {
  p0 = f32x16{}; p1 = f32x16{};
#pragma unroll
  for (int d0 = 0; d0 < 8; ++d0) { int cb = (d0 * 16 + hi * 8) * 2;
    bf16x8 b0 = *reinterpret_cast<const bf16x8*>((const char*)Ks + KSWZ(r32, cb));
    bf16x8 b1 = *reinterpret_cast<const bf16x8*>((const char*)Ks + KSWZ(32 + r32, cb));
    p0 = __builtin_amdgcn_mfma_f32_32x32x16_bf16(b0, qr[d0], p0, 0, 0, 0);
    p1 = __builtin_amdgcn_mfma_f32_32x32x16_bf16(b1, qr[d0], p1, 0, 0, 0); }
}
__device__ __forceinline__ int v_st(int k, int c) { const int kk = (k & ~0xC) | ((k & 4) << 1) | ((k & 8) >> 1); return ((kk >> 3) * 4 + (c >> 5)) * 512 + ((kk & 7) * 32 + (c & 31)) * 2; }
__device__ __forceinline__ int v_rd_base(int lane) { return ((lane & 3) << 3) | (((lane >> 2) & 3) << 6) | (((lane >> 4) & 1) << 5) | (((lane >> 5) & 1) << 8); }
constexpr int v_rd_off(int d0, int ks, int half) { return d0 * 512 + ks * 4096 + half * 2048; }
template <int OFF> __device__ __forceinline__ s16x4 tr_read(int vb) {
  s16x4 r; asm volatile("ds_read_b64_tr_b16 %0, %1 offset:%2" : "=&v"(r) : "v"(vb), "i"(OFF) : "memory"); return r;
}
template <int D0> __device__ __forceinline__ void pv_one(f32x16& od, int vb, bf16x8 pa0, bf16x8 pa1, bf16x8 pa2, bf16x8 pa3) {
  const s16x4 l0 = tr_read<v_rd_off(D0, 0, 0)>(vb), h0 = tr_read<v_rd_off(D0, 0, 1)>(vb), l1 = tr_read<v_rd_off(D0, 1, 0)>(vb), h1 = tr_read<v_rd_off(D0, 1, 1)>(vb);
  const s16x4 l2 = tr_read<v_rd_off(D0, 2, 0)>(vb), h2 = tr_read<v_rd_off(D0, 2, 1)>(vb), l3 = tr_read<v_rd_off(D0, 3, 0)>(vb), h3 = tr_read<v_rd_off(D0, 3, 1)>(vb);
  asm volatile("s_waitcnt lgkmcnt(0)" ::: "memory"); SBAR();
#define PK(L, H) (bf16x8){L[0], L[1], L[2], L[3], H[0], H[1], H[2], H[3]}
  od = __builtin_amdgcn_mfma_f32_32x32x16_bf16(pa0, PK(l0, h0), od, 0, 0, 0);
  od = __builtin_amdgcn_mfma_f32_32x32x16_bf16(pa1, PK(l1, h1), od, 0, 0, 0);
  od = __builtin_amdgcn_mfma_f32_32x32x16_bf16(pa2, PK(l2, h2), od, 0, 0, 0);
  od = __builtin_amdgcn_mfma_f32_32x32x16_bf16(pa3, PK(l3, h3), od, 0, 0, 0);
#undef PK
}
__device__ __forceinline__ void pv_d0(f32x16* o, int vb, bf16x8 pa0, bf16x8 pa1, bf16x8 pa2, bf16x8 pa3) {
  pv_one<0>(o[0], vb, pa0, pa1, pa2, pa3); pv_one<1>(o[1], vb, pa0, pa1, pa2, pa3); pv_one<2>(o[2], vb, pa0, pa1, pa2, pa3); pv_one<3>(o[3], vb, pa0, pa1, pa2, pa3);
}

struct UnitP { const bf16_t* Q; const bf16_t* K; const bf16_t* V; bf16_t* O; int ldq, ldk, ldo, NT, base_row, qb; float sink_l2e; };

template <int MODE> __device__ __forceinline__ int tile_row0(const UnitP& u, int t) {
  if (MODE == DENSE) return u.base_row + KVBLK * t;
  if (t < 4) return SEQ + KVBLK * t;
  if (MODE == NA) { int R0 = 4 * u.qb - 4; R0 = R0 < 0 ? 0 : (R0 > 120 ? 120 : R0); int kr = R0 + t - 4; kr = kr > 127 ? 127 : kr; return kr * 64; }
  int k0 = 256 * u.qb - 128 + 64 * (t - 4); k0 = k0 < 0 ? 0 : (k0 > SEQ - 64 ? SEQ - 64 : k0); return k0;
}
template <int MODE> __device__ __forceinline__ void mask_tile(f32x16& p0, f32x16& p1, const UnitP& u, int t, int wid, int r32, int hi, const float* biasL) {
  if (MODE == DENSE) return;
  if (t < 4) return;
  if (MODE == SW) {
    const int kpos0 = 256 * u.qb - 128 + 64 * (t - 4); int qpos = 256 * u.qb + wid * 32 + r32; int hi_ = hi;
    asm volatile("" : "+v"(qpos), "+v"(hi_));
#pragma unroll
    for (int r = 0; r < 16; ++r) { const int k0 = kpos0 + crow(r, hi_), k1 = k0 + 32; const int d0 = k0 - qpos, d1 = k1 - qpos;
      const bool v0 = (k0 >= 0) && (k0 < SEQ) && (d0 <= 128) && (d0 >= -128); const bool v1 = (k1 >= 0) && (k1 < SEQ) && (d1 <= 128) && (d1 >= -128);
      p0[r] = v0 ? p0[r] : NEG; p1[r] = v1 ? p1[r] : NEG; }
  } else {
    int R0 = 4 * u.qb - 4; R0 = R0 < 0 ? 0 : (R0 > 120 ? 120 : R0); const int kr = R0 + t - 4;
    const int rq = 4 * u.qb + (wid >> 1); int rs = rq - 4; rs = rs < 0 ? 0 : (rs > 120 ? 120 : rs);
    const bool rowvalid = (kr >= rs) && (kr < rs + 8);
    if (!rowvalid) {
#pragma unroll
      for (int r = 0; r < 16; ++r) { p0[r] = NEG; p1[r] = NEG; }
      return; }
    int cq = (wid & 1) * 32 + r32; int hi_ = hi;
    asm volatile("" : "+v"(cq), "+v"(hi_));
    int cs = cq - 8; cs = cs < 0 ? 0 : (cs > 48 ? 48 : cs);
    int brow = kr - rq + 7; brow = brow < 0 ? 0 : (brow > 14 ? 14 : brow);
    const float* bl = biasL + brow * 31 + 15 - cq;
#pragma unroll
    for (int r = 0; r < 16; ++r) { const int k0 = crow(r, hi_), k1 = k0 + 32;
      const bool v0 = rowvalid && (k0 >= cs) && (k0 < cs + 16); const bool v1 = rowvalid && (k1 >= cs) && (k1 < cs + 16);
      int i0 = k0 - cq; i0 = i0 < -15 ? -15 : (i0 > 15 ? 15 : i0); int i1 = k1 - cq; i1 = i1 < -15 ? -15 : (i1 > 15 ? 15 : i1);
      const float b0 = bl[cq + i0], b1 = bl[cq + i1];
      p0[r] = v0 ? p0[r] + b0 : NEG; p1[r] = v1 ? p1[r] + b1 : NEG;
      SBAR(); }
  }
}

template <int MODE, int SDEPTH>
__device__ __forceinline__ void attn_unit(const UnitP& u, char* lds) {
  const int tid = TID(), wid = tid >> 6, lane = tid & 63, r32 = lane & 31, hi = lane >> 5;
  bf16_t* V_lds = (bf16_t*)lds; bf16_t* K_lds = (bf16_t*)(lds + 2 * SHM_V);
  float* ws = (float*)(lds + 2 * SHM_V + 2 * SHM_K) + wid * 64; float* li_l = ws; float* al_l = ws + 32;
  const float* biasL = (const float*)(lds + BIAS_OFF);
  const bf16_t* __restrict__ Kh = u.K; const bf16_t* __restrict__ Vh = u.V; const int LDK = u.ldk;
  float m_reg = -1e30f, l_reg = 0; f32x16 o[4] = {}; bf16x8 qr[8];
  const bf16_t* Qw = u.Q + (long)(wid * QBLK + r32) * u.ldq + hi * 8;
#pragma unroll
  for (int d0 = 0; d0 < 8; ++d0) qr[d0] = *reinterpret_cast<const bf16x8*>(Qw + d0 * 16);
  const int vb0 = (int)(uintptr_t)V_lds + v_rd_base(lane);
  struct { bf16x8 vs0, vs1, ks0, ks1; } sr_[SDEPTH];
#define SLOAD(i, k0) do { int t_ = tid; if (MODE != DENSE) asm volatile("" : "+v"(t_)); const int sr = t_ >> 4, sc = (t_ & 15) * 8; \
    const long _r0 = (long)((k0) + sr) * LDK + sc, _r1 = (long)((k0) + 32 + sr) * LDK + sc; \
    sr_[i].vs0 = *reinterpret_cast<const bf16x8*>(&Vh[_r0]); sr_[i].vs1 = *reinterpret_cast<const bf16x8*>(&Vh[_r1]); \
    sr_[i].ks0 = *reinterpret_cast<const bf16x8*>(&Kh[_r0]); sr_[i].ks1 = *reinterpret_cast<const bf16x8*>(&Kh[_r1]); } while (0)
#define SWRITE(b, i) do { int t_ = tid; if (MODE != DENSE) asm volatile("" : "+v"(t_)); const int sr = t_ >> 4, sc = (t_ & 15) * 8, vst0 = v_st(sr, sc), vst1 = v_st(32 + sr, sc); \
    *(bf16x8*)((char*)V_lds + (b) * SHM_V + vst0) = sr_[i].vs0;          \
    *(bf16x8*)((char*)V_lds + (b) * SHM_V + vst1) = sr_[i].vs1; int kc = sc * 2;               \
    *(bf16x8*)((char*)K_lds + (b) * SHM_K + KSWZ(sr, kc)) = sr_[i].ks0;                       \
    *(bf16x8*)((char*)K_lds + (b) * SHM_K + KSWZ(32 + sr, kc)) = sr_[i].ks1; } while (0)
#define SWAIT() do { if constexpr (SDEPTH == 2) asm volatile("s_waitcnt vmcnt(4)" ::: "memory"); else asm volatile("s_waitcnt vmcnt(0)" ::: "memory"); } while (0)
#define RESC(a) do { if (__any((a) < 1.f)) { if (hi == 0) al_l[r32] = (a); asm volatile("s_waitcnt lgkmcnt(0)" ::: "memory"); \
    _Pragma("unroll") for (int d = 0; d < 4; ++d) _Pragma("unroll") for (int r = 0; r < 16; ++r) o[d][r] *= al_l[crow(r, hi)]; } } while (0)
#define ROW0(t) tile_row0<MODE>(u, (t))
  f32x16 pA0, pA1, pB0, pB1; float mnA, mnB, alA, alB; bf16x8 pa0, pa1, pa2, pa3; const int NT = u.NT;
  constexpr int SE = 0, SO = SDEPTH - 1;
  SLOAD(SE, ROW0(0)); asm volatile("s_waitcnt vmcnt(0)" ::: "memory"); SWRITE(0, SE); __syncthreads();
  qkt(pA0, pA1, K_lds, qr, r32, hi); mask_tile<MODE>(pA0, pA1, u, 0, wid, r32, hi, biasL); partialSM(pA0, pA1, m_reg, mnA, alA);
  SLOAD(SO, ROW0(1)); if constexpr (SDEPTH == 2) { if (2 < NT) SLOAD(SE, ROW0(2)); }
  SWAIT(); SWRITE(1, SO); __syncthreads();
  for (int j = 1; j + 1 < NT; j += 2) {
    SBAR(); qkt(pB0, pB1, (bf16_t*)((char*)K_lds + SHM_K), qr, r32, hi);
    finishSM(pA0, pA1, alA, l_reg, pa0, pa1, pa2, pa3); SBAR();
    SLOAD(SO, ROW0(j + SDEPTH)); SBAR();
    pv_d0(o, vb0, pa0, pa1, pa2, pa3); mask_tile<MODE>(pB0, pB1, u, j, wid, r32, hi, biasL); partialSM(pB0, pB1, m_reg, mnB, alB);
    __syncthreads(); SWAIT(); SWRITE(0, SE);
    RESC(alB); __syncthreads();
    SBAR(); qkt(pA0, pA1, K_lds, qr, r32, hi);
    finishSM(pB0, pB1, alB, l_reg, pa0, pa1, pa2, pa3); SBAR();
    if (SDEPTH == 1 || j + 3 < NT) SLOAD(SE, ROW0(j + 1 + SDEPTH)); SBAR();
    pv_d0(o, vb0 + (int)SHM_V, pa0, pa1, pa2, pa3); mask_tile<MODE>(pA0, pA1, u, j + 1, wid, r32, hi, biasL); partialSM(pA0, pA1, m_reg, mnA, alA);
    __syncthreads(); SWAIT(); SWRITE(1, SO);
    RESC(alA); __syncthreads();
  }
  SBAR(); qkt(pB0, pB1, (bf16_t*)((char*)K_lds + SHM_K), qr, r32, hi);
  finishSM(pA0, pA1, alA, l_reg, pa0, pa1, pa2, pa3); SBAR();
  pv_d0(o, vb0, pa0, pa1, pa2, pa3); mask_tile<MODE>(pB0, pB1, u, NT - 1, wid, r32, hi, biasL); partialSM(pB0, pB1, m_reg, mnB, alB);
  __syncthreads(); RESC(alB);
  finishSM(pB0, pB1, alB, l_reg, pa0, pa1, pa2, pa3); SBAR();
  pv_d0(o, vb0 + (int)SHM_V, pa0, pa1, pa2, pa3);
  l_reg += __builtin_amdgcn_exp2f(u.sink_l2e - m_reg * (SCALE * 1.4426950408889634f));
  if (hi == 0) li_l[r32] = l_reg; asm volatile("s_waitcnt lgkmcnt(0)" ::: "memory");
  float rli[16];
#pragma unroll
  for (int r = 0; r < 16; ++r) rli[r] = __builtin_amdgcn_rcpf(li_l[crow(r, hi)]);
  bf16_t* Ow = u.O + (long)(wid * QBLK) * u.ldo;
#pragma unroll
  for (int r = 0; r < 16; ++r) { int orow = crow(r, hi);
#pragma unroll
    for (int d0 = 0; d0 < 4; ++d0) { const float v = o[d0][r] * rli[r]; Ow[(long)orow * u.ldo + d0 * 32 + r32] = (bf16_t)(cvt_pk_bf16(v, v) & 0xffffu); } }
  __syncthreads();
#undef SLOAD
#undef SWRITE
#undef SWAIT
#undef RESC
#undef ROW0
}
#undef KSWZ
#undef SBAR
}

struct Args { const float* in[22]; float* out; unsigned char* ws; int ph_lo, ph_hi; };
#define CAS __attribute__((address_space(4)))
__device__ __forceinline__ const float* INP(int i) { const CAS char* k = (const CAS char*)__builtin_amdgcn_kernarg_segment_ptr(); asm volatile("" : "+s"(k)); return *(const float* const CAS*)(k + 8 * i); }
__device__ __forceinline__ float* OUTP() { const CAS char* k = (const CAS char*)__builtin_amdgcn_kernarg_segment_ptr(); asm volatile("" : "+s"(k)); return *(float* const CAS*)(k + 8 * 22); }
__device__ __forceinline__ unsigned char* WSP() { const CAS char* k = (const CAS char*)__builtin_amdgcn_kernarg_segment_ptr(); asm volatile("" : "+s"(k)); return *(unsigned char* const CAS*)(k + 8 * 23); }
enum { I_X = 0, I_C, I_CTX, I_CCTX, I_ADAW, I_ADAB, I_NORMG, I_WG, I_WU, I_WD, I_ABIN, I_ABOUT, I_NAQG, I_NAKG, I_NABIAS, I_SWQG, I_SWKG, I_SINK, I_GIN, I_GOUT, I_GQG, I_GKG };

__device__ __forceinline__ unsigned f2bf(float f) { unsigned u = __builtin_bit_cast(unsigned, f); return (u + 0x7fffu + ((u >> 16) & 1u)) >> 16; }
__device__ __forceinline__ unsigned pk2(float lo, float hi) { return f2bf(lo) | (f2bf(hi) << 16); }
__device__ __forceinline__ void transpose_item(const float* __restrict__ W, int K, int N, bf16_t* WT, int mode, LAS float* scr, int item, int lane) {
    const int nblk = N / 32, kb = item / nblk, nb = item % nblk, k0 = 64 * kb, n0 = 32 * nb;
#pragma unroll 8
    for (int i = 0; i < 32; ++i) { const int kk = 2 * i + (lane >> 5); scr[kk * 33 + (lane & 31)] = W[(size_t)(k0 + kk) * N + n0 + (lane & 31)]; }
    asm volatile("s_waitcnt lgkmcnt(0)" ::: "memory");
    const int c = lane & 7;
    const int rbase = (mode == 0) ? n0 : ((n0 >> 7) * 256 + (n0 & 127) + (mode == 2 ? 128 : 0));
#pragma unroll
    for (int j = 0; j < 4; ++j) { const int n = (lane >> 3) + 8 * j; const LAS float* s = scr + (8 * c) * 33 + n;
        u32x4 o; o.x = pk2(s[0 * 33], s[1 * 33]); o.y = pk2(s[2 * 33], s[3 * 33]); o.z = pk2(s[4 * 33], s[5 * 33]); o.w = pk2(s[6 * 33], s[7 * 33]);
        *(u32x4*)(WT + (size_t)(rbase + n) * K + k0 + 8 * c) = o; }
    asm volatile("s_waitcnt lgkmcnt(0)" ::: "memory");
}
__device__ __forceinline__ void phase0(const Args& a, unsigned char* lds_g, int G) {
    const int tid = TID(), lane = tid & 63, wave = tid >> 6; const int bid = BID();
    float* sc = (float*)lds_g;
    float* red = sc + 4096;
    for (int i = tid; i < DM; i += 512) { const float c = INP(I_C)[i]; sc[i] = c / (1.0f + __expf(-c)); const float cc = INP(I_CCTX)[i]; sc[DM + i] = cc / (1.0f + __expf(-cc)); }
    __syncthreads();
    float* mod = (float*)(WSP() + WS_MOD);
    for (int unit = bid; unit < 256; unit += G) {
        const int layer = unit >> 7, col0 = (unit & 127) * 144;
        f32x4 a1 = {0.f, 0.f, 0.f, 0.f}, a2 = {0.f, 0.f, 0.f, 0.f};
        if (lane < 36) {
            const float* W = INP(I_ADAW) + (size_t)layer * DM * NMODV + col0 + 4 * lane;
            for (int k = wave * 256; k < wave * 256 + 256; k += 8) {
                f32x4 w[8];
#pragma unroll
                for (int q = 0; q < 8; ++q) w[q] = __builtin_nontemporal_load((const f32x4*)(W + (size_t)(k + q) * NMODV));
#pragma unroll
                for (int q = 0; q < 8; ++q) { a1 += w[q] * sc[k + q]; a2 += w[q] * sc[DM + k + q]; }
            }
#pragma unroll
            for (int e = 0; e < 4; ++e) { red[(wave * 2 + 0) * 144 + 4 * lane + e] = a1[e]; red[(wave * 2 + 1) * 144 + 4 * lane + e] = a2[e]; }
        }
        __syncthreads();
        if (tid < 288) { const int v = tid / 144, j = tid % 144; float s = INP(I_ADAB)[layer * NMODV + col0 + j];
#pragma unroll
            for (int w = 0; w < 8; ++w) s += red[(w * 2 + v) * 144 + j];
            mod[(size_t)(layer * 2 + v) * NMODV + col0 + j] = s; }
        __syncthreads();
    }
    LAS float* scr = (LAS float*)((LAS unsigned char*)lds_g + wave * 16384);
    const int gw = bid * 8 + wave, NGW = G * 8;
    constexpr int I_GU1 = (DM / 64) * (FF / 32);
    constexpr int I_D1 = (FF / 64) * (DM / 32);
    constexpr int I_GU = 8 * I_GU1, I_D = 4 * I_D1, I_ABI = (DM / 64) * (AB_IN / 32), I_SQ = (DM / 64) * (DM / 32), I_GI = (DM / 64) * (C_IN / 32);
    constexpr int NITEMS = I_GU + I_D + I_ABI + I_SQ + I_GI + I_SQ;
    bf16_t* wgu = (bf16_t*)(WSP() + WS_WGU); bf16_t* wd = (bf16_t*)(WSP() + WS_WD);
    for (int it = gw; it < NITEMS; it += NGW) {
        int r = it;
        if (r < I_GU) { const int q = r / I_GU1, lf = q >> 1, gu = q & 1; r -= q * I_GU1;
            transpose_item((gu ? INP(I_WU) : INP(I_WG)) + (size_t)lf * DM * FF, DM, FF, wgu + (size_t)lf * WGU_ELEMS, 1 + gu, scr, r, lane); continue; }
        r -= I_GU;
        if (r < I_D) { const int lf = r / I_D1; r -= lf * I_D1; transpose_item(INP(I_WD) + (size_t)lf * FF * DM, FF, DM, wd + (size_t)lf * WD_ELEMS, 0, scr, r, lane); continue; }
        r -= I_D;
        if (r < I_ABI) { transpose_item(INP(I_ABIN), DM, AB_IN, (bf16_t*)(WSP() + WS_WABIN), 0, scr, r, lane); continue; }
        r -= I_ABI;
        if (r < I_SQ) { transpose_item(INP(I_ABOUT), DM, DM, (bf16_t*)(WSP() + WS_WABOUT), 0, scr, r, lane); continue; }
        r -= I_SQ;
        if (r < I_GI) { transpose_item(INP(I_GIN), DM, C_IN, (bf16_t*)(WSP() + WS_WGIN), 0, scr, r, lane); continue; }
        r -= I_GI;
        transpose_item(INP(I_GOUT), DM, DM, (bf16_t*)(WSP() + WS_WGOUT), 0, scr, r, lane);
    }
}

__device__ __forceinline__ void modulate_phase(const float* xsrc, const float* csrc, float* cdst, const float* part, int nsplit, const float* cgate, float ccoef,
                                               const float* g, const float* shift_l, const float* scale_l, const float* shift_c, const float* scale_c, bf16_t* h, int nrows, int G, unsigned char* lds_g) {
    const int tid = TID(), lane = tid & 63, wave = tid >> 6;
    const int bid = BID();
    if (nrows > SEQ) {
        float* red = (float*)lds_g;
        float* ssl = red + 8 * DM;
        for (int r = bid; r < CTXL; r += G) {
            f32x4 s[8];
#pragma unroll
            for (int j = 0; j < 8; ++j) s[j] = (f32x4){0.f, 0.f, 0.f, 0.f};
            for (int sp = wave; sp < nsplit; sp += 8) { const f32x4* pr = (const f32x4*)(part + ((size_t)sp * 256 + r) * DM) + lane;
#pragma unroll
                for (int j = 0; j < 8; ++j) s[j] += pr[64 * j]; }
#pragma unroll
            for (int j = 0; j < 8; ++j) *((f32x4*)(red + wave * DM) + lane + 64 * j) = s[j];
            __syncthreads();
            const int col = wave * 256 + 4 * lane;
            f32x4 t = *(const f32x4*)(red + col);
#pragma unroll
            for (int w = 1; w < 8; ++w) t += *(const f32x4*)(red + w * DM + col);
            f32x4 v = *(const f32x4*)(csrc + (size_t)r * DM + col);
            if (nsplit > 0) v += ccoef * (*(const f32x4*)(cgate + col)) * t;
            *(f32x4*)(cdst + (size_t)r * DM + col) = v;
            const float ssw = wave_sum((v.x * v.x + v.y * v.y) + (v.z * v.z + v.w * v.w));
            if (lane == 0) ssl[wave] = ssw;
            __syncthreads();
            float ss = 0.f;
#pragma unroll
            for (int w = 0; w < 8; ++w) ss += ssl[w];
            const float rstd = 1.0f / sqrtf(ss * (1.0f / DM) + EPS);
            const f32x4 y = (v * rstd) * (*(const f32x4*)(g + col)); const f32x4 z = y * (*(const f32x4*)(scale_c + col) + 1.0f) + *(const f32x4*)(shift_c + col);
            u32x2 w2; w2.x = cvt_pk_bf16(z.x, z.y); w2.y = cvt_pk_bf16(z.z, z.w); *(u32x2*)(h + (size_t)(SEQ + r) * DM + col) = w2;
            __syncthreads();
        }
    }
    const int gw = bid * 8 + wave, NGW = G * 8;
    for (int row = gw; row < SEQ; row += NGW) {
        f32x4 v[8];
        const f32x4* xr = (const f32x4*)(xsrc + (size_t)row * DM) + lane;
#pragma unroll
        for (int j = 0; j < 8; ++j) v[j] = xr[64 * j];
        float ss = 0.f;
#pragma unroll
        for (int j = 0; j < 8; ++j) ss += (v[j].x * v[j].x + v[j].y * v[j].y) + (v[j].z * v[j].z + v[j].w * v[j].w);
        const float rstd = 1.0f / sqrtf(wave_sum(ss) * (1.0f / DM) + EPS);
        const f32x4* sh = (const f32x4*)shift_l + lane; const f32x4* scl = (const f32x4*)scale_l + lane;
        const f32x4* gg = (const f32x4*)g + lane;
        u32x2* ho = (u32x2*)(h + (size_t)row * DM) + lane;
#pragma unroll
        for (int j = 0; j < 8; ++j) { const f32x4 y = (v[j] * rstd) * gg[64 * j]; const f32x4 z = y * (scl[64 * j] + 1.0f) + sh[64 * j];
            u32x2 w; w.x = cvt_pk_bf16(z.x, z.y); w.y = cvt_pk_bf16(z.z, z.w); ho[64 * j] = w; }
    }
}

__device__ __forceinline__ void attn_phase0(const Args& a, unsigned char* lds_g, int G) {
    bf16_t* P = (bf16_t*)(WSP() + WS_P); bf16_t* O = (bf16_t*)(WSP() + WS_O);
    float* biasL = (float*)(lds_g + att::BIAS_OFF);
    const int tid0 = TID();
    for (int un = BID(); un < 528; un += G) {
        att::UnitP u; u.ldq = AB_IN; u.ldk = AB_IN; u.ldo = DM; u.sink_l2e = -INFINITY;
        if (un < 256) {
            const int h = un & 7, qb = un >> 3;
            for (int i = tid0; i < 465; i += 512) biasL[i] = INP(I_NABIAS)[h * 465 + i] * att::INV_SCALE;
            __syncthreads();
            u.Q = P + (size_t)(256 * qb) * AB_IN + h * 128; u.K = P + (16 + h) * 128; u.V = P + (24 + h) * 128; u.O = O + (size_t)(256 * qb) * DM + h * 128;
            u.NT = 16; u.base_row = 0; u.qb = qb;
            att::attn_unit<att::NA, 1>(u, (char*)lds_g);
        } else if (un < 512) {
            const int hq = (un - 256) & 7, qb = (un - 256) >> 3, kvh = hq >> 2;
            u.Q = P + (size_t)(256 * qb) * AB_IN + (8 + hq) * 128; u.K = P + (32 + kvh) * 128; u.V = P + (34 + kvh) * 128; u.O = O + (size_t)(256 * qb) * DM + (8 + hq) * 128;
            u.NT = 12; u.base_row = 0; u.qb = qb; u.sink_l2e = INP(I_SINK)[hq] * 1.4426950408889634f;
            att::attn_unit<att::SW, 1>(u, (char*)lds_g);
        } else {
            const int hh = un - 512;
            u.Q = P + (size_t)SEQ * AB_IN + hh * 128; u.O = O + (size_t)SEQ * DM + hh * 128;
            const bool nah = hh < 8; const int hq = nah ? 0 : hh - 8, kvh = hq >> 2;
            const int kslot = nah ? 16 + hh : 32 + kvh, vslot = nah ? 24 + hh : 34 + kvh;
            u.K = P + kslot * 128; u.V = P + vslot * 128;
            const float sk = INP(I_SINK)[hq] * 1.4426950408889634f; u.sink_l2e = nah ? -INFINITY : sk;
            u.NT = 4; u.base_row = SEQ; u.qb = 0;
            att::attn_unit<att::DENSE, 2>(u, (char*)lds_g);
        }
    }
}
__device__ __forceinline__ void attn_phase1(const Args& a, unsigned char* lds_g, int G) {
    bf16_t* P = (bf16_t*)(WSP() + WS_P); bf16_t* O = (bf16_t*)(WSP() + WS_O);
    const int bid = BID();
    for (int i = 0;; ++i) {
        int un;
        if ((G & 7) == 0) { const int x = bid & 7, j = (bid >> 3) + i * (G >> 3); if (j >= 64) break; un = x * 64 + j; }
        else { un = bid + i * G; if (un >= 512) break; }
        const int h = un >> 5, qb = un & 31, kvh = h >> 2;
        att::UnitP u; u.ldq = C_IN; u.ldk = C_IN; u.ldo = DM; u.sink_l2e = -INFINITY;
        u.Q = P + (size_t)(256 * qb) * C_IN + h * 128; u.K = P + (16 + kvh) * 128; u.V = P + (20 + kvh) * 128; u.O = O + (size_t)(256 * qb) * DM + h * 128;
        u.NT = MT / 64; u.base_row = 0; u.qb = qb;
        att::attn_unit<att::DENSE, 2>(u, (char*)lds_g);
    }
}

#define XB_TMO      128
#define XB_XCNT(j)  (256  + 64 * (j))
#define XB_XSUB(j)  (1280 + 64 * (j))
#define XB_XGEN(j)  (2304 + 64 * (j))
#define XB_TOP      3328
#define XB_TOPGEN   3392
#define XCD_BAR_WORDS 3456
#define XB_SPIN_CAP (1u << 18)
__device__ __forceinline__ unsigned xb_ld(unsigned* p)              { return __hip_atomic_load(p, __ATOMIC_RELAXED, __HIP_MEMORY_SCOPE_AGENT); }
__device__ __forceinline__ unsigned xb_add(unsigned* p, unsigned v) { return __hip_atomic_fetch_add(p, v, __ATOMIC_RELAXED, __HIP_MEMORY_SCOPE_AGENT); }
__device__ __forceinline__ unsigned xb_xcc_id() { return (unsigned)__builtin_amdgcn_s_getreg((3 << 11) | 20) & 0xFu; }
#define XB_SPIN(cond, bar) do { unsigned _sp = 0; while (cond) { __builtin_amdgcn_s_sleep(1); \
    if ((++_sp & 255u) == 0u) { if (xb_ld(&(bar)[XB_TMO])) break; if (_sp > XB_SPIN_CAP) { atomicAdd(&(bar)[XB_TMO], 1u); break; } } } } while (0)
struct XcdBarrier { unsigned* bar; unsigned x; volatile LAS unsigned* st; };
__device__ __forceinline__ XcdBarrier xcd_barrier_post(unsigned* bar, volatile LAS unsigned* st) {
    XcdBarrier b; b.bar = bar; b.x = xb_xcc_id(); b.st = st;
    if (threadIdx.x == 0) (void)xb_add(&bar[XB_XCNT(b.x)], 1u);
    return b;
}
__device__ __forceinline__ void xcd_barrier_complete(unsigned* bar, unsigned x, unsigned& nloc, unsigned& nx) {
    const unsigned G = gridDim.x * gridDim.y * gridDim.z;
    unsigned sum, cnt, mine, sp = 0u;
    for (;;) {
        sum = 0u; cnt = 0u; mine = 0u;
#pragma unroll
        for (unsigned j = 0; j < 16; ++j) { const unsigned c = xb_ld(&bar[XB_XCNT(j)]); sum += c; cnt += (c > 0u) ? 1u : 0u; mine = (j == x) ? c : mine; }
        if (sum == G) break;
        __builtin_amdgcn_s_sleep(1);
        if ((++sp & 255u) == 0u) { if (xb_ld(&bar[XB_TMO])) break; if (sp > XB_SPIN_CAP) { atomicAdd(&bar[XB_TMO], 1u); break; } }
    }
    nloc = mine > 0u ? mine : 1u; nx = cnt > 0u ? cnt : 1u;
}
__device__ __forceinline__ void xcd_barrier(const XcdBarrier& b) {
    asm volatile("s_waitcnt vmcnt(0)" ::: "memory");
    __syncthreads();
    if (threadIdx.x == 0) {
        unsigned* bar = b.bar;
        __builtin_amdgcn_s_waitcnt(0);
        unsigned nloc = b.st[0], nx = b.st[1];
        if (nloc == 0u) { xcd_barrier_complete(bar, b.x, nloc, nx); b.st[0] = nloc; b.st[1] = nx; }
        const unsigned old = xb_add(&bar[XB_XSUB(b.x)], 1u);
        const unsigned gen = old / nloc;
        if (old + 1u == (gen + 1u) * nloc) {
            __builtin_amdgcn_fence(__ATOMIC_RELEASE, "agent");
            asm volatile("s_waitcnt vmcnt(0)" ::: "memory");
            const unsigned og = xb_add(&bar[XB_TOP], 1u);
            const unsigned tg = og / nx;
            if (og + 1u == (tg + 1u) * nx) xb_add(&bar[XB_TOPGEN], 1u);
            else XB_SPIN(xb_ld(&bar[XB_TOPGEN]) == tg, bar);
            __builtin_amdgcn_fence(__ATOMIC_ACQUIRE, "agent");
            xb_add(&bar[XB_XGEN(b.x)], 1u);
            asm volatile("s_waitcnt vmcnt(0)" ::: "memory");
        } else {
            XB_SPIN(xb_ld(&bar[XB_XGEN(b.x)]) == gen, bar);
            __builtin_amdgcn_fence(__ATOMIC_ACQUIRE, "agent");
            asm volatile("s_waitcnt vmcnt(0)" ::: "memory");
        }
    }
    __syncthreads();
}

__global__ void __launch_bounds__(512, 2) mk_fwd(Args a) {
    extern __shared__ __attribute__((aligned(16))) unsigned char lds[];
    cg::grid_group grid = cg::this_grid();
    const int G = gridDim.x;
    LAS unsigned char* lds3 = (LAS unsigned char*)lds;
    volatile LAS unsigned* misc = (volatile LAS unsigned*)(lds3 + MISC_OFF);
    if (threadIdx.x < 2) misc[threadIdx.x] = 0u;
    __syncthreads();
    XcdBarrier bar = xcd_barrier_post((unsigned*)(WSP() + WS_BAR), misc);
    float* mod = (float*)(WSP() + WS_MOD);
    float* xc = (float*)(WSP() + WS_XC); float* part = (float*)(WSP() + WS_PART);
    bf16_t* H = (bf16_t*)(WSP() + WS_H); bf16_t* O = (bf16_t*)(WSP() + WS_O); bf16_t* P = (bf16_t*)(WSP() + WS_P); bf16_t* A = (bf16_t*)(WSP() + WS_A);
    for (int ph = a.ph_lo; ph < a.ph_hi; ++ph) {
        if (ph == 0) { phase0(a, lds, G); if (REPMASK & 1) { __syncthreads(); phase0(a, lds, G); } }
        else {
            const int layer = (ph - 1) / 10, sub = (ph - 1) % 10;
            const float* mL = mod + (size_t)(layer * 2 + 0) * NMODV; const float* mC = mod + (size_t)(layer * 2 + 1) * NMODV;
            const bool with_ctx = layer == 0;
            if (sub == 0 || sub == 3 || sub == 7) {
                const int k = sub == 0 ? 0 : (sub == 3 ? 1 : 2);
                const bool first = (ph == 1);
                const float* xsrc = (ph <= 3) ? INP(I_X) : OUTP();
                const float* csrc = first ? INP(I_CTX) : xc;
                const bool upd_prev = (sub == 0 && layer == 1);
                const int nsplit = (upd_prev || sub == 3) ? NSPLIT_DOWN : ((sub == 7) ? NSPLIT_OUT : 0);
                const float* cgate = upd_prev ? (mod + (size_t)(0 * 2 + 1) * NMODV + 8 * DM) : (sub == 3 ? mC + 2 * DM : mC + 5 * DM);
                const float ccoef = (sub == 7) ? 1.0f : 0.5f;
                const int nrows = (sub == 7 && !with_ctx) ? SEQ : MT;
                modulate_phase(xsrc, csrc, xc, part, nsplit, cgate, ccoef, INP(I_NORMG) + (size_t)(layer * 3 + k) * DM,
                               mL + (3 * k) * DM, mL + (3 * k + 1) * DM, mC + (3 * k) * DM, mC + (3 * k + 1) * DM, H, nrows, G, lds);
            } else if (sub == 1 || sub == 8) {
                const int f = sub == 1 ? 0 : 1; const int nM = (f == 1 && !with_ctx) ? SEQ / 256 : MT / 256;
                pg8::Gemm g{H, (const bf16_t*)(WSP() + WS_WGU) + (size_t)(layer * 2 + f) * WGU_ELEMS, DM};
                pg8::Sched S; S.init(nM, 2 * FF / 256, DM, G, BID(), 0, 0, 0);
                pg8::EpiSwiGLU E{A, FF};
                pg8::gemm_phase<pg8::EpiSwiGLU, true, true>(lds3, g, S, E);
                if (REPMASK & 2) pg8::gemm_phase<pg8::EpiSwiGLU, true, true>(lds3, g, S, E);
            } else if (sub == 2 || sub == 9) {
                const int f = sub == 2 ? 0 : 1; const bool ctxrows = !(f == 1 && !with_ctx);
                pg8::Gemm g{A, (const bf16_t*)(WSP() + WS_WD) + (size_t)(layer * 2 + f) * WD_ELEMS, FF};
                pg8::Sched S; S.init(SEQ / 256, DM / 256, FF, G, BID(), ctxrows ? NSPLIT_DOWN : 0, NT_SPLIT_DOWN, SEQ / 256);
                pg8::EpiResid E{(ph == 3) ? INP(I_X) : (const float*)OUTP(), OUTP(), mL + (f == 0 ? 2 : 8) * DM, 0.5f, part};
                pg8::gemm_phase<pg8::EpiResid, true, true>(lds3, g, S, E);
                if (REPMASK & 256) { pg8::EpiResid E2{(const float*)P, (float*)P, mL + (f == 0 ? 2 : 8) * DM, 0.5f, part}; pg8::gemm_phase<pg8::EpiResid, true, true>(lds3, g, S, E2); }
            } else if (sub == 4) {
                const int N = layer == 0 ? AB_IN : C_IN;
                pg8::Gemm g{H, (const bf16_t*)(WSP() + (layer == 0 ? WS_WABIN : WS_WGIN)), DM};
                pg8::Sched S; S.init(MT / 256, N / 256, DM, G, BID(), 0, 0, 0);
                pg8::EpiQK E{P, N, layer, layer == 0 ? INP(I_NAQG) : INP(I_GQG), layer == 0 ? INP(I_SWQG) : INP(I_GKG), INP(I_NAKG), INP(I_SWKG), (LAS float*)(lds3 + XCH_OFF)};
                pg8::gemm_phase<pg8::EpiQK, true, true>(lds3, g, S, E);
                if (REPMASK & 16) pg8::gemm_phase<pg8::EpiQK, true, true>(lds3, g, S, E);
            }
            else if (sub == 5) { if (layer == 0) { attn_phase0(a, lds, G); if (REPMASK & 32) attn_phase0(a, lds, G); } else { attn_phase1(a, lds, G); if (REPMASK & 4) attn_phase1(a, lds, G); } }
            else if (sub == 6) {
                pg8::Gemm g{O, (const bf16_t*)(WSP() + (layer == 0 ? WS_WABOUT : WS_WGOUT)), DM};
                pg8::Sched S; S.init(SEQ / 256, DM / 256, DM, G, BID(), with_ctx ? NSPLIT_OUT : 0, NT_SPLIT_OUT, SEQ / 256);
                pg8::EpiResid E{OUTP(), OUTP(), mL + 5 * DM, 1.0f, part};
                pg8::gemm_phase<pg8::EpiResid, true, true>(lds3, g, S, E);
                if (REPMASK & 512) { pg8::EpiResid E2{(const float*)A, (float*)A, mL + 5 * DM, 1.0f, part}; pg8::gemm_phase<pg8::EpiResid, true, true>(lds3, g, S, E2); }
            }
        }
        if (ph + 1 < a.ph_hi) {
            if (a.ph_lo < 0) grid.sync(); else xcd_barrier(bar);
            if (REPMASK & 8) xcd_barrier(bar); }
    }
}

extern "C" void kernel_launch(void* const* d_in, const int* in_sizes, int n_in, void* d_out, int out_size, void* d_ws, size_t ws_size, hipStream_t stream) {
    static int grid = 0;
    if (grid == 0) {
        if (n_in != 22 || out_size != SEQ * DM || ws_size < WS_END) { fprintf(stderr, "kernel_launch: unexpected shapes (n_in %d out %d ws %zu)\n", n_in, out_size, ws_size); grid = -1; return; }
        int dev = 0, cus = 0, per_cu = 0;
        hipGetDevice(&dev); hipDeviceGetAttribute(&cus, hipDeviceAttributeMultiprocessorCount, dev);
        if (hipFuncSetAttribute((const void*)mk_fwd, hipFuncAttributeMaxDynamicSharedMemorySize, LDS_BYTES) != hipSuccess) { fprintf(stderr, "kernel_launch: hipFuncSetAttribute failed\n"); grid = -1; return; }
        if (hipOccupancyMaxActiveBlocksPerMultiprocessor(&per_cu, (const void*)mk_fwd, 512, LDS_BYTES) != hipSuccess || per_cu < 1) { fprintf(stderr, "kernel_launch: occupancy query gave %d\n", per_cu); per_cu = 1; }
        (void)hipGetLastError();
        grid = cus * per_cu;
        if (grid > 256) grid = 256;
    }
    if (grid < 0) return;
    if (hipMemsetAsync((char*)d_ws + WS_BAR, 0, BAR_BYTES, stream) != hipSuccess) { fprintf(stderr, "kernel_launch: memset failed\n"); return; }
    Args a{};
    for (int i = 0; i < 22; ++i) a.in[i] = (const float*)d_in[i];
    a.out = (float*)d_out; a.ws = (unsigned char*)d_ws;
#if MK_MULTI
    for (int p = 0; p < NPHASE; ++p) { a.ph_lo = p; a.ph_hi = p + 1; hipLaunchKernelGGL(mk_fwd, dim3(grid), dim3(512), LDS_BYTES, stream, a); }
#else
    a.ph_lo = 0; a.ph_hi = NPHASE;
    void* args[] = {&a};
    hipError_t e = hipLaunchCooperativeKernel((const void*)mk_fwd, dim3(grid), dim3(512), args, LDS_BYTES, stream);
    if (e != hipSuccess) fprintf(stderr, "cooperative launch failed: %s (grid %d)\n", hipGetErrorString(e), grid);
#endif
}
```

```cpp
#include <hip/hip_runtime.h>
#include <hip/hip_cooperative_groups.h>
#include <cstdio>
#include <cstdint>
namespace cg = cooperative_groups;

#ifndef REPMASK
#define REPMASK 0
#endif
#ifndef MK_MULTI
#define MK_MULTI 0
#endif

constexpr int SEQ = 8192, CTXL = 256, MT = SEQ + CTXL, DM = 2048, FF = 5632, NMODV = 9 * DM;
constexpr int AB_IN = 4608, C_IN = 3072, GRIDW = 64;
constexpr float EPS = 1e-6f;
constexpr int NPHASE = 21;
constexpr int NSPLIT_DOWN = 22, NT_SPLIT_DOWN = 4;
constexpr int NSPLIT_OUT = 16, NT_SPLIT_OUT = 2;

constexpr size_t MiB = 1u << 20;
constexpr size_t WS_MOD = 0;
constexpr size_t WS_BAR = 512 * 1024, BAR_BYTES = 16384;
constexpr size_t WS_XC = 1 * MiB;
constexpr size_t WS_PART = 4 * MiB;
constexpr size_t WS_H = 52 * MiB;
constexpr size_t WS_O = 88 * MiB;
constexpr size_t WS_P = 124 * MiB;
constexpr size_t WS_A = 200 * MiB;
constexpr size_t WS_WGU = 292 * MiB;
constexpr size_t WS_WD = 468 * MiB;
constexpr size_t WS_WABIN = 556 * MiB;
constexpr size_t WS_WABOUT = 574 * MiB;
constexpr size_t WS_WGIN = 582 * MiB;
constexpr size_t WS_WGOUT = 594 * MiB;
constexpr size_t WS_END = 602 * MiB;
constexpr size_t WGU_ELEMS = (size_t)2 * FF * DM, WD_ELEMS = (size_t)DM * FF;

constexpr int LDS_BYTES = 143360;
constexpr int XCH_OFF = 131072;
constexpr int MISC_OFF = 141312;

typedef unsigned short bf16_t;
typedef short bf16x8 __attribute__((ext_vector_type(8)));
typedef short s16x4 __attribute__((ext_vector_type(4)));
typedef float f32x4 __attribute__((ext_vector_type(4)));
typedef float f32x2 __attribute__((ext_vector_type(2)));
typedef float f32x16 __attribute__((ext_vector_type(16)));
typedef unsigned u32x4 __attribute__((ext_vector_type(4)));
typedef unsigned u32x2 __attribute__((ext_vector_type(2)));
#define LAS __attribute__((address_space(3)))

__device__ __forceinline__ unsigned cvt_pk_bf16(float lo, float hi) { unsigned r; asm volatile("v_cvt_pk_bf16_f32 %0, %1, %2" : "=v"(r) : "v"(lo), "v"(hi)); return r; }
__device__ __forceinline__ int TID() { int t = threadIdx.x; asm volatile("" : "+v"(t)); return t; }
__device__ __forceinline__ int BID() { int b = blockIdx.x; asm volatile("" : "+s"(b)); return b; }
__device__ __forceinline__ float bf2f(unsigned short b) { return __uint_as_float(((unsigned)b) << 16); }
__device__ __forceinline__ float wave_sum(float v) {
#pragma unroll
    for (int o = 1; o < 64; o <<= 1) v += __shfl_xor(v, o);
    return v;
}

namespace pg8 {
constexpr int BM = 256, BK = 64, HALF = 128, HTB = HALF * BK * 2, STAGE_BYTES = 8 * HTB, NXCD = 8, WGM = 8;
__host__ __device__ __forceinline__ int lds_byte(int r, int c) { const int st = (r >> 4) * 2 + (c >> 5), rr = r & 15, cc = c & 31, ob = rr * 64 + cc * 2; return st * 1024 + (ob ^ (((ob >> 9) & 1) << 5)); }
__host__ __device__ __forceinline__ void stage_rc(int b, int& R, int& C) { const int st = b / 1024, sb = b % 1024, swz = sb ^ (((sb >> 9) & 1) << 5); R = (st >> 1) * 16 + swz / 64; C = (st & 1) * 32 + (swz % 64) / 2; }
__host__ __device__ __forceinline__ int perm32(int rho) { const int n = rho >> 4, i = rho & 15; return 8 * (i >> 2) + 4 * n + (i & 3); }

__host__ __device__ __forceinline__ int permrope(int s) { return 64 * ((s >> 4) & 1) + 16 * (s >> 5) + (s & 15); }
struct Unit { int pm, pn, k0, nt, split; };
struct Gemm { const bf16_t* A; const bf16_t* Bt; int K; };

struct Sched {
    int nM, nN, nwg, G, c, nt_full, nsplit_units, split_nt, split_pm;
    __device__ __forceinline__ void init(int nM_, int nN_, int K, int G_, int c_, int nsplit, int snt, int spm) {
        nM = nM_; nN = nN_; nwg = nM * nN; G = G_; c = c_; nt_full = K / BK; nsplit_units = nsplit * nN_; split_nt = snt; split_pm = spm; }
    __device__ __forceinline__ bool next(int i, Unit& u) const {
        const long L = (long)i * G + c;
        const bool reg = L < nwg; const int s = reg ? 0 : (int)(L - nwg);
        if (!reg && s >= nsplit_units) return false;
        int wgid = reg ? (int)L : 0; { const int q = nwg / NXCD, r = nwg % NXCD, xcd = wgid % NXCD, off = wgid / NXCD; wgid = (xcd < r ? xcd * (q + 1) : r * (q + 1) + (xcd - r) * q) + off; }
        const int nig = WGM * nN, gid = wgid / nig, fm = gid * WGM, gsz = (nM - fm) < WGM ? (nM - fm) : WGM;
        const int pm_r = fm + ((wgid % nig) % gsz), pn_r = (wgid % nig) / gsz;
        const int pn_s = s % nN, sp_s = s / nN;
        u.pm = __builtin_amdgcn_readfirstlane(reg ? pm_r : split_pm); u.pn = __builtin_amdgcn_readfirstlane(reg ? pn_r : pn_s);
        u.split = __builtin_amdgcn_readfirstlane(reg ? -1 : sp_s); u.k0 = __builtin_amdgcn_readfirstlane(reg ? 0 : sp_s * split_nt); u.nt = __builtin_amdgcn_readfirstlane(reg ? nt_full : split_nt);
        return true;
    }
};

__device__ __forceinline__ float silu_mul(float g, float u) { const float e = __builtin_amdgcn_exp2f(-g * 1.4426950408889634f); return g * __builtin_amdgcn_rcpf(1.0f + e) * u; }
struct EpiSwiGLU {
    static constexpr int PERM = 1;
    bf16_t* O; int ldc;
    __device__ __forceinline__ void operator()(const f32x4 (&acc)[2][2][4][2], const Unit& u, int wr, int wc, int fr, int fq) const {
        asm volatile("" : "+v"(fr), "+v"(fq));
        const int row0 = u.pm * BM + wr * 64 + fr; const int col0 = u.pn * HALF + wc * 32 + 8 * fq;
#pragma unroll
        for (int ai = 0; ai < 2; ++ai)
#pragma unroll
            for (int m = 0; m < 4; ++m) { bf16_t* rowp = O + (size_t)(row0 + ai * HALF + m * 16) * ldc + col0;
                const f32x4 g0 = acc[ai][0][m][0], g1 = acc[ai][0][m][1], u0 = acc[ai][1][m][0], u1 = acc[ai][1][m][1];
                u32x4 w; w.x = cvt_pk_bf16(silu_mul(g0[0], u0[0]), silu_mul(g0[1], u0[1])); w.y = cvt_pk_bf16(silu_mul(g0[2], u0[2]), silu_mul(g0[3], u0[3]));
                w.z = cvt_pk_bf16(silu_mul(g1[0], u1[0]), silu_mul(g1[1], u1[1])); w.w = cvt_pk_bf16(silu_mul(g1[2], u1[2]), silu_mul(g1[3], u1[3]));
                *(u32x4*)rowp = w; }
    }
};
struct EpiResid {
    static constexpr int PERM = 0;
    const float* Xs; float* X; const float* gate; float coef; float* part;
    __device__ __forceinline__ void operator()(const f32x4 (&acc)[2][2][4][2], const Unit& u, int wr, int wc, int fr, int fq) const {
        asm volatile("" : "+v"(fr), "+v"(fq));
        const int col0 = u.pn * BM + wc * 32 + 4 * fq;
        if (u.split < 0) {
            f32x4 gv[2][2];
#pragma unroll
            for (int bj = 0; bj < 2; ++bj)
#pragma unroll
                for (int n = 0; n < 2; ++n) gv[bj][n] = *(const f32x4*)(gate + col0 + bj * HALF + n * 16) * coef;
#pragma unroll
            for (int ai = 0; ai < 2; ++ai)
#pragma unroll
                for (int mh = 0; mh < 1; ++mh) {
                    f32x4 xv[4][2][2];
#pragma unroll
                    for (int mm = 0; mm < 4; ++mm) { const int m = mh * 4 + mm; const float* rows = Xs + (size_t)(u.pm * BM + ai * HALF + wr * 64 + m * 16 + fr) * DM + col0;
#pragma unroll
                        for (int bj = 0; bj < 2; ++bj)
#pragma unroll
                            for (int n = 0; n < 2; ++n) xv[mm][bj][n] = *(const f32x4*)(rows + bj * HALF + n * 16); }
#pragma unroll
                    for (int mm = 0; mm < 4; ++mm) { const int m = mh * 4 + mm; float* rowp = X + (size_t)(u.pm * BM + ai * HALF + wr * 64 + m * 16 + fr) * DM + col0;
#pragma unroll
                        for (int bj = 0; bj < 2; ++bj)
#pragma unroll
                            for (int n = 0; n < 2; ++n) *(f32x4*)(rowp + bj * HALF + n * 16) = xv[mm][bj][n] + gv[bj][n] * acc[ai][bj][m][n]; }
                    asm volatile("" ::: "memory"); }
        } else {
            float* base = part + (size_t)u.split * 256 * DM;
#pragma unroll
            for (int ai = 0; ai < 2; ++ai)
#pragma unroll
                for (int m = 0; m < 4; ++m) { float* rowp = base + (size_t)(ai * HALF + wr * 64 + m * 16 + fr) * DM + col0;
#pragma unroll
                    for (int bj = 0; bj < 2; ++bj)
#pragma unroll
                        for (int n = 0; n < 2; ++n) *(f32x4*)(rowp + bj * HALF + n * 16) = acc[ai][bj][m][n]; }
        }
    }
};

struct EpiQK {
    static constexpr int PERM = 2;
    bf16_t* O; int ldc; int layer; const float* g0; const float* g1; const float* g2; const float* g3; LAS float* xch;
    __device__ __forceinline__ void operator()(const f32x4 (&acc)[2][2][4][2], const Unit& u, int wr, int wc, int fr, int fq) const {
        asm volatile("" : "+v"(fr), "+v"(fq));
        const int pn = u.pn;
        const float* const q0 = g0; const float* const q1 = g1; const float* const q2 = g2; const float* const q3 = g3; const int lay = layer;
        const int kind0 = (pn < 4) ? 1 : ((pn < 8) ? 2 : ((pn < 12) ? 1 : ((pn == 16) ? 2 : 0))), kind1 = (pn < 10) ? 2 : 0;
        const float* const gain0 = (pn < 4) ? q0 : ((pn < 8) ? q1 : ((pn < 12) ? q2 : q3)); const float* const gain1 = (pn < 8) ? q0 : q1;
        const int kind = lay == 0 ? kind0 : kind1; const float* const gain = lay == 0 ? gain0 : gain1;
        const bool latent = u.pm < SEQ / 256;
        const int dl = 16 * wc + 4 * fq;
        bf16_t* obase = O + (size_t)(u.pm * BM + wr * 64 + fr) * ldc + pn * BM + dl;
        if (kind == 0) {
#pragma unroll
            for (int ai = 0; ai < 2; ++ai)
#pragma unroll
                for (int m = 0; m < 4; ++m)
#pragma unroll
                    for (int bj = 0; bj < 2; ++bj) { bf16_t* p = obase + (size_t)(ai * HALF + m * 16) * ldc + bj * HALF; const f32x4 x1 = acc[ai][bj][m][0], x2 = acc[ai][bj][m][1];
                        u32x2 w1, w2; w1.x = cvt_pk_bf16(x1[0], x1[1]); w1.y = cvt_pk_bf16(x1[2], x1[3]); w2.x = cvt_pk_bf16(x2[0], x2[1]); w2.y = cvt_pk_bf16(x2[2], x2[3]);
                        *(u32x2*)p = w1; *(u32x2*)(p + 64) = w2; }
            return;
        }
        LAS float* xr = xch + ((wr * 128 + fr) * 8 + wc);
#pragma unroll
        for (int ai = 0; ai < 2; ++ai)
#pragma unroll
            for (int m = 0; m < 4; ++m)
#pragma unroll
                for (int bj = 0; bj < 2; ++bj) { const f32x4 x1 = acc[ai][bj][m][0], x2 = acc[ai][bj][m][1];
                    float s = (x1[0] * x1[0] + x1[1] * x1[1]) + (x1[2] * x1[2] + x1[3] * x1[3]) + (x2[0] * x2[0] + x2[1] * x2[1]) + (x2[2] * x2[2] + x2[3] * x2[3]);
                    { auto r16 = __builtin_amdgcn_permlane16_swap(__float_as_uint(s), __float_as_uint(s), false, false); s = __uint_as_float(r16[0]) + __uint_as_float(r16[1]); }
                    { auto r32 = __builtin_amdgcn_permlane32_swap(__float_as_uint(s), __float_as_uint(s), false, false); s = __uint_as_float(r32[0]) + __uint_as_float(r32[1]); }
                    if (fq == 0) xr[(ai * 64 + m * 16) * 8 + bj * 4] = s; }
        const f32x4 ga = *(const f32x4*)(gain + dl), gb = *(const f32x4*)(gain + 64 + dl);
        asm volatile("s_waitcnt lgkmcnt(0)" ::: "memory"); __builtin_amdgcn_s_barrier(); asm volatile("" ::: "memory");
        const bool rope = (kind == 2) && latent;
        float cc[2][4], sc[2][4], cd[4], sd[4];
#pragma unroll
        for (int j = 0; j < 4; ++j) { cc[0][j] = 1.f; cc[1][j] = 1.f; sc[0][j] = 0.f; sc[1][j] = 0.f; cd[j] = 1.f; sd[j] = 0.f; }
        if (rope) {
#pragma unroll
            for (int j = 0; j < 4; ++j) {
                const float inv = __builtin_amdgcn_exp2f(-(float)((dl + j) & 31) * (13.287712379549449f / 32.0f)) * 0.15915494309189535f;
                if (wc < 2) {
#pragma unroll
                    for (int ai = 0; ai < 2; ++ai) { float rv = (float)((u.pm * BM + ai * HALF + wr * 64) >> 6) * inv; rv -= floorf(rv); sc[ai][j] = __builtin_amdgcn_sinf(rv); cc[ai][j] = __builtin_amdgcn_cosf(rv); }
                } else {
                    float rv = (float)fr * inv; rv -= floorf(rv); const float s0 = __builtin_amdgcn_sinf(rv), c0 = __builtin_amdgcn_cosf(rv);
                    sc[0][j] = s0; sc[1][j] = s0; cc[0][j] = c0; cc[1][j] = c0;
                    float rd = 16.0f * inv; rd -= floorf(rd); sd[j] = __builtin_amdgcn_sinf(rd); cd[j] = __builtin_amdgcn_cosf(rd);
                }
            }
        }
#pragma unroll
        for (int m = 0; m < 4; ++m) {
#pragma unroll
            for (int ai = 0; ai < 2; ++ai)
#pragma unroll
                for (int bj = 0; bj < 2; ++bj) {
                    const f32x4 pr = *(const LAS f32x4*)(xch + ((wr * 128 + ai * 64 + m * 16 + fr) * 8 + bj * 4));
                    const float rstd = __builtin_amdgcn_rsqf(((pr[0] + pr[1]) + (pr[2] + pr[3])) * (1.0f / 128.0f) + EPS);
                    const f32x4 x1 = acc[ai][bj][m][0] * rstd * ga, x2 = acc[ai][bj][m][1] * rstd * gb;
                    float y1[4], y2[4];
#pragma unroll
                    for (int j = 0; j < 4; ++j) { y1[j] = x1[j] * cc[ai][j] - x2[j] * sc[ai][j]; y2[j] = x1[j] * sc[ai][j] + x2[j] * cc[ai][j]; }
                    bf16_t* p = obase + (size_t)(ai * HALF + m * 16) * ldc + bj * HALF;
                    u32x2 w1, w2; w1.x = cvt_pk_bf16(y1[0], y1[1]); w1.y = cvt_pk_bf16(y1[2], y1[3]); w2.x = cvt_pk_bf16(y2[0], y2[1]); w2.y = cvt_pk_bf16(y2[2], y2[3]);
                    *(u32x2*)p = w1; *(u32x2*)(p + 64) = w2; }
            if (rope && wc >= 2) {
#pragma unroll
                for (int ai = 0; ai < 2; ++ai)
#pragma unroll
                    for (int j = 0; j < 4; ++j) { const float c = cc[ai][j], s = sc[ai][j]; cc[ai][j] = c * cd[j] - s * sd[j]; sc[ai][j] = s * cd[j] + c * sd[j]; }
            }
        }
    }
};

template <class Epi, bool ALIGN_EPI, bool SP2>
__device__ __forceinline__ void gemm_phase(LAS unsigned char* lds, const Gemm g, const Sched& S, const Epi& E) {
    const int tid = TID(), wid = __builtin_amdgcn_readfirstlane(tid >> 6), lane = tid & 63, wr = wid >> 2, wc = wid & 3, fr = lane & 15, fq = lane >> 4;
    const int K = g.K;
    unsigned voffA[2], voffB[2];
#pragma unroll
    for (int i = 0; i < 2; ++i) { int R, C; stage_rc(tid * 16 + i * 8192, R, C); const int Rb = Epi::PERM == 1 ? ((R & ~31) + perm32(R & 31)) : (Epi::PERM == 2 ? ((R & ~127) + permrope(R & 127)) : R);
        voffA[i] = (unsigned)(R * K + C) * 2u; voffB[i] = (unsigned)(Rb * K + C) * 2u; }
    const size_t kstep = (size_t)(BK * 2);
    const size_t hstep = (size_t)HALF * K * 2;
    const size_t tstep = 2 * hstep;
    const unsigned ldsw = (unsigned)wid * 1024u;
    const int aoff = lds_byte(wr * 64 + fr, fq * 8), boff = lds_byte(wc * 32 + fr, fq * 8);
#define PG8_SA(b, h) (((b) * 2 + (h)) * HTB)
#define PG8_SB(b, h) ((4 + (b) * 2 + (h)) * HTB)
#define PG8_STAGE(bufoff, gbase, voff) do { _Pragma("unroll") for (int _i = 0; _i < 2; ++_i) \
        __builtin_amdgcn_global_load_lds((const unsigned*)((const char*)(gbase) + (voff)[_i]), (LAS unsigned*)(lds + (bufoff) + ldsw + _i * 8192), 16, 0, 0); } while (0)
#define PG8_LDA(dst, b, h) do { _Pragma("unroll") for (int m = 0; m < 4; ++m) _Pragma("unroll") for (int k = 0; k < 2; ++k) dst[m][k] = *(const LAS bf16x8*)(lds + PG8_SA(b, h) + aoff + m * 2048 + k * 1024); } while (0)
#define PG8_LDB(dst, b, h) do { _Pragma("unroll") for (int n = 0; n < 2; ++n) _Pragma("unroll") for (int k = 0; k < 2; ++k) dst[n][k] = *(const LAS bf16x8*)(lds + PG8_SB(b, h) + boff + n * 2048 + k * 1024); } while (0)
#define PG8_MMA(ai, bj, At, Bt) do { __builtin_amdgcn_s_setprio(1); _Pragma("unroll") for (int m = 0; m < 4; ++m) _Pragma("unroll") for (int n = 0; n < 2; ++n) _Pragma("unroll") for (int k = 0; k < 2; ++k) \
        acc[ai][bj][m][n] = __builtin_amdgcn_mfma_f32_16x16x32_bf16(Bt[n][k], At[m][k], acc[ai][bj][m][n], 0, 0, 0); __builtin_amdgcn_s_setprio(0); } while (0)
#define PG8_WAIT_V(n) asm volatile("s_waitcnt vmcnt(" #n ")" ::: "memory")
#define PG8_WAIT_L(n) asm volatile("s_waitcnt lgkmcnt(" #n ")" ::: "memory")
#define PG8_BAR __builtin_amdgcn_s_barrier()
#define PG8_SCHED __builtin_amdgcn_sched_barrier(0)
    Unit cur, nxt; int ui = 0;
    if (!S.next(0, cur)) return;
    f32x4 acc[2][2][4][2];
#pragma unroll
    for (int a = 0; a < 2; ++a)
#pragma unroll
        for (int b = 0; b < 2; ++b)
#pragma unroll
            for (int m = 0; m < 4; ++m)
#pragma unroll
                for (int n = 0; n < 2; ++n) acc[a][b][m][n] = (f32x4){0.f, 0.f, 0.f, 0.f};
    bf16x8 At[4][2], B0[2][2], B1[2][2];
    const char* cA = (const char*)g.A + (size_t)cur.pm * tstep + (size_t)cur.k0 * kstep; const char* cB = (const char*)g.Bt + (size_t)cur.pn * tstep + (size_t)cur.k0 * kstep;
    if constexpr (SP2) {
        PG8_STAGE(PG8_SB(0, 0), cB, voffB); PG8_STAGE(PG8_SB(0, 1), cB + hstep, voffB); PG8_STAGE(PG8_SA(0, 0), cA, voffA); PG8_STAGE(PG8_SA(0, 1), cA + hstep, voffA);
        if (wr == 1) PG8_BAR;
        PG8_WAIT_V(2); PG8_BAR;
        PG8_STAGE(PG8_SB(1, 0), cB + kstep, voffB); PG8_STAGE(PG8_SA(1, 0), cA + kstep, voffA); PG8_STAGE(PG8_SB(1, 1), cB + hstep + kstep, voffB);
        PG8_WAIT_V(6); PG8_BAR;
    } else {
        PG8_STAGE(PG8_SB(0, 0), cB, voffB); PG8_STAGE(PG8_SA(0, 0), cA, voffA); PG8_STAGE(PG8_SB(0, 1), cB + hstep, voffB); PG8_STAGE(PG8_SA(0, 1), cA + hstep, voffA);
        if (wr == 1) PG8_BAR;
        PG8_WAIT_V(4); PG8_BAR;
        PG8_STAGE(PG8_SB(1, 0), cB + kstep, voffB); PG8_STAGE(PG8_SA(1, 0), cA + kstep, voffA); PG8_STAGE(PG8_SB(1, 1), cB + hstep + kstep, voffB);
        PG8_WAIT_V(6); PG8_BAR;
    }
    for (;;) {
        const bool has_next = S.next(ui + 1, nxt);
        const int nt = cur.nt;
        const char* nA = has_next ? (const char*)g.A + (size_t)nxt.pm * tstep + (size_t)nxt.k0 * kstep : cA; const char* nB = has_next ? (const char*)g.Bt + (size_t)nxt.pn * tstep + (size_t)nxt.k0 * kstep : cB;
        for (int t = 0; t < nt; t += 2) {
            const bool last = (t == nt - 2);
            const char* a1 = cA + (size_t)(t + 1) * kstep;
            const char* a2 = last ? nA : cA + (size_t)(t + 2) * kstep; const char* b2 = last ? nB : cB + (size_t)(t + 2) * kstep;
            const char* a3 = a2 + kstep; const char* b3 = b2 + kstep;
            if constexpr (SP2) {
            PG8_LDB(B0, 0, 0); PG8_LDB(B1, 0, 1); PG8_SCHED; PG8_LDA(At, 0, 0); PG8_STAGE(PG8_SA(1, 1), a1 + hstep, voffA);
            PG8_WAIT_V(8); PG8_WAIT_L(0); PG8_BAR; PG8_MMA(0, 0, At, B0); PG8_MMA(0, 1, At, B1); PG8_BAR; PG8_SCHED;
            PG8_LDA(At, 0, 1); PG8_STAGE(PG8_SB(0, 0), b2, voffB); PG8_STAGE(PG8_SB(0, 1), b2 + hstep, voffB); PG8_STAGE(PG8_SA(0, 0), a2, voffA);
            PG8_WAIT_V(8); PG8_WAIT_L(0); PG8_BAR; PG8_MMA(1, 0, At, B0); PG8_MMA(1, 1, At, B1); PG8_BAR; PG8_SCHED;
            PG8_LDB(B0, 1, 0); PG8_LDB(B1, 1, 1); PG8_SCHED; PG8_LDA(At, 1, 0); PG8_STAGE(PG8_SA(0, 1), a2 + hstep, voffA);
            PG8_WAIT_V(8); PG8_WAIT_L(0); PG8_BAR; PG8_MMA(0, 0, At, B0); PG8_MMA(0, 1, At, B1); PG8_BAR; PG8_SCHED;
            PG8_LDA(At, 1, 1); PG8_STAGE(PG8_SB(1, 0), b3, voffB); PG8_STAGE(PG8_SB(1, 1), b3 + hstep, voffB); PG8_STAGE(PG8_SA(1, 0), a3, voffA);
            PG8_WAIT_V(8); PG8_WAIT_L(0); PG8_BAR; PG8_MMA(1, 0, At, B0); PG8_MMA(1, 1, At, B1); PG8_BAR; PG8_SCHED;
            } else {
            PG8_LDB(B0, 0, 0); PG8_SCHED; PG8_LDA(At, 0, 0); PG8_STAGE(PG8_SA(1, 1), a1 + hstep, voffA);
            PG8_WAIT_L(8); PG8_BAR; PG8_WAIT_L(0); PG8_MMA(0, 0, At, B0); PG8_BAR; PG8_SCHED;
            PG8_LDB(B1, 0, 1); PG8_STAGE(PG8_SB(0, 0), b2, voffB);
            PG8_BAR; PG8_WAIT_L(0); PG8_MMA(0, 1, At, B1); PG8_BAR;
            PG8_LDA(At, 0, 1); PG8_STAGE(PG8_SA(0, 0), a2, voffA);
            PG8_BAR; PG8_WAIT_L(0); PG8_MMA(1, 0, At, B0); PG8_BAR; PG8_SCHED;
            PG8_STAGE(PG8_SB(0, 1), b2 + hstep, voffB);
            PG8_WAIT_V(6); PG8_BAR; PG8_MMA(1, 1, At, B1); PG8_BAR;
            PG8_LDB(B0, 1, 0); PG8_SCHED; PG8_LDA(At, 1, 0); PG8_STAGE(PG8_SA(0, 1), a2 + hstep, voffA);
            PG8_WAIT_L(8); PG8_BAR; PG8_WAIT_L(0); PG8_MMA(0, 0, At, B0); PG8_BAR; PG8_SCHED;
            PG8_LDB(B1, 1, 1); PG8_STAGE(PG8_SB(1, 0), b3, voffB);
            PG8_BAR; PG8_WAIT_L(0); PG8_MMA(0, 1, At, B1); PG8_BAR;
            PG8_LDA(At, 1, 1); PG8_STAGE(PG8_SA(1, 0), a3, voffA);
            PG8_BAR; PG8_WAIT_L(0); PG8_MMA(1, 0, At, B0); PG8_BAR; PG8_SCHED;
            PG8_STAGE(PG8_SB(1, 1), b3 + hstep, voffB);
            PG8_WAIT_V(6); PG8_BAR; PG8_MMA(1, 1, At, B1); PG8_BAR;
            }
        }
        if constexpr (ALIGN_EPI) { if (wr == 0) PG8_BAR; }
        E(acc, cur, wr, wc, fr, fq);
        if (!has_next) break;
#pragma unroll
        for (int a = 0; a < 2; ++a)
#pragma unroll
            for (int b = 0; b < 2; ++b)
#pragma unroll
                for (int m = 0; m < 4; ++m)
#pragma unroll
                    for (int n = 0; n < 2; ++n) acc[a][b][m][n] = (f32x4){0.f, 0.f, 0.f, 0.f};
        cur = nxt; cA = nA; cB = nB; ++ui;
        if constexpr (ALIGN_EPI) { if (wr == 1) PG8_BAR; }
    }
    PG8_WAIT_V(0);
    if constexpr (!ALIGN_EPI) { if (wr == 0) PG8_BAR; }
    PG8_BAR;
#undef PG8_SA
#undef PG8_SB
#undef PG8_STAGE
#undef PG8_LDA
#undef PG8_LDB
#undef PG8_MMA
#undef PG8_WAIT_V
#undef PG8_WAIT_L
#undef PG8_BAR
#undef PG8_SCHED
}
}

namespace att {
constexpr int D = 128, NW = 8, QBLK = 32, KVBLK = 64;
constexpr float SCALE = 0.088388347648318440f;
constexpr float INV_SCALE = 11.313708498984761f;
constexpr float THR = 8.f;
constexpr float NEG = -1e30f;
constexpr size_t SHM_V = KVBLK * D * 2, SHM_K = KVBLK * D * 2, SHM_ATTN = 2 * SHM_V + 2 * SHM_K + NW * 64 * 4;
constexpr int BIAS_OFF = (int)SHM_ATTN;
enum { DENSE = 0, NA = 1, SW = 2 };
#define KSWZ(row, colB) ((row) * 256 + ((colB) ^ (((row) & 7) << 4)))
#define SBAR() __builtin_amdgcn_sched_barrier(0)
__device__ __forceinline__ int crow(int r, int hi) { return (r & 3) + 8 * (r >> 2) + 4 * hi; }

__device__ __forceinline__ void partialSM(f32x16& p0, f32x16& p1, float& m_reg, float& mn, float& alpha) {
  constexpr float C = SCALE * 1.4426950408889634f;
  float pmax = p0[0];
#pragma unroll
  for (int r = 1; r < 16; ++r) pmax = fmaxf(pmax, p0[r]);
#pragma unroll
  for (int r = 0; r < 16; ++r) pmax = fmaxf(pmax, p1[r]);
  { auto rr = __builtin_amdgcn_permlane32_swap(__float_as_uint(pmax), __float_as_uint(pmax), false, false);
    pmax = fmaxf(__uint_as_float(rr[0]), __uint_as_float(rr[1])); }
  if (__builtin_expect(__all(pmax - m_reg <= THR / SCALE), 1)) { mn = m_reg; alpha = 1.f; }
  else { mn = fmaxf(m_reg, pmax); alpha = __builtin_amdgcn_exp2f((m_reg - mn) * C); m_reg = mn; }
  float mnC = -mn * C;
#pragma unroll
  for (int r = 0; r < 16; ++r) p0[r] = fmaf(p0[r], C, mnC);
#pragma unroll
  for (int r = 0; r < 16; ++r) p1[r] = fmaf(p1[r], C, mnC);
#pragma unroll
  for (int r = 0; r < 16; ++r) p0[r] = __builtin_amdgcn_exp2f(p0[r]);
}
__device__ __forceinline__ void finishSM(f32x16& p0, f32x16& p1, float alpha, float& l_reg, bf16x8& pa0, bf16x8& pa1, bf16x8& pa2, bf16x8& pa3) {
#pragma unroll
  for (int r = 0; r < 16; ++r) p1[r] = __builtin_amdgcn_exp2f(p1[r]);
  float ps = 0;
#pragma unroll
  for (int r = 0; r < 16; ++r) ps += p0[r];
#pragma unroll
  for (int r = 0; r < 16; ++r) ps += p1[r];
  { auto rr = __builtin_amdgcn_permlane32_swap(__float_as_uint(ps), __float_as_uint(ps), false, false);
    ps = __uint_as_float(rr[0]) + __uint_as_float(rr[1]); }
  l_reg = l_reg * alpha + ps;
#define PK4(P, BASE, OUT) do { unsigned a0 = cvt_pk_bf16(P[BASE + 0], P[BASE + 1]), a1 = cvt_pk_bf16(P[BASE + 2], P[BASE + 3]);   \
    unsigned b0 = cvt_pk_bf16(P[BASE + 4], P[BASE + 5]), b1 = cvt_pk_bf16(P[BASE + 6], P[BASE + 7]);                              \
    auto r0 = __builtin_amdgcn_permlane32_swap(a0, b0, false, false); auto r1 = __builtin_amdgcn_permlane32_swap(a1, b1, false, false); \
    u32x4 w = {r0[0], r1[0], r0[1], r1[1]}; OUT = *reinterpret_cast<bf16x8*>(&w); } while (0)
  PK4(p0, 0, pa0); PK4(p0, 8, pa1); PK4(p1, 0, pa2); PK4(p1, 8, pa3);
#undef PK4
}
__device__ __forceinline__ void qkt(f32x16& p0, f32x16& p1, const bf16_t* Ks, const bf16x8* qr, int r32, int hi) {
  p0 = f32x16{}; p1 = f32x16{};
#pragma unroll
  for (int d0 = 0; d0 < 8; ++d0) { int cb = (d0 * 16 + hi * 8) * 2;
    bf16x8 b0 = *reinterpret_cast<const bf16x8*>((const char*)Ks + KSWZ(r32, cb));
    bf16x8 b1 = *reinterpret_cast<const bf16x8*>((const char*)Ks + KSWZ(32 + r32, cb));
    p0 = __builtin_amdgcn_mfma_f32_32x32x16_bf16(b0, qr[d0], p0, 0, 0, 0);
    p1 = __builtin_amdgcn_mfma_f32_32x32x16_bf16(b1, qr[d0], p1, 0, 0, 0); }
}
__device__ __forceinline__ int v_st(int k, int c) { const int kk = (k & ~0xC) | ((k & 4) << 1) | ((k & 8) >> 1); return ((kk >> 3) * 4 + (c >> 5)) * 512 + ((kk & 7) * 32 + (c & 31)) * 2; }
__device__ __forceinline__ int v_rd_base(int lane) { return ((lane & 3) << 3) | (((lane >> 2) & 3) << 6) | (((lane >> 4) & 1) << 5) | (((lane >> 5) & 1) << 8); }
constexpr int v_rd_off(int d0, int ks, int half) { return d0 * 512 + ks * 4096 + half * 2048; }
template <int OFF> __device__ __forceinline__ s16x4 tr_read(int vb) {
  s16x4 r; asm volatile("ds_read_b64_tr_b16 %0, %1 offset:%2" : "=&v"(r) : "v"(vb), "i"(OFF) : "memory"); return r;
}
template <int D0> __device__ __forceinline__ void pv_one(f32x16& od, int vb, bf16x8 pa0, bf16x8 pa1, bf16x8 pa2, bf16x8 pa3) {
  const s16x4 l0 = tr_read<v_rd_off(D0, 0, 0)>(vb), h0 = tr_read<v_rd_off(D0, 0, 1)>(vb), l1 = tr_read<v_rd_off(D0, 1, 0)>(vb), h1 = tr_read<v_rd_off(D0, 1, 1)>(vb);
  const s16x4 l2 = tr_read<v_rd_off(D0, 2, 0)>(vb), h2 = tr_read<v_rd_off(D0, 2, 1)>(vb), l3 = tr_read<v_rd_off(D0, 3, 0)>(vb), h3 = tr_read<v_rd_off(D0, 3, 1)>(vb);
  asm volatile("s_waitcnt lgkmcnt(0)" ::: "memory"); SBAR();
#define PK(L, H) (bf16x8){L[0], L[1], L[2], L[3], H[0], H[1], H[2], H[3]}
  od = __builtin_amdgcn_mfma_f32_32x32x16_bf16(pa0, PK(l0, h0), od, 0, 0, 0);
  od = __builtin_amdgcn_mfma_f32_32x32x16_bf16(pa1, PK(l1, h1), od, 0, 0, 0);
  od = __builtin_amdgcn_mfma_f32_32x32x16_bf16(pa2, PK(l2, h2), od, 0, 0, 0);
  od = __builtin_amdgcn_mfma_f32_32x32x16_bf16(pa3, PK(l3, h3), od, 0, 0, 0);
#undef PK
}
__device__ __forceinline__ void pv_d0(f32x16* o, int vb, bf16x8 pa0, bf16x8 pa1, bf16x8 pa2, bf16x8 pa3) {
  pv_one<0>(o[0], vb, pa0, pa1, pa2, pa3); pv_one<1>(o[1], vb, pa0, pa1, pa2, pa3); pv_one<2>(o[2], vb, pa0, pa1, pa2, pa3); pv_one<3>(o[3], vb, pa0, pa1, pa2, pa3);
}

struct UnitP { const bf16_t* Q; const bf16_t* K; const bf16_t* V; bf16_t* O; int ldq, ldk, ldo, NT, base_row, qb; float sink_l2e; };

template <int MODE> __device__ __forceinline__ int tile_row0(const UnitP& u, int t) {
  if (MODE == DENSE) return u.base_row + KVBLK * t;
  if (t < 4) return SEQ + KVBLK * t;
  if (MODE == NA) { int R0 = 4 * u.qb - 4; R0 = R0 < 0 ? 0 : (R0 > 120 ? 120 : R0); int kr = R0 + t - 4; kr = kr > 127 ? 127 : kr; return kr * 64; }
  int k0 = 256 * u.qb - 128 + 64 * (t - 4); k0 = k0 < 0 ? 0 : (k0 > SEQ - 64 ? SEQ - 64 : k0); return k0;
}
template <int MODE> __device__ __forceinline__ void mask_tile(f32x16& p0, f32x16& p1, const UnitP& u, int t, int wid, int r32, int hi, const float* biasL) {
  if (MODE == DENSE) return;
  if (t < 4) return;
  if (MODE == SW) {
    const int kpos0 = 256 * u.qb - 128 + 64 * (t - 4); int qpos = 256 * u.qb + wid * 32 + r32; int hi_ = hi;
    asm volatile("" : "+v"(qpos), "+v"(hi_));
#pragma unroll
    for (int r = 0; r < 16; ++r) { const int k0 = kpos0 + crow(r, hi_), k1 = k0 + 32; const int d0 = k0 - qpos, d1 = k1 - qpos;
      const bool v0 = (k0 >= 0) && (k0 < SEQ) && (d0 <= 128) && (d0 >= -128); const bool v1 = (k1 >= 0) && (k1 < SEQ) && (d1 <= 128) && (d1 >= -128);
      p0[r] = v0 ? p0[r] : NEG; p1[r] = v1 ? p1[r] : NEG; }
  } else {
    int R0 = 4 * u.qb - 4; R0 = R0 < 0 ? 0 : (R0 > 120 ? 120 : R0); const int kr = R0 + t - 4;
    const int rq = 4 * u.qb + (wid >> 1); int rs = rq - 4; rs = rs < 0 ? 0 : (rs > 120 ? 120 : rs);
    const bool rowvalid = (kr >= rs) && (kr < rs + 8);
    if (!rowvalid) {
#pragma unroll
      for (int r = 0; r < 16; ++r) { p0[r] = NEG; p1[r] = NEG; }
      return; }
    int cq = (wid & 1) * 32 + r32; int hi_ = hi;
    asm volatile("" : "+v"(cq), "+v"(hi_));
    int cs = cq - 8; cs = cs < 0 ? 0 : (cs > 48 ? 48 : cs);
    int brow = kr - rq + 7; brow = brow < 0 ? 0 : (brow > 14 ? 14 : brow);
    const float* bl = biasL + brow * 31 + 15 - cq;
#pragma unroll
    for (int r = 0; r < 16; ++r) { const int k0 = crow(r, hi_), k1 = k0 + 32;
      const bool v0 = rowvalid && (k0 >= cs) && (k0 < cs + 16); const bool v1 = rowvalid && (k1 >= cs) && (k1 < cs + 16);
      int i0 = k0 - cq; i0 = i0 < -15 ? -15 : (i0 > 15 ? 15 : i0); int i1 = k1 - cq; i1 = i1 < -15 ? -15 : (i1 > 15 ? 15 : i1);
      const float b0 = bl[cq + i0], b1 = bl[cq + i1];
      p0[r] = v0 ? p0[r] + b0 : NEG; p1[r] = v1 ? p1[r] + b1 : NEG;
      SBAR(); }
  }
}

template <int MODE, int SDEPTH>
__device__ __forceinline__ void attn_unit(const UnitP& u, char* lds) {
  const int tid = TID(), wid = tid >> 6, lane = tid & 63, r32 = lane & 31, hi = lane >> 5;
  bf16_t* V_lds = (bf16_t*)lds; bf16_t* K_lds = (bf16_t*)(lds + 2 * SHM_V);
  float* ws = (float*)(lds + 2 * SHM_V + 2 * SHM_K) + wid * 64; float* li_l = ws; float* al_l = ws + 32;
  const float* biasL = (const float*)(lds + BIAS_OFF);
  const bf16_t* __restrict__ Kh = u.K; const bf16_t* __restrict__ Vh = u.V; const int LDK = u.ldk;
  float m_reg = -1e30f, l_reg = 0; f32x16 o[4] = {}; bf16x8 qr[8];
  const bf16_t* Qw = u.Q + (long)(wid * QBLK + r32) * u.ldq + hi * 8;
#pragma unroll
  for (int d0 = 0; d0 < 8; ++d0) qr[d0] = *reinterpret_cast<const bf16x8*>(Qw + d0 * 16);
  const int vb0 = (int)(uintptr_t)V_lds + v_rd_base(lane);
  struct { bf16x8 vs0, vs1, ks0, ks1; } sr_[SDEPTH];
#define SLOAD(i, k0) do { int t_ = tid; if (MODE != DENSE) asm volatile("" : "+v"(t_)); const int sr = t_ >> 4, sc = (t_ & 15) * 8; \
    const long _r0 = (long)((k0) + sr) * LDK + sc, _r1 = (long)((k0) + 32 + sr) * LDK + sc; \
    sr_[i].vs0 = *reinterpret_cast<const bf16x8*>(&Vh[_r0]); sr_[i].vs1 = *reinterpret_cast<const bf16x8*>(&Vh[_r1]); \
    sr_[i].ks0 = *reinterpret_cast<const bf16x8*>(&Kh[_r0]); sr_[i].ks1 = *reinterpret_cast<const bf16x8*>(&Kh[_r1]); } while (0)
#define SWRITE(b, i) do { int t_ = tid; if (MODE != DENSE) asm volatile("" : "+v"(t_)); const int sr = t_ >> 4, sc = (t_ & 15) * 8, vst0 = v_st(sr, sc), vst1 = v_st(32 + sr, sc); \
    *(bf16x8*)((char*)V_lds + (b) * SHM_V + vst0) = sr_[i].vs0;          \
    *(bf16x8*)((char*)V_lds + (b) * SHM_V + vst1) = sr_[i].vs1; int kc = sc * 2;               \
    *(bf16x8*)((char*)K_lds + (b) * SHM_K + KSWZ(sr, kc)) = sr_[i].ks0;                       \
    *(bf16x8*)((char*)K_lds + (b) * SHM_K + KSWZ(32 + sr, kc)) = sr_[i].ks1; } while (0)
#define SWAIT() do { if constexpr (SDEPTH == 2) asm volatile("s_waitcnt vmcnt(4)" ::: "memory"); else asm volatile("s_waitcnt vmcnt(0)" ::: "memory"); } while (0)
#define RESC(a) do { if (__any((a) < 1.f)) { if (hi == 0) al_l[r32] = (a); asm volatile("s_waitcnt lgkmcnt(0)" ::: "memory"); \
    _Pragma("unroll") for (int d = 0; d < 4; ++d) _Pragma("unroll") for (int r = 0; r < 16; ++r) o[d][r] *= al_l[crow(r, hi)]; } } while (0)
#define ROW0(t) tile_row0<MODE>(u, (t))
  f32x16 pA0, pA1, pB0, pB1; float mnA, mnB, alA, alB; bf16x8 pa0, pa1, pa2, pa3; const int NT = u.NT;
  constexpr int SE = 0, SO = SDEPTH - 1;
  SLOAD(SE, ROW0(0)); asm volatile("s_waitcnt vmcnt(0)" ::: "memory"); SWRITE(0, SE); __syncthreads();
  qkt(pA0, pA1, K_lds, qr, r32, hi); mask_tile<MODE>(pA0, pA1, u, 0, wid, r32, hi, biasL); partialSM(pA0, pA1, m_reg, mnA, alA);
  SLOAD(SO, ROW0(1)); if constexpr (SDEPTH == 2) { if (2 < NT) SLOAD(SE, ROW0(2)); }
  SWAIT(); SWRITE(1, SO); __syncthreads();
  for (int j = 1; j + 1 < NT; j += 2) {
    SBAR(); qkt(pB0, pB1, (bf16_t*)((char*)K_lds + SHM_K), qr, r32, hi);
    finishSM(pA0, pA1, alA, l_reg, pa0, pa1, pa2, pa3); SBAR();
    SLOAD(SO, ROW0(j + SDEPTH)); SBAR();
    pv_d0(o, vb0, pa0, pa1, pa2, pa3); mask_tile<MODE>(pB0, pB1, u, j, wid, r32, hi, biasL); partialSM(pB0, pB1, m_reg, mnB, alB);
    __syncthreads(); SWAIT(); SWRITE(0, SE);
    RESC(alB); __syncthreads();
    SBAR(); qkt(pA0, pA1, K_lds, qr, r32, hi);
    finishSM(pB0, pB1, alB, l_reg, pa0, pa1, pa2, pa3); SBAR();
    if (SDEPTH == 1 || j + 3 < NT) SLOAD(SE, ROW0(j + 1 + SDEPTH)); SBAR();
    pv_d0(o, vb0 + (int)SHM_V, pa0, pa1, pa2, pa3); mask_tile<MODE>(pA0, pA1, u, j + 1, wid, r32, hi, biasL); partialSM(pA0, pA1, m_reg, mnA, alA);
    __syncthreads(); SWAIT(); SWRITE(1, SO);
    RESC(alA); __syncthreads();
  }
  SBAR(); qkt(pB0, pB1, (bf16_t*)((char*)K_lds + SHM_K), qr, r32, hi);
  finishSM(pA0, pA1, alA, l_reg, pa0, pa1, pa2, pa3); SBAR();
  pv_d0(o, vb0, pa0, pa1, pa2, pa3); mask_tile<MODE>(pB0, pB1, u, NT - 1, wid, r32, hi, biasL); partialSM(pB0, pB1, m_reg, mnB, alB);
  __syncthreads(); RESC(alB);
  finishSM(pB0, pB1, alB, l_reg, pa0, pa1, pa2, pa3); SBAR();
  pv_d0(o, vb0 + (int)SHM_V, pa0, pa1, pa2, pa3);
  l_reg += __builtin_amdgcn_exp2f(u.sink_l2e - m_reg * (SCALE * 1.4426950408889634f));
  if (hi == 0) li_l[r32] = l_reg; asm volatile("s_waitcnt lgkmcnt(0)" ::: "memory");
  float rli[16];
#pragma unroll
  for (int r = 0; r < 16; ++r) rli[r] = __builtin_amdgcn_rcpf(li_l[crow(r, hi)]);
  bf16_t* Ow = u.O + (long)(wid * QBLK) * u.ldo;
#pragma unroll
  for (int r = 0; r < 16; ++r) { int orow = crow(r, hi);
#pragma unroll
    for (int d0 = 0; d0 < 4; ++d0) { const float v = o[d0][r] * rli[r]; Ow[(long)orow * u.ldo + d0 * 32 + r32] = (bf16_t)(cvt_pk_bf16(v, v) & 0xffffu); } }
  __syncthreads();
#undef SLOAD
#undef SWRITE
#undef SWAIT
#undef RESC
#undef ROW0
}
#undef KSWZ
#undef SBAR
}

struct Args { const float* in[22]; float* out; unsigned char* ws; int ph_lo, ph_hi; };
#define CAS __attribute__((address_space(4)))
__device__ __forceinline__ const float* INP(int i) { const CAS char* k = (const CAS char*)__builtin_amdgcn_kernarg_segment_ptr(); asm volatile("" : "+s"(k)); return *(const float* const CAS*)(k + 8 * i); }
__device__ __forceinline__ float* OUTP() { const CAS char* k = (const CAS char*)__builtin_amdgcn_kernarg_segment_ptr(); asm volatile("" : "+s"(k)); return *(float* const CAS*)(k + 8 * 22); }
__device__ __forceinline__ unsigned char* WSP() { const CAS char* k = (const CAS char*)__builtin_amdgcn_kernarg_segment_ptr(); asm volatile("" : "+s"(k)); return *(unsigned char* const CAS*)(k + 8 * 23); }
enum { I_X = 0, I_C, I_CTX, I_CCTX, I_ADAW, I_ADAB, I_NORMG, I_WG, I_WU, I_WD, I_ABIN, I_ABOUT, I_NAQG, I_NAKG, I_NABIAS, I_SWQG, I_SWKG, I_SINK, I_GIN, I_GOUT, I_GQG, I_GKG };

__device__ __forceinline__ unsigned f2bf(float f) { unsigned u = __builtin_bit_cast(unsigned, f); return (u + 0x7fffu + ((u >> 16) & 1u)) >> 16; }
__device__ __forceinline__ unsigned pk2(float lo, float hi) { return f2bf(lo) | (f2bf(hi) << 16); }
__device__ __forceinline__ void transpose_item(const float* __restrict__ W, int K, int N, bf16_t* WT, int mode, LAS float* scr, int item, int lane) {
    const int nblk = N / 32, kb = item / nblk, nb = item % nblk, k0 = 64 * kb, n0 = 32 * nb;
#pragma unroll 8
    for (int i = 0; i < 32; ++i) { const int kk = 2 * i + (lane >> 5); scr[kk * 33 + (lane & 31)] = W[(size_t)(k0 + kk) * N + n0 + (lane & 31)]; }
    asm volatile("s_waitcnt lgkmcnt(0)" ::: "memory");
    const int c = lane & 7;
    const int rbase = (mode == 0) ? n0 : ((n0 >> 7) * 256 + (n0 & 127) + (mode == 2 ? 128 : 0));
#pragma unroll
    for (int j = 0; j < 4; ++j) { const int n = (lane >> 3) + 8 * j; const LAS float* s = scr + (8 * c) * 33 + n;
        u32x4 o; o.x = pk2(s[0 * 33], s[1 * 33]); o.y = pk2(s[2 * 33], s[3 * 33]); o.z = pk2(s[4 * 33], s[5 * 33]); o.w = pk2(s[6 * 33], s[7 * 33]);
        *(u32x4*)(WT + (size_t)(rbase + n) * K + k0 + 8 * c) = o; }
    asm volatile("s_waitcnt lgkmcnt(0)" ::: "memory");
}
__device__ __forceinline__ void phase0(const Args& a, unsigned char* lds_g, int G) {
    const int tid = TID(), lane = tid & 63, wave = tid >> 6; const int bid = BID();
    float* sc = (float*)lds_g;
    float* red = sc + 4096;
    for (int i = tid; i < DM; i += 512) { const float c = INP(I_C)[i]; sc[i] = c / (1.0f + __expf(-c)); const float cc = INP(I_CCTX)[i]; sc[DM + i] = cc / (1.0f + __expf(-cc)); }
    __syncthreads();
    float* mod = (float*)(WSP() + WS_MOD);
    for (int unit = bid; unit < 256; unit += G) {
        const int layer = unit >> 7, col0 = (unit & 127) * 144;
        f32x4 a1 = {0.f, 0.f, 0.f, 0.f}, a2 = {0.f, 0.f, 0.f, 0.f};
        if (lane < 36) {
            const float* W = INP(I_ADAW) + (size_t)layer * DM * NMODV + col0 + 4 * lane;
            for (int k = wave * 256; k < wave * 256 + 256; k += 8) {
                f32x4 w[8];
#pragma unroll
                for (int q = 0; q < 8; ++q) w[q] = __builtin_nontemporal_load((const f32x4*)(W + (size_t)(k + q) * NMODV));
#pragma unroll
                for (int q = 0; q < 8; ++q) { a1 += w[q] * sc[k + q]; a2 += w[q] * sc[DM + k + q]; }
            }
#pragma unroll
            for (int e = 0; e < 4; ++e) { red[(wave * 2 + 0) * 144 + 4 * lane + e] = a1[e]; red[(wave * 2 + 1) * 144 + 4 * lane + e] = a2[e]; }
        }
        __syncthreads();
        if (tid < 288) { const int v = tid / 144, j = tid % 144; float s = INP(I_ADAB)[layer * NMODV + col0 + j];
#pragma unroll
            for (int w = 0; w < 8; ++w) s += red[(w * 2 + v) * 144 + j];
            mod[(size_t)(layer * 2 + v) * NMODV + col0 + j] = s; }
        __syncthreads();
    }
    LAS float* scr = (LAS float*)((LAS unsigned char*)lds_g + wave * 16384);
    const int gw = bid * 8 + wave, NGW = G * 8;
    constexpr int I_GU1 = (DM / 64) * (FF / 32);
    constexpr int I_D1 = (FF / 64) * (DM / 32);
    constexpr int I_GU = 8 * I_GU1, I_D = 4 * I_D1, I_ABI = (DM / 64) * (AB_IN / 32), I_SQ = (DM / 64) * (DM / 32), I_GI = (DM / 64) * (C_IN / 32);
    constexpr int NITEMS = I_GU + I_D + I_ABI + I_SQ + I_GI + I_SQ;
    bf16_t* wgu = (bf16_t*)(WSP() + WS_WGU); bf16_t* wd = (bf16_t*)(WSP() + WS_WD);
    for (int it = gw; it < NITEMS; it += NGW) {
        int r = it;
        if (r < I_GU) { const int q = r / I_GU1, lf = q >> 1, gu = q & 1; r -= q * I_GU1;
            transpose_item((gu ? INP(I_WU) : INP(I_WG)) + (size_t)lf * DM * FF, DM, FF, wgu + (size_t)lf * WGU_ELEMS, 1 + gu, scr, r, lane); continue; }
        r -= I_GU;
        if (r < I_D) { const int lf = r / I_D1; r -= lf * I_D1; transpose_item(INP(I_WD) + (size_t)lf * FF * DM, FF, DM, wd + (size_t)lf * WD_ELEMS, 0, scr, r, lane); continue; }
        r -= I_D;
        if (r < I_ABI) { transpose_item(INP(I_ABIN), DM, AB_IN, (bf16_t*)(WSP() + WS_WABIN), 0, scr, r, lane); continue; }
        r -= I_ABI;
        if (r < I_SQ) { transpose_item(INP(I_ABOUT), DM, DM, (bf16_t*)(WSP() + WS_WABOUT), 0, scr, r, lane); continue; }
        r -= I_SQ;
        if (r < I_GI) { transpose_item(INP(I_GIN), DM, C_IN, (bf16_t*)(WSP() + WS_WGIN), 0, scr, r, lane); continue; }
        r -= I_GI;
        transpose_item(INP(I_GOUT), DM, DM, (bf16_t*)(WSP() + WS_WGOUT), 0, scr, r, lane);
    }
}

__device__ __forceinline__ void modulate_phase(const float* xsrc, const float* csrc, float* cdst, const float* part, int nsplit, const float* cgate, float ccoef,
                                               const float* g, const float* shift_l, const float* scale_l, const float* shift_c, const float* scale_c, bf16_t* h, int nrows, int G, unsigned char* lds_g) {
    const int tid = TID(), lane = tid & 63, wave = tid >> 6;
    const int bid = BID();
    if (nrows > SEQ) {
        float* red = (float*)lds_g;
        float* ssl = red + 8 * DM;
        for (int r = bid; r < CTXL; r += G) {
            f32x4 s[8];
#pragma unroll
            for (int j = 0; j < 8; ++j) s[j] = (f32x4){0.f, 0.f, 0.f, 0.f};
            for (int sp = wave; sp < nsplit; sp += 8) { const f32x4* pr = (const f32x4*)(part + ((size_t)sp * 256 + r) * DM) + lane;
#pragma unroll
                for (int j = 0; j < 8; ++j) s[j] += pr[64 * j]; }
#pragma unroll
            for (int j = 0; j < 8; ++j) *((f32x4*)(red + wave * DM) + lane + 64 * j) = s[j];
            __syncthreads();
            const int col = wave * 256 + 4 * lane;
            f32x4 t = *(const f32x4*)(red + col);
#pragma unroll
            for (int w = 1; w < 8; ++w) t += *(const f32x4*)(red + w * DM + col);
            f32x4 v = *(const f32x4*)(csrc + (size_t)r * DM + col);
            if (nsplit > 0) v += ccoef * (*(const f32x4*)(cgate + col)) * t;
            *(f32x4*)(cdst + (size_t)r * DM + col) = v;
            const float ssw = wave_sum((v.x * v.x + v.y * v.y) + (v.z * v.z + v.w * v.w));
            if (lane == 0) ssl[wave] = ssw;
            __syncthreads();
            float ss = 0.f;
#pragma unroll
            for (int w = 0; w < 8; ++w) ss += ssl[w];
            const float rstd = 1.0f / sqrtf(ss * (1.0f / DM) + EPS);
            const f32x4 y = (v * rstd) * (*(const f32x4*)(g + col)); const f32x4 z = y * (*(const f32x4*)(scale_c + col) + 1.0f) + *(const f32x4*)(shift_c + col);
            u32x2 w2; w2.x = cvt_pk_bf16(z.x, z.y); w2.y = cvt_pk_bf16(z.z, z.w); *(u32x2*)(h + (size_t)(SEQ + r) * DM + col) = w2;
            __syncthreads();
        }
    }
    const int gw = bid * 8 + wave, NGW = G * 8;
    for (int row = gw; row < SEQ; row += NGW) {
        f32x4 v[8];
        const f32x4* xr = (const f32x4*)(xsrc + (size_t)row * DM) + lane;
#pragma unroll
        for (int j = 0; j < 8; ++j) v[j] = xr[64 * j];
        float ss = 0.f;
#pragma unroll
        for (int j = 0; j < 8; ++j) ss += (v[j].x * v[j].x + v[j].y * v[j].y) + (v[j].z * v[j].z + v[j].w * v[j].w);
        const float rstd = 1.0f / sqrtf(wave_sum(ss) * (1.0f / DM) + EPS);
        const f32x4* sh = (const f32x4*)shift_l + lane; const f32x4* scl = (const f32x4*)scale_l + lane;
        const f32x4* gg = (const f32x4*)g + lane;
        u32x2* ho = (u32x2*)(h + (size_t)row * DM) + lane;
#pragma unroll
        for (int j = 0; j < 8; ++j) { const f32x4 y = (v[j] * rstd) * gg[64 * j]; const f32x4 z = y * (scl[64 * j] + 1.0f) + sh[64 * j];
            u32x2 w; w.x = cvt_pk_bf16(z.x, z.y); w.y = cvt_pk_bf16(z.z, z.w); ho[64 * j] = w; }
    }
}

__device__ __forceinline__ void attn_phase0(const Args& a, unsigned char* lds_g, int G) {
    bf16_t* P = (bf16_t*)(WSP() + WS_P); bf16_t* O = (bf16_t*)(WSP() + WS_O);
    float* biasL = (float*)(lds_g + att::BIAS_OFF);
    const int tid0 = TID();
    for (int un = BID(); un < 528; un += G) {
        att::UnitP u; u.ldq = AB_IN; u.ldk = AB_IN; u.ldo = DM; u.sink_l2e = -INFINITY;
        if (un < 256) {
            const int h = un & 7, qb = un >> 3;
            for (int i = tid0; i < 465; i += 512) biasL[i] = INP(I_NABIAS)[h * 465 + i] * att::INV_SCALE;
            __syncthreads();
            u.Q = P + (size_t)(256 * qb) * AB_IN + h * 128; u.K = P + (16 + h) * 128; u.V = P + (24 + h) * 128; u.O = O + (size_t)(256 * qb) * DM + h * 128;
            u.NT = 16; u.base_row = 0; u.qb = qb;
            att::attn_unit<att::NA, 1>(u, (char*)lds_g);
        } else if (un < 512) {
            const int hq = (un - 256) & 7, qb = (un - 256) >> 3, kvh = hq >> 2;
            u.Q = P + (size_t)(256 * qb) * AB_IN + (8 + hq) * 128; u.K = P + (32 + kvh) * 128; u.V = P + (34 + kvh) * 128; u.O = O + (size_t)(256 * qb) * DM + (8 + hq) * 128;
            u.NT = 12; u.base_row = 0; u.qb = qb; u.sink_l2e = INP(I_SINK)[hq] * 1.4426950408889634f;
            att::attn_unit<att::SW, 1>(u, (char*)lds_g);
        } else {
            const int hh = un - 512;
            u.Q = P + (size_t)SEQ * AB_IN + hh * 128; u.O = O + (size_t)SEQ * DM + hh * 128;
            const bool nah = hh < 8; const int hq = nah ? 0 : hh - 8, kvh = hq >> 2;
            const int kslot = nah ? 16 + hh : 32 + kvh, vslot = nah ? 24 + hh : 34 + kvh;
            u.K = P + kslot * 128; u.V = P + vslot * 128;
            const float sk = INP(I_SINK)[hq] * 1.4426950408889634f; u.sink_l2e = nah ? -INFINITY : sk;
            u.NT = 4; u.base_row = SEQ; u.qb = 0;
            att::attn_unit<att::DENSE, 2>(u, (char*)lds_g);
        }
    }
}
__device__ __forceinline__ void attn_phase1(const Args& a, unsigned char* lds_g, int G) {
    bf16_t* P = (bf16_t*)(WSP() + WS_P); bf16_t* O = (bf16_t*)(WSP() + WS_O);
    const int bid = BID();
    for (int i = 0;; ++i) {
        int un;
        if ((G & 7) == 0) { const int x = bid & 7, j = (bid >> 3) + i * (G >> 3); if (j >= 64) break; un = x * 64 + j; }
        else { un = bid + i * G; if (un >= 512) break; }
        const int h = un >> 5, qb = un & 31, kvh = h >> 2;
        att::UnitP u; u.ldq = C_IN; u.ldk = C_IN; u.ldo = DM; u.sink_l2e = -INFINITY;
        u.Q = P + (size_t)(256 * qb) * C_IN + h * 128; u.K = P + (16 + kvh) * 128; u.V = P + (20 + kvh) * 128; u.O = O + (size_t)(256 * qb) * DM + h * 128;
        u.NT = MT / 64; u.base_row = 0; u.qb = qb;
        att::attn_unit<att::DENSE, 2>(u, (char*)lds_g);
    }
}

#define XB_TMO      128
#define XB_XCNT(j)  (256  + 64 * (j))
#define XB_XSUB(j)  (1280 + 64 * (j))
#define XB_XGEN(j)  (2304 + 64 * (j))
#define XB_TOP      3328
#define XB_TOPGEN   3392
#define XCD_BAR_WORDS 3456
#define XB_SPIN_CAP (1u << 18)
__device__ __forceinline__ unsigned xb_ld(unsigned* p)              { return __hip_atomic_load(p, __ATOMIC_RELAXED, __HIP_MEMORY_SCOPE_AGENT); }
__device__ __forceinline__ unsigned xb_add(unsigned* p, unsigned v) { return __hip_atomic_fetch_add(p, v, __ATOMIC_RELAXED, __HIP_MEMORY_SCOPE_AGENT); }
__device__ __forceinline__ unsigned xb_xcc_id() { return (unsigned)__builtin_amdgcn_s_getreg((3 << 11) | 20) & 0xFu; }
#define XB_SPIN(cond, bar) do { unsigned _sp = 0; while (cond) { __builtin_amdgcn_s_sleep(1); \
    if ((++_sp & 255u) == 0u) { if (xb_ld(&(bar)[XB_TMO])) break; if (_sp > XB_SPIN_CAP) { atomicAdd(&(bar)[XB_TMO], 1u); break; } } } } while (0)
struct XcdBarrier { unsigned* bar; unsigned x; volatile LAS unsigned* st; };
__device__ __forceinline__ XcdBarrier xcd_barrier_post(unsigned* bar, volatile LAS unsigned* st) {
    XcdBarrier b; b.bar = bar; b.x = xb_xcc_id(); b.st = st;
    if (threadIdx.x == 0) (void)xb_add(&bar[XB_XCNT(b.x)], 1u);
    return b;
}
__device__ __forceinline__ void xcd_barrier_complete(unsigned* bar, unsigned x, unsigned& nloc, unsigned& nx) {
    const unsigned G = gridDim.x * gridDim.y * gridDim.z;
    unsigned sum, cnt, mine, sp = 0u;
    for (;;) {
        sum = 0u; cnt = 0u; mine = 0u;
#pragma unroll
        for (unsigned j = 0; j < 16; ++j) { const unsigned c = xb_ld(&bar[XB_XCNT(j)]); sum += c; cnt += (c > 0u) ? 1u : 0u; mine = (j == x) ? c : mine; }
        if (sum == G) break;
        __builtin_amdgcn_s_sleep(1);
        if ((++sp & 255u) == 0u) { if (xb_ld(&bar[XB_TMO])) break; if (sp > XB_SPIN_CAP) { atomicAdd(&bar[XB_TMO], 1u); break; } }
    }
    nloc = mine > 0u ? mine : 1u; nx = cnt > 0u ? cnt : 1u;
}
__device__ __forceinline__ void xcd_barrier(const XcdBarrier& b) {
    asm volatile("s_waitcnt vmcnt(0)" ::: "memory");
    __syncthreads();
    if (threadIdx.x == 0) {
        unsigned* bar = b.bar;
        __builtin_amdgcn_s_waitcnt(0);
        unsigned nloc = b.st[0], nx = b.st[1];
        if (nloc == 0u) { xcd_barrier_complete(bar, b.x, nloc, nx); b.st[0] = nloc; b.st[1] = nx; }
        const unsigned old = xb_add(&bar[XB_XSUB(b.x)], 1u);
        const unsigned gen = old / nloc;
        if (old + 1u == (gen + 1u) * nloc) {
            __builtin_amdgcn_fence(__ATOMIC_RELEASE, "agent");
            asm volatile("s_waitcnt vmcnt(0)" ::: "memory");
            const unsigned og = xb_add(&bar[XB_TOP], 1u);
            const unsigned tg = og / nx;
            if (og + 1u == (tg + 1u) * nx) xb_add(&bar[XB_TOPGEN], 1u);
            else XB_SPIN(xb_ld(&bar[XB_TOPGEN]) == tg, bar);
            __builtin_amdgcn_fence(__ATOMIC_ACQUIRE, "agent");
            xb_add(&bar[XB_XGEN(b.x)], 1u);
            asm volatile("s_waitcnt vmcnt(0)" ::: "memory");
        } else {
            XB_SPIN(xb_ld(&bar[XB_XGEN(b.x)]) == gen, bar);
            __builtin_amdgcn_fence(__ATOMIC_ACQUIRE, "agent");
            asm volatile("s_waitcnt vmcnt(0)" ::: "memory");
        }
    }
    __syncthreads();
}

__global__ void __launch_bounds__(512, 2) mk_fwd(Args a) {
    extern __shared__ __attribute__((aligned(16))) unsigned char lds[];
    cg::grid_group grid = cg::this_grid();
    const int G = gridDim.x;
    LAS unsigned char* lds3 = (LAS unsigned char*)lds;
    volatile LAS unsigned* misc = (volatile LAS unsigned*)(lds3 + MISC_OFF);
    if (threadIdx.x < 2) misc[threadIdx.x] = 0u;
    __syncthreads();
    XcdBarrier bar = xcd_barrier_post((unsigned*)(WSP() + WS_BAR), misc);
    float* mod = (float*)(WSP() + WS_MOD);
    float* xc = (float*)(WSP() + WS_XC); float* part = (float*)(WSP() + WS_PART);
    bf16_t* H = (bf16_t*)(WSP() + WS_H); bf16_t* O = (bf16_t*)(WSP() + WS_O); bf16_t* P = (bf16_t*)(WSP() + WS_P); bf16_t* A = (bf16_t*)(WSP() + WS_A);
    for (int ph = a.ph_lo; ph < a.ph_hi; ++ph) {
        if (ph == 0) { phase0(a, lds, G); if (REPMASK & 1) { __syncthreads(); phase0(a, lds, G); } }
        else {
            const int layer = (ph - 1) / 10, sub = (ph - 1) % 10;
            const float* mL = mod + (size_t)(layer * 2 + 0) * NMODV; const float* mC = mod + (size_t)(layer * 2 + 1) * NMODV;
            const bool with_ctx = layer == 0;
            if (sub == 0 || sub == 3 || sub == 7) {
                const int k = sub == 0 ? 0 : (sub == 3 ? 1 : 2);
                const bool first = (ph == 1);
                const float* xsrc = (ph <= 3) ? INP(I_X) : OUTP();
                const float* csrc = first ? INP(I_CTX) : xc;
                const bool upd_prev = (sub == 0 && layer == 1);
                const int nsplit = (upd_prev || sub == 3) ? NSPLIT_DOWN : ((sub == 7) ? NSPLIT_OUT : 0);
                const float* cgate = upd_prev ? (mod + (size_t)(0 * 2 + 1) * NMODV + 8 * DM) : (sub == 3 ? mC + 2 * DM : mC + 5 * DM);
                const float ccoef = (sub == 7) ? 1.0f : 0.5f;
                const int nrows = (sub == 7 && !with_ctx) ? SEQ : MT;
                modulate_phase(xsrc, csrc, xc, part, nsplit, cgate, ccoef, INP(I_NORMG) + (size_t)(layer * 3 + k) * DM,
                               mL + (3 * k) * DM, mL + (3 * k + 1) * DM, mC + (3 * k) * DM, mC + (3 * k + 1) * DM, H, nrows, G, lds);
            } else if (sub == 1 || sub == 8) {
                const int f = sub == 1 ? 0 : 1; const int nM = (f == 1 && !with_ctx) ? SEQ / 256 : MT / 256;
                pg8::Gemm g{H, (const bf16_t*)(WSP() + WS_WGU) + (size_t)(layer * 2 + f) * WGU_ELEMS, DM};
                pg8::Sched S; S.init(nM, 2 * FF / 256, DM, G, BID(), 0, 0, 0);
                pg8::EpiSwiGLU E{A, FF};
                pg8::gemm_phase<pg8::EpiSwiGLU, true, true>(lds3, g, S, E);
                if (REPMASK & 2) pg8::gemm_phase<pg8::EpiSwiGLU, true, true>(lds3, g, S, E);
            } else if (sub == 2 || sub == 9) {
                const int f = sub == 2 ? 0 : 1; const bool ctxrows = !(f == 1 && !with_ctx);
                pg8::Gemm g{A, (const bf16_t*)(WSP() + WS_WD) + (size_t)(layer * 2 + f) * WD_ELEMS, FF};
                pg8::Sched S; S.init(SEQ / 256, DM / 256, FF, G, BID(), ctxrows ? NSPLIT_DOWN : 0, NT_SPLIT_DOWN, SEQ / 256);
                pg8::EpiResid E{(ph == 3) ? INP(I_X) : (const float*)OUTP(), OUTP(), mL + (f == 0 ? 2 : 8) * DM, 0.5f, part};
                pg8::gemm_phase<pg8::EpiResid, true, true>(lds3, g, S, E);
                if (REPMASK & 256) { pg8::EpiResid E2{(const float*)P, (float*)P, mL + (f == 0 ? 2 : 8) * DM, 0.5f, part}; pg8::gemm_phase<pg8::EpiResid, true, true>(lds3, g, S, E2); }
            } else if (sub == 4) {
                const int N = layer == 0 ? AB_IN : C_IN;
                pg8::Gemm g{H, (const bf16_t*)(WSP() + (layer == 0 ? WS_WABIN : WS_WGIN)), DM};
                pg8::Sched S; S.init(MT / 256, N / 256, DM, G, BID(), 0, 0, 0);
                pg8::EpiQK E{P, N, layer, layer == 0 ? INP(I_NAQG) : INP(I_GQG), layer == 0 ? INP(I_SWQG) : INP(I_GKG), INP(I_NAKG), INP(I_SWKG), (LAS float*)(lds3 + XCH_OFF)};
                pg8::gemm_phase<pg8::EpiQK, true, true>(lds3, g, S, E);
                if (REPMASK & 16) pg8::gemm_phase<pg8::EpiQK, true, true>(lds3, g, S, E);
            }
            else if (sub == 5) { if (layer == 0) { attn_phase0(a, lds, G); if (REPMASK & 32) attn_phase0(a, lds, G); } else { attn_phase1(a, lds, G); if (REPMASK & 4) attn_phase1(a, lds, G); } }
            else if (sub == 6) {
                pg8::Gemm g{O, (const bf16_t*)(WSP() + (layer == 0 ? WS_WABOUT : WS_WGOUT)), DM};
                pg8::Sched S; S.init(SEQ / 256, DM / 256, DM, G, BID(), with_ctx ? NSPLIT_OUT : 0, NT_SPLIT_OUT, SEQ / 256);
                pg8::EpiResid E{OUTP(), OUTP(), mL + 5 * DM, 1.0f, part};
                pg8::gemm_phase<pg8::EpiResid, true, true>(lds3, g, S, E);
                if (REPMASK & 512) { pg8::EpiResid E2{(const float*)A, (float*)A, mL + 5 * DM, 1.0f, part}; pg8::gemm_phase<pg8::EpiResid, true, true>(lds3, g, S, E2); }
            }
        }
        if (ph + 1 < a.ph_hi) {
            if (a.ph_lo < 0) grid.sync(); else xcd_barrier(bar);
            if (REPMASK & 8) xcd_barrier(bar); }
    }
}

extern "C" void kernel_launch(void* const* d_in, const int* in_sizes, int n_in, void* d_out, int out_size, void* d_ws, size_t ws_size, hipStream_t stream) {
    static int grid = 0;
    if (grid == 0) {
        if (n_in != 22 || out_size != SEQ * DM || ws_size < WS_END) { fprintf(stderr, "kernel_launch: unexpected shapes (n_in %d out %d ws %zu)\n", n_in, out_size, ws_size); grid = -1; return; }
        int dev = 0, cus = 0, per_cu = 0;
        hipGetDevice(&dev); hipDeviceGetAttribute(&cus, hipDeviceAttributeMultiprocessorCount, dev);
        if (hipFuncSetAttribute((const void*)mk_fwd, hipFuncAttributeMaxDynamicSharedMemorySize, LDS_BYTES) != hipSuccess) { fprintf(stderr, "kernel_launch: hipFuncSetAttribute failed\n"); grid = -1; return; }
        if (hipOccupancyMaxActiveBlocksPerMultiprocessor(&per_cu, (const void*)mk_fwd, 512, LDS_BYTES) != hipSuccess || per_cu < 1) { fprintf(stderr, "kernel_launch: occupancy query gave %d\n", per_cu); per_cu = 1; }
        (void)hipGetLastError();
        grid = cus * per_cu;
        if (grid > 256) grid = 256;
    }
    if (grid < 0) return;
    if (hipMemsetAsync((char*)d_ws + WS_BAR, 0, BAR_BYTES, stream) != hipSuccess) { fprintf(stderr, "kernel_launch: memset failed\n"); return; }
    Args a{};
    for (int i = 0; i < 22; ++i) a.in[i] = (const float*)d_in[i];
    a.out = (float*)d_out; a.ws = (unsigned char*)d_ws;
#if MK_MULTI
    for (int p = 0; p < NPHASE; ++p) { a.ph_lo = p; a.ph_hi = p + 1; hipLaunchKernelGGL(mk_fwd, dim3(grid), dim3(512), LDS_BYTES, stream, a); }
#else
    a.ph_lo = 0; a.ph_hi = NPHASE;
    void* args[] = {&a};
    hipError_t e = hipLaunchCooperativeKernel((const void*)mk_fwd, dim3(grid), dim3(512), args, LDS_BYTES, stream);
    if (e != hipSuccess) fprintf(stderr, "cooperative launch failed: %s (grid %d)\n", hipGetErrorString(e), grid);
#endif
}
```

```cpp
#include <hip/hip_runtime.h>
#include <hip/hip_cooperative_groups.h>
#include <cstdio>
#include <cstdint>
namespace cg = cooperative_groups;

#ifndef REPMASK
#define REPMASK 0
#endif
#ifndef MK_MULTI
#define MK_MULTI 0
#endif

constexpr int SEQ = 8192, CTXL = 256, MT = SEQ + CTXL, DM = 2048, FF = 5632, NMODV = 9 * DM;
constexpr int AB_IN = 4608, C_IN = 3072, GRIDW = 64;
constexpr float EPS = 1e-6f;
constexpr int NPHASE = 21;
constexpr int SIDE_Q = 8, SIDE_E0 = 84 * 8 * SIDE_Q, SIDE_E1 = SIDE_E0 + 174 * 8 * SIDE_Q, SIDE_E2 = SIDE_E1 + 84 * 8 * SIDE_Q, SIDE_E3 = SIDE_E2 + 84 * 8 * SIDE_Q, SIDE_E4 = SIDE_E3 + 116 * 8 * SIDE_Q;
constexpr int SIDE_END = SIDE_E4 < 38912 ? SIDE_E4 : 38912;
static_assert(SIDE_E2 >= 3 * 5632 && SIDE_E3 >= 3 * 5632 + 3072 + 2048, "FFN(1,0) must be converted by phase 9, gqa_in / gqa_out by phase 12");
constexpr int NSPLIT_DOWN = 22, NT_SPLIT_DOWN = 4;
constexpr int NSPLIT_OUT = 16, NT_SPLIT_OUT = 2;

constexpr size_t MiB = 1u << 20;
constexpr size_t WS_MOD = 0;
constexpr size_t WS_BAR = 512 * 1024, BAR_BYTES = 16384;
constexpr size_t WS_XC = 1 * MiB;
constexpr size_t WS_PART = 4 * MiB;
constexpr size_t WS_H = 52 * MiB;
constexpr size_t WS_O = 88 * MiB;
constexpr size_t WS_P = 124 * MiB;
constexpr size_t WS_A = 200 * MiB;
constexpr size_t WS_WGU = 292 * MiB;
constexpr size_t WS_WD = 468 * MiB;
constexpr size_t WS_WABIN = 556 * MiB;
constexpr size_t WS_WABOUT = 574 * MiB;
constexpr size_t WS_WGIN = 582 * MiB;
constexpr size_t WS_WGOUT = 594 * MiB;
constexpr size_t WS_END = 602 * MiB;
constexpr size_t WGU_ELEMS = (size_t)2 * FF * DM, WD_ELEMS = (size_t)DM * FF;

constexpr int LDS_BYTES = 143360;
constexpr int XCH_OFF = 131072;
constexpr int MISC_OFF = 141312;

typedef unsigned short bf16_t;
typedef short bf16x8 __attribute__((ext_vector_type(8)));
typedef short s16x4 __attribute__((ext_vector_type(4)));
typedef float f32x4 __attribute__((ext_vector_type(4)));
typedef float f32x2 __attribute__((ext_vector_type(2)));
typedef float f32x16 __attribute__((ext_vector_type(16)));
typedef unsigned u32x4 __attribute__((ext_vector_type(4)));
typedef unsigned u32x2 __attribute__((ext_vector_type(2)));
#define LAS __attribute__((address_space(3)))

__device__ __forceinline__ unsigned cvt_pk_bf16(float lo, float hi) { unsigned r; asm volatile("v_cvt_pk_bf16_f32 %0, %1, %2" : "=v"(r) : "v"(lo), "v"(hi)); return r; }
__device__ __forceinline__ int TID() { int t = threadIdx.x; asm volatile("" : "+v"(t)); return t; }
__device__ __forceinline__ int BID() { int b = blockIdx.x; asm volatile("" : "+s"(b)); return b; }
__device__ __forceinline__ float bf2f(unsigned short b) { return __uint_as_float(((unsigned)b) << 16); }
__device__ __forceinline__ float wave_sum(float v) {
#pragma unroll
    for (int o = 1; o < 64; o <<= 1) v += __shfl_xor(v, o);
    return v;
}

namespace pg8 {
constexpr int BM = 256, BK = 64, HALF = 128, HTB = HALF * BK * 2, STAGE_BYTES = 8 * HTB, NXCD = 8, WGM = 8;
__host__ __device__ __forceinline__ int lds_byte(int r, int c) { const int st = (r >> 4) * 2 + (c >> 5), rr = r & 15, cc = c & 31, ob = rr * 64 + cc * 2; return st * 1024 + (ob ^ (((ob >> 9) & 1) << 5)); }
__host__ __device__ __forceinline__ void stage_rc(int b, int& R, int& C) { const int st = b / 1024, sb = b % 1024, swz = sb ^ (((sb >> 9) & 1) << 5); R = (st >> 1) * 16 + swz / 64; C = (st & 1) * 32 + (swz % 64) / 2; }
__host__ __device__ __forceinline__ int perm32(int rho) { const int n = rho >> 4, i = rho & 15; return 8 * (i >> 2) + 4 * n + (i & 3); }

__host__ __device__ __forceinline__ int permrope(int s) { return 64 * ((s >> 4) & 1) + 16 * (s >> 5) + (s & 15); }
struct Unit { int pm, pn, k0, nt, split; };
struct Gemm { const bf16_t* A; const bf16_t* Bt; int K; };

struct Sched {
    int nM, nN, nwg, G, c, nt_full, nsplit_units, split_nt, split_pm;
    __device__ __forceinline__ void init(int nM_, int nN_, int K, int G_, int c_, int nsplit, int snt, int spm) {
        nM = nM_; nN = nN_; nwg = nM * nN; G = G_; c = c_; nt_full = K / BK; nsplit_units = nsplit * nN_; split_nt = snt; split_pm = spm; }
    __device__ __forceinline__ bool next(int i, Unit& u) const {
        const long L = (long)i * G + c;
        const bool reg = L < nwg; const int s = reg ? 0 : (int)(L - nwg);
        if (!reg && s >= nsplit_units) return false;
        int wgid = reg ? (int)L : 0; { const int q = nwg / NXCD, r = nwg % NXCD, xcd = wgid % NXCD, off = wgid / NXCD; wgid = (xcd < r ? xcd * (q + 1) : r * (q + 1) + (xcd - r) * q) + off; }
        const int nig = WGM * nN, gid = wgid / nig, fm = gid * WGM, gsz = (nM - fm) < WGM ? (nM - fm) : WGM;
        const int pm_r = fm + ((wgid % nig) % gsz), pn_r = (wgid % nig) / gsz;
        const int pn_s = s % nN, sp_s = s / nN;
        u.pm = __builtin_amdgcn_readfirstlane(reg ? pm_r : split_pm); u.pn = __builtin_amdgcn_readfirstlane(reg ? pn_r : pn_s);
        u.split = __builtin_amdgcn_readfirstlane(reg ? -1 : sp_s); u.k0 = __builtin_amdgcn_readfirstlane(reg ? 0 : sp_s * split_nt); u.nt = __builtin_amdgcn_readfirstlane(reg ? nt_full : split_nt);
        return true;
    }
};

__device__ __forceinline__ float silu_mul(float g, float u) { const float e = __builtin_amdgcn_exp2f(-g * 1.4426950408889634f); return g * __builtin_amdgcn_rcpf(1.0f + e) * u; }
struct EpiSwiGLU {
    static constexpr int PERM = 1;
    bf16_t* O; int ldc;
    __device__ __forceinline__ void operator()(const f32x4 (&acc)[2][2][4][2], const Unit& u, int wr, int wc, int fr, int fq) const {
        asm volatile("" : "+v"(fr), "+v"(fq));
        const int row0 = u.pm * BM + wr * 64 + fr; const int col0 = u.pn * HALF + wc * 32 + 8 * fq;
#pragma unroll
        for (int ai = 0; ai < 2; ++ai)
#pragma unroll
            for (int m = 0; m < 4; ++m) { bf16_t* rowp = O + (size_t)(row0 + ai * HALF + m * 16) * ldc + col0;
                const f32x4 g0 = acc[ai][0][m][0], g1 = acc[ai][0][m][1], u0 = acc[ai][1][m][0], u1 = acc[ai][1][m][1];
                u32x4 w; w.x = cvt_pk_bf16(silu_mul(g0[0], u0[0]), silu_mul(g0[1], u0[1])); w.y = cvt_pk_bf16(silu_mul(g0[2], u0[2]), silu_mul(g0[3], u0[3]));
                w.z = cvt_pk_bf16(silu_mul(g1[0], u1[0]), silu_mul(g1[1], u1[1])); w.w = cvt_pk_bf16(silu_mul(g1[2], u1[2]), silu_mul(g1[3], u1[3]));
                *(u32x4*)rowp = w; }
    }
};
struct EpiResid {
    static constexpr int PERM = 0;
    const float* Xs; float* X; const float* gate; float coef; float* part;
    __device__ __forceinline__ void operator()(const f32x4 (&acc)[2][2][4][2], const Unit& u, int wr, int wc, int fr, int fq) const {
        asm volatile("" : "+v"(fr), "+v"(fq));
        const int col0 = u.pn * BM + wc * 32 + 4 * fq;
        if (u.split < 0) {
            f32x4 gv[2][2];
#pragma unroll
            for (int bj = 0; bj < 2; ++bj)
#pragma unroll
                for (int n = 0; n < 2; ++n) gv[bj][n] = *(const f32x4*)(gate + col0 + bj * HALF + n * 16) * coef;
#pragma unroll
            for (int ai = 0; ai < 2; ++ai)
#pragma unroll
                for (int mh = 0; mh < 1; ++mh) {
                    f32x4 xv[4][2][2];
#pragma unroll
                    for (int mm = 0; mm < 4; ++mm) { const int m = mh * 4 + mm; const float* rows = Xs + (size_t)(u.pm * BM + ai * HALF + wr * 64 + m * 16 + fr) * DM + col0;
#pragma unroll
                        for (int bj = 0; bj < 2; ++bj)
#pragma unroll
                            for (int n = 0; n < 2; ++n) xv[mm][bj][n] = *(const f32x4*)(rows + bj * HALF + n * 16); }
#pragma unroll
                    for (int mm = 0; mm < 4; ++mm) { const int m = mh * 4 + mm; float* rowp = X + (size_t)(u.pm * BM + ai * HALF + wr * 64 + m * 16 + fr) * DM + col0;
#pragma unroll
                        for (int bj = 0; bj < 2; ++bj)
#pragma unroll
                            for (int n = 0; n < 2; ++n) *(f32x4*)(rowp + bj * HALF + n * 16) = xv[mm][bj][n] + gv[bj][n] * acc[ai][bj][m][n]; }
                    asm volatile("" ::: "memory"); }
        } else {
            float* base = part + (size_t)u.split * 256 * DM;
#pragma unroll
            for (int ai = 0; ai < 2; ++ai)
#pragma unroll
                for (int m = 0; m < 4; ++m) { float* rowp = base + (size_t)(ai * HALF + wr * 64 + m * 16 + fr) * DM + col0;
#pragma unroll
                    for (int bj = 0; bj < 2; ++bj)
#pragma unroll
                        for (int n = 0; n < 2; ++n) *(f32x4*)(rowp + bj * HALF + n * 16) = acc[ai][bj][m][n]; }
        }
    }
};

struct EpiQK {
    static constexpr int PERM = 2;
    bf16_t* O; int ldc; int layer; const float* g0; const float* g1; const float* g2; const float* g3; LAS float* xch;
    __device__ __forceinline__ void operator()(const f32x4 (&acc)[2][2][4][2], const Unit& u, int wr, int wc, int fr, int fq) const {
        asm volatile("" : "+v"(fr), "+v"(fq));
        const int pn = u.pn;
        const float* const q0 = g0; const float* const q1 = g1; const float* const q2 = g2; const float* const q3 = g3; const int lay = layer;
        const int kind0 = (pn < 4) ? 1 : ((pn < 8) ? 2 : ((pn < 12) ? 1 : ((pn == 16) ? 2 : 0))), kind1 = (pn < 10) ? 2 : 0;
        const float* const gain0 = (pn < 4) ? q0 : ((pn < 8) ? q1 : ((pn < 12) ? q2 : q3)); const float* const gain1 = (pn < 8) ? q0 : q1;
        const int kind = lay == 0 ? kind0 : kind1; const float* const gain = lay == 0 ? gain0 : gain1;
        const bool latent = u.pm < SEQ / 256;
        const int dl = 16 * wc + 4 * fq;
        bf16_t* obase = O + (size_t)(u.pm * BM + wr * 64 + fr) * ldc + pn * BM + dl;
        if (kind == 0) {
#pragma unroll
            for (int ai = 0; ai < 2; ++ai)
#pragma unroll
                for (int m = 0; m < 4; ++m)
#pragma unroll
                    for (int bj = 0; bj < 2; ++bj) { bf16_t* p = obase + (size_t)(ai * HALF + m * 16) * ldc + bj * HALF; const f32x4 x1 = acc[ai][bj][m][0], x2 = acc[ai][bj][m][1];
                        u32x2 w1, w2; w1.x = cvt_pk_bf16(x1[0], x1[1]); w1.y = cvt_pk_bf16(x1[2], x1[3]); w2.x = cvt_pk_bf16(x2[0], x2[1]); w2.y = cvt_pk_bf16(x2[2], x2[3]);
                        *(u32x2*)p = w1; *(u32x2*)(p + 64) = w2; }
            return;
        }
        LAS float* xr = xch + ((wr * 128 + fr) * 8 + wc);
#pragma unroll
        for (int ai = 0; ai < 2; ++ai)
#pragma unroll
            for (int m = 0; m < 4; ++m)
#pragma unroll
                for (int bj = 0; bj < 2; ++bj) { const f32x4 x1 = acc[ai][bj][m][0], x2 = acc[ai][bj][m][1];
                    float s = (x1[0] * x1[0] + x1[1] * x1[1]) + (x1[2] * x1[2] + x1[3] * x1[3]) + (x2[0] * x2[0] + x2[1] * x2[1]) + (x2[2] * x2[2] + x2[3] * x2[3]);
                    { auto r16 = __builtin_amdgcn_permlane16_swap(__float_as_uint(s), __float_as_uint(s), false, false); s = __uint_as_float(r16[0]) + __uint_as_float(r16[1]); }
                    { auto r32 = __builtin_amdgcn_permlane32_swap(__float_as_uint(s), __float_as_uint(s), false, false); s = __uint_as_float(r32[0]) + __uint_as_float(r32[1]); }
                    if (fq == 0) xr[(ai * 64 + m * 16) * 8 + bj * 4] = s; }
        const f32x4 ga = *(const f32x4*)(gain + dl), gb = *(const f32x4*)(gain + 64 + dl);
        asm volatile("s_waitcnt lgkmcnt(0)" ::: "memory"); __builtin_amdgcn_s_barrier(); asm volatile("" ::: "memory");
        const bool rope = (kind == 2) && latent;
        float cc[2][4], sc[2][4], cd[4], sd[4];
#pragma unroll
        for (int j = 0; j < 4; ++j) { cc[0][j] = 1.f; cc[1][j] = 1.f; sc[0][j] = 0.f; sc[1][j] = 0.f; cd[j] = 1.f; sd[j] = 0.f; }
        if (rope) {
#pragma unroll
            for (int j = 0; j < 4; ++j) {
                const float inv = __builtin_amdgcn_exp2f(-(float)((dl + j) & 31) * (13.287712379549449f / 32.0f)) * 0.15915494309189535f;
                if (wc < 2) {
#pragma unroll
                    for (int ai = 0; ai < 2; ++ai) { float rv = (float)((u.pm * BM + ai * HALF + wr * 64) >> 6) * inv; rv -= floorf(rv); sc[ai][j] = __builtin_amdgcn_sinf(rv); cc[ai][j] = __builtin_amdgcn_cosf(rv); }
                } else {
                    float rv = (float)fr * inv; rv -= floorf(rv); const float s0 = __builtin_amdgcn_sinf(rv), c0 = __builtin_amdgcn_cosf(rv);
                    sc[0][j] = s0; sc[1][j] = s0; cc[0][j] = c0; cc[1][j] = c0;
                    float rd = 16.0f * inv; rd -= floorf(rd); sd[j] = __builtin_amdgcn_sinf(rd); cd[j] = __builtin_amdgcn_cosf(rd);
                }
            }
        }
#pragma unroll
        for (int m = 0; m < 4; ++m) {
#pragma unroll
            for (int ai = 0; ai < 2; ++ai)
#pragma unroll
                for (int bj = 0; bj < 2; ++bj) {
                    const f32x4 pr = *(const LAS f32x4*)(xch + ((wr * 128 + ai * 64 + m * 16 + fr) * 8 + bj * 4));
                    const float rstd = __builtin_amdgcn_rsqf(((pr[0] + pr[1]) + (pr[2] + pr[3])) * (1.0f / 128.0f) + EPS);
                    const f32x4 x1 = acc[ai][bj][m][0] * rstd * ga, x2 = acc[ai][bj][m][1] * rstd * gb;
                    float y1[4], y2[4];
#pragma unroll
                    for (int j = 0; j < 4; ++j) { y1[j] = x1[j] * cc[ai][j] - x2[j] * sc[ai][j]; y2[j] = x1[j] * sc[ai][j] + x2[j] * cc[ai][j]; }
                    bf16_t* p = obase + (size_t)(ai * HALF + m * 16) * ldc + bj * HALF;
                    u32x2 w1, w2; w1.x = cvt_pk_bf16(y1[0], y1[1]); w1.y = cvt_pk_bf16(y1[2], y1[3]); w2.x = cvt_pk_bf16(y2[0], y2[1]); w2.y = cvt_pk_bf16(y2[2], y2[3]);
                    *(u32x2*)p = w1; *(u32x2*)(p + 64) = w2; }
            if (rope && wc >= 2) {
#pragma unroll
                for (int ai = 0; ai < 2; ++ai)
#pragma unroll
                    for (int j = 0; j < 4; ++j) { const float c = cc[ai][j], s = sc[ai][j]; cc[ai][j] = c * cd[j] - s * sd[j]; sc[ai][j] = s * cd[j] + c * sd[j]; }
            }
        }
    }
};

template <class Epi, bool ALIGN_EPI, bool SP2>
__device__ __forceinline__ void gemm_phase(LAS unsigned char* lds, const Gemm g, const Sched& S, const Epi& E) {
    const int tid = TID(), wid = __builtin_amdgcn_readfirstlane(tid >> 6), lane = tid & 63, wr = wid >> 2, wc = wid & 3, fr = lane & 15, fq = lane >> 4;
    const int K = g.K;
    unsigned voffA[2], voffB[2];
#pragma unroll
    for (int i = 0; i < 2; ++i) { int R, C; stage_rc(tid * 16 + i * 8192, R, C); const int Rb = Epi::PERM == 1 ? ((R & ~31) + perm32(R & 31)) : (Epi::PERM == 2 ? ((R & ~127) + permrope(R & 127)) : R);
        voffA[i] = (unsigned)(R * K + C) * 2u; voffB[i] = (unsigned)(Rb * K + C) * 2u; }
    const size_t kstep = (size_t)(BK * 2);
    const size_t hstep = (size_t)HALF * K * 2;
    const size_t tstep = 2 * hstep;
    const unsigned ldsw = (unsigned)wid * 1024u;
    const int aoff = lds_byte(wr * 64 + fr, fq * 8), boff = lds_byte(wc * 32 + fr, fq * 8);
#define PG8_SA(b, h) (((b) * 2 + (h)) * HTB)
#define PG8_SB(b, h) ((4 + (b) * 2 + (h)) * HTB)
#define PG8_STAGE(bufoff, gbase, voff) do { _Pragma("unroll") for (int _i = 0; _i < 2; ++_i) \
        __builtin_amdgcn_global_load_lds((const unsigned*)((const char*)(gbase) + (voff)[_i]), (LAS unsigned*)(lds + (bufoff) + ldsw + _i * 8192), 16, 0, 0); } while (0)
#define PG8_LDA(dst, b, h) do { _Pragma("unroll") for (int m = 0; m < 4; ++m) _Pragma("unroll") for (int k = 0; k < 2; ++k) dst[m][k] = *(const LAS bf16x8*)(lds + PG8_SA(b, h) + aoff + m * 2048 + k * 1024); } while (0)
#define PG8_LDB(dst, b, h) do { _Pragma("unroll") for (int n = 0; n < 2; ++n) _Pragma("unroll") for (int k = 0; k < 2; ++k) dst[n][k] = *(const LAS bf16x8*)(lds + PG8_SB(b, h) + boff + n * 2048 + k * 1024); } while (0)
#define PG8_MMA(ai, bj, At, Bt) do { __builtin_amdgcn_s_setprio(1); _Pragma("unroll") for (int m = 0; m < 4; ++m) _Pragma("unroll") for (int n = 0; n < 2; ++n) _Pragma("unroll") for (int k = 0; k < 2; ++k) \
        acc[ai][bj][m][n] = __builtin_amdgcn_mfma_f32_16x16x32_bf16(Bt[n][k], At[m][k], acc[ai][bj][m][n], 0, 0, 0); __builtin_amdgcn_s_setprio(0); } while (0)
#define PG8_WAIT_V(n) asm volatile("s_waitcnt vmcnt(" #n ")" ::: "memory")
#define PG8_WAIT_L(n) asm volatile("s_waitcnt lgkmcnt(" #n ")" ::: "memory")
#define PG8_BAR __builtin_amdgcn_s_barrier()
#define PG8_SCHED __builtin_amdgcn_sched_barrier(0)
    Unit cur, nxt; int ui = 0;
    if (!S.next(0, cur)) return;
    f32x4 acc[2][2][4][2];
#pragma unroll
    for (int a = 0; a < 2; ++a)
#pragma unroll
        for (int b = 0; b < 2; ++b)
#pragma unroll
            for (int m = 0; m < 4; ++m)
#pragma unroll
                for (int n = 0; n < 2; ++n) acc[a][b][m][n] = (f32x4){0.f, 0.f, 0.f, 0.f};
    bf16x8 At[4][2], B0[2][2], B1[2][2];
    const char* cA = (const char*)g.A + (size_t)cur.pm * tstep + (size_t)cur.k0 * kstep; const char* cB = (const char*)g.Bt + (size_t)cur.pn * tstep + (size_t)cur.k0 * kstep;
    if constexpr (SP2) {
        PG8_STAGE(PG8_SB(0, 0), cB, voffB); PG8_STAGE(PG8_SB(0, 1), cB + hstep, voffB); PG8_STAGE(PG8_SA(0, 0), cA, voffA); PG8_STAGE(PG8_SA(0, 1), cA + hstep, voffA);
        if (wr == 1) PG8_BAR;
        PG8_WAIT_V(2); PG8_BAR;
        PG8_STAGE(PG8_SB(1, 0), cB + kstep, voffB); PG8_STAGE(PG8_SA(1, 0), cA + kstep, voffA); PG8_STAGE(PG8_SB(1, 1), cB + hstep + kstep, voffB);
        PG8_WAIT_V(6); PG8_BAR;
    } else {
        PG8_STAGE(PG8_SB(0, 0), cB, voffB); PG8_STAGE(PG8_SA(0, 0), cA, voffA); PG8_STAGE(PG8_SB(0, 1), cB + hstep, voffB); PG8_STAGE(PG8_SA(0, 1), cA + hstep, voffA);
        if (wr == 1) PG8_BAR;
        PG8_WAIT_V(4); PG8_BAR;
        PG8_STAGE(PG8_SB(1, 0), cB + kstep, voffB); PG8_STAGE(PG8_SA(1, 0), cA + kstep, voffA); PG8_STAGE(PG8_SB(1, 1), cB + hstep + kstep, voffB);
        PG8_WAIT_V(6); PG8_BAR;
    }
    for (;;) {
        const bool has_next = S.next(ui + 1, nxt);
        const int nt = cur.nt;
        const char* nA = has_next ? (const char*)g.A + (size_t)nxt.pm * tstep + (size_t)nxt.k0 * kstep : cA; const char* nB = has_next ? (const char*)g.Bt + (size_t)nxt.pn * tstep + (size_t)nxt.k0 * kstep : cB;
        for (int t = 0; t < nt; t += 2) {
            const bool last = (t == nt - 2);
            const char* a1 = cA + (size_t)(t + 1) * kstep;
            const char* a2 = last ? nA : cA + (size_t)(t + 2) * kstep; const char* b2 = last ? nB : cB + (size_t)(t + 2) * kstep;
            const char* a3 = a2 + kstep; const char* b3 = b2 + kstep;
            if constexpr (SP2) {
            PG8_LDB(B0, 0, 0); PG8_LDB(B1, 0, 1); PG8_SCHED; PG8_LDA(At, 0, 0); PG8_STAGE(PG8_SA(1, 1), a1 + hstep, voffA);
            PG8_WAIT_V(8); PG8_WAIT_L(0); PG8_BAR; PG8_MMA(0, 0, At, B0); PG8_MMA(0, 1, At, B1); PG8_BAR; PG8_SCHED;
            PG8_LDA(At, 0, 1); PG8_STAGE(PG8_SB(0, 0), b2, voffB); PG8_STAGE(PG8_SB(0, 1), b2 + hstep, voffB); PG8_STAGE(PG8_SA(0, 0), a2, voffA);
            PG8_WAIT_V(8); PG8_WAIT_L(0); PG8_BAR; PG8_MMA(1, 0, At, B0); PG8_MMA(1, 1, At, B1); PG8_BAR; PG8_SCHED;
            PG8_LDB(B0, 1, 0); PG8_LDB(B1, 1, 1); PG8_SCHED; PG8_LDA(At, 1, 0); PG8_STAGE(PG8_SA(0, 1), a2 + hstep, voffA);
            PG8_WAIT_V(8); PG8_WAIT_L(0); PG8_BAR; PG8_MMA(0, 0, At, B0); PG8_MMA(0, 1, At, B1); PG8_BAR; PG8_SCHED;
            PG8_LDA(At, 1, 1); PG8_STAGE(PG8_SB(1, 0), b3, voffB); PG8_STAGE(PG8_SB(1, 1), b3 + hstep, voffB); PG8_STAGE(PG8_SA(1, 0), a3, voffA);
            PG8_WAIT_V(8); PG8_WAIT_L(0); PG8_BAR; PG8_MMA(1, 0, At, B0); PG8_MMA(1, 1, At, B1); PG8_BAR; PG8_SCHED;
            } else {
            PG8_LDB(B0, 0, 0); PG8_SCHED; PG8_LDA(At, 0, 0); PG8_STAGE(PG8_SA(1, 1), a1 + hstep, voffA);
            PG8_WAIT_L(8); PG8_BAR; PG8_WAIT_L(0); PG8_MMA(0, 0, At, B0); PG8_BAR; PG8_SCHED;
            PG8_LDB(B1, 0, 1); PG8_STAGE(PG8_SB(0, 0), b2, voffB);
            PG8_BAR; PG8_WAIT_L(0); PG8_MMA(0, 1, At, B1); PG8_BAR;
            PG8_LDA(At, 0, 1); PG8_STAGE(PG8_SA(0, 0), a2, voffA);
            PG8_BAR; PG8_WAIT_L(0); PG8_MMA(1, 0, At, B0); PG8_BAR; PG8_SCHED;
            PG8_STAGE(PG8_SB(0, 1), b2 + hstep, voffB);
            PG8_WAIT_V(6); PG8_BAR; PG8_MMA(1, 1, At, B1); PG8_BAR;
            PG8_LDB(B0, 1, 0); PG8_SCHED; PG8_LDA(At, 1, 0); PG8_STAGE(PG8_SA(0, 1), a2 + hstep, voffA);
            PG8_WAIT_L(8); PG8_BAR; PG8_WAIT_L(0); PG8_MMA(0, 0, At, B0); PG8_BAR; PG8_SCHED;
            PG8_LDB(B1, 1, 1); PG8_STAGE(PG8_SB(1, 0), b3, voffB);
            PG8_BAR; PG8_WAIT_L(0); PG8_MMA(0, 1, At, B1); PG8_BAR;
            PG8_LDA(At, 1, 1); PG8_STAGE(PG8_SA(1, 0), a3, voffA);
            PG8_BAR; PG8_WAIT_L(0); PG8_MMA(1, 0, At, B0); PG8_BAR; PG8_SCHED;
            PG8_STAGE(PG8_SB(1, 1), b3 + hstep, voffB);
            PG8_WAIT_V(6); PG8_BAR; PG8_MMA(1, 1, At, B1); PG8_BAR;
            }
        }
        if constexpr (ALIGN_EPI) { if (wr == 0) PG8_BAR; }
        E(acc, cur, wr, wc, fr, fq);
        if (!has_next) break;
#pragma unroll
        for (int a = 0; a < 2; ++a)
#pragma unroll
            for (int b = 0; b < 2; ++b)
#pragma unroll
                for (int m = 0; m < 4; ++m)
#pragma unroll
                    for (int n = 0; n < 2; ++n) acc[a][b][m][n] = (f32x4){0.f, 0.f, 0.f, 0.f};
        cur = nxt; cA = nA; cB = nB; ++ui;
        if constexpr (ALIGN_EPI) { if (wr == 1) PG8_BAR; }
    }
    PG8_WAIT_V(0);
    if constexpr (!ALIGN_EPI) { if (wr == 0) PG8_BAR; }
    PG8_BAR;
#undef PG8_SA
#undef PG8_SB
#undef PG8_STAGE
#undef PG8_LDA
#undef PG8_LDB
#undef PG8_MMA
#undef PG8_WAIT_V
#undef PG8_WAIT_L
#undef PG8_BAR
#undef PG8_SCHED
}
}

namespace att {
constexpr int D = 128, NW = 8, QBLK = 32, KVBLK = 64;
constexpr float SCALE = 0.088388347648318440f;
constexpr float INV_SCALE = 11.313708498984761f;
constexpr float THR = 8.f;
constexpr float NEG = -1e30f;
constexpr size_t SHM_V = KVBLK * D * 2, SHM_K = KVBLK * D * 2, SHM_ATTN = 2 * SHM_V + 2 * SHM_K + NW * 64 * 4;
constexpr int BIAS_OFF = (int)SHM_ATTN;
enum { DENSE = 0, NA = 1, SW = 2 };
#define KSWZ(row, colB) ((row) * 256 + ((colB) ^ (((row) & 7) << 4)))
#define SBAR() __builtin_amdgcn_sched_barrier(0)
__device__ __forceinline__ int crow(int r, int hi) { return (r & 3) + 8 * (r >> 2) + 4 * hi; }

__device__ __forceinline__ void partialSM(f32x16& p0, f32x16& p1, float& m_reg, float& mn, float& alpha) {
  constexpr float C = SCALE * 1.4426950408889634f;
  float pmax = p0[0];
#pragma unroll
  for (int r = 1; r < 16; ++r) pmax = fmaxf(pmax, p0[r]);
#pragma unroll
  for (int r = 0; r < 16; ++r) pmax = fmaxf(pmax, p1[r]);
  { auto rr = __builtin_amdgcn_permlane32_swap(__float_as_uint(pmax), __float_as_uint(pmax), false, false);
    pmax = fmaxf(__uint_as_float(rr[0]), __uint_as_float(rr[1])); }
  if (__builtin_expect(__all(pmax - m_reg <= THR / SCALE), 1)) { mn = m_reg; alpha = 1.f; }
  else { mn = fmaxf(m_reg, pmax); alpha = __builtin_amdgcn_exp2f((m_reg - mn) * C); m_reg = mn; }
  float mnC = -mn * C;
#pragma unroll
  for (int r = 0; r < 16; ++r) p0[r] = fmaf(p0[r], C, mnC);
#pragma unroll
  for (int r = 0; r < 16; ++r) p1[r] = fmaf(p1[r], C, mnC);
#pragma unroll
  for (int r = 0; r < 16; ++r) p0[r] = __builtin_amdgcn_exp2f(p0[r]);
}
__device__ __forceinline__ void finishSM(f32x16& p0, f32x16& p1, float alpha, float& l_reg, bf16x8& pa0, bf16x8& pa1, bf16x8& pa2, bf16x8& pa3) {
#pragma unroll
  for (int r = 0; r < 16; ++r) p1[r] = __builtin_amdgcn_exp2f(p1[r]);
  float ps = 0;
#pragma unroll
  for (int r = 0; r < 16; ++r) ps += p0[r];
#pragma unroll
  for (int r = 0; r < 16; ++r) ps += p1[r];
  { auto rr = __builtin_amdgcn_permlane32_swap(__float_as_uint(ps), __float_as_uint(ps), false, false);
    ps = __uint_as_float(rr[0]) + __uint_as_float(rr[1]); }
  l_reg = l_reg * alpha + ps;
#define PK4(P, BASE, OUT) do { unsigned a0 = cvt_pk_bf16(P[BASE + 0], P[BASE + 1]), a1 = cvt_pk_bf16(P[BASE + 2], P[BASE + 3]);   \
    unsigned b0 = cvt_pk_bf16(P[BASE + 4], P[BASE + 5]), b1 = cvt_pk_bf16(P[BASE + 6], P[BASE + 7]);                              \
    auto r0 = __builtin_amdgcn_permlane32_swap(a0, b0, false, false); auto r1 = __builtin_amdgcn_permlane32_swap(a1, b1, false, false); \
    u32x4 w = {r0[0], r1[0], r0[1], r1[1]}; OUT = *reinterpret_cast<bf16x8*>(&w); } while (0)
  PK4(p0, 0, pa0); PK4(p0, 8, pa1); PK4(p1, 0, pa2); PK4(p1, 8, pa3);
#undef PK4
}
__device__ __forceinline__ void qkt(f32x16& p0, f32x16& p1, const bf16_t* Ks, const bf16x8* qr, int r32, int hi) {
  p0 = f32x16{}; p1 = f32x16{};
#pragma unroll
  for (int d0 = 0; d0 < 8; ++d0) { int cb = (d0 * 16 + hi * 8) * 2;
    bf16x8 b0 = *reinterpret_cast<const bf16x8*>((const char*)Ks + KSWZ(r32, cb));
    bf16x8 b1 = *reinterpret_cast<const bf16x8*>((const char*)Ks + KSWZ(32 + r32, cb));
    p0 = __builtin_amdgcn_mfma_f32_32x32x16_bf16(b0, qr[d0], p0, 0, 0, 0);
    p1 = __builtin_amdgcn_mfma_f32_32x32x16_bf16(b1, qr[d0], p1, 0, 0, 0); }
}
__device__ __forceinline__ int v_st(int k, int c) { const int kk = (k & ~0xC) | ((k & 4) << 1) | ((k & 8) >> 1); return ((kk >> 3) * 4 + (c >> 5)) * 512 + ((kk & 7) * 32 + (c & 31)) * 2; }
__device__ __forceinline__ int v_rd_base(int lane) { return ((lane & 3) << 3) | (((lane >> 2) & 3) << 6) | (((lane >> 4) & 1) << 5) | (((lane >> 5) & 1) << 8); }
constexpr int v_rd_off(int d0, int ks, int half) { return d0 * 512 + ks * 4096 + half * 2048; }
template <int OFF> __device__ __forceinline__ s16x4 tr_read(int vb) {
  s16x4 r; asm volatile("ds_read_b64_tr_b16 %0, %1 offset:%2" : "=&v"(r) : "v"(vb), "i"(OFF) : "memory"); return r;
}
template <int D0> __device__ __forceinline__ void pv_one(f32x16& od, int vb, bf16x8 pa0, bf16x8 pa1, bf16x8 pa2, bf16x8 pa3) {
  const s16x4 l0 = tr_read<v_rd_off(D0, 0, 0)>(vb), h0 = tr_read<v_rd_off(D0, 0, 1)>(vb), l1 = tr_read<v_rd_off(D0, 1, 0)>(vb), h1 = tr_read<v_rd_off(D0, 1, 1)>(vb);
  const s16x4 l2 = tr_read<v_rd_off(D0, 2, 0)>(vb), h2 = tr_read<v_rd_off(D0, 2, 1)>(vb), l3 = tr_read<v_rd_off(D0, 3, 0)>(vb), h3 = tr_read<v_rd_off(D0, 3, 1)>(vb);
  asm volatile("s_waitcnt lgkmcnt(0)" ::: "memory"); SBAR();
#define PK(L, H) (bf16x8){L[0], L[1], L[2], L[3], H[0], H[1], H[2], H[3]}
  od = __builtin_amdgcn_mfma_f32_32x32x16_bf16(pa0, PK(l0, h0), od, 0, 0, 0);
  od = __builtin_amdgcn_mfma_f32_32x32x16_bf16(pa1, PK(l1, h1), od, 0, 0, 0);
  od = __builtin_amdgcn_mfma_f32_32x32x16_bf16(pa2, PK(l2, h2), od, 0, 0, 0);
  od = __builtin_amdgcn_mfma_f32_32x32x16_bf16(pa3, PK(l3, h3), od, 0, 0, 0);
#undef PK
}
__device__ __forceinline__ void pv_d0(f32x16* o, int vb, bf16x8 pa0, bf16x8 pa1, bf16x8 pa2, bf16x8 pa3) {
  pv_one<0>(o[0], vb, pa0, pa1, pa2, pa3); pv_one<1>(o[1], vb, pa0, pa1, pa2, pa3); pv_one<2>(o[2], vb, pa0, pa1, pa2, pa3); pv_one<3>(o[3], vb, pa0, pa1, pa2, pa3);
}

struct UnitP { const bf16_t* Q; const bf16_t* K; const bf16_t* V; bf16_t* O; int ldq, ldk, ldo, NT, base_row, qb; float sink_l2e; };

template <int MODE> __device__ __forceinline__ int tile_row0(const UnitP& u, int t) {
  if (MODE == DENSE) return u.base_row + KVBLK * t;
  if (t < 4) return SEQ + KVBLK * t;
  if (MODE == NA) { int R0 = 4 * u.qb - 4; R0 = R0 < 0 ? 0 : (R0 > 120 ? 120 : R0); int kr = R0 + t - 4; kr = kr > 127 ? 127 : kr; return kr * 64; }
  int k0 = 256 * u.qb - 128 + 64 * (t - 4); k0 = k0 < 0 ? 0 : (k0 > SEQ - 64 ? SEQ - 64 : k0); return k0;
}
template <int MODE> __device__ __forceinline__ void mask_tile(f32x16& p0, f32x16& p1, const UnitP& u, int t, int wid, int r32, int hi, const float* biasL) {
  if (MODE == DENSE) return;
  if (t < 4) return;
  if (MODE == SW) {
    const int kpos0 = 256 * u.qb - 128 + 64 * (t - 4); int qpos = 256 * u.qb + wid * 32 + r32; int hi_ = hi;
    asm volatile("" : "+v"(qpos), "+v"(hi_));
#pragma unroll
    for (int r = 0; r < 16; ++r) { const int k0 = kpos0 + crow(r, hi_), k1 = k0 + 32; const int d0 = k0 - qpos, d1 = k1 - qpos;
      const bool v0 = (k0 >= 0) && (k0 < SEQ) && (d0 <= 128) && (d0 >= -128); const bool v1 = (k1 >= 0) && (k1 < SEQ) && (d1 <= 128) && (d1 >= -128);
      p0[r] = v0 ? p0[r] : NEG; p1[r] = v1 ? p1[r] : NEG; }
  } else {
    int R0 = 4 * u.qb - 4; R0 = R0 < 0 ? 0 : (R0 > 120 ? 120 : R0); const int kr = R0 + t - 4;
    const int rq = 4 * u.qb + (wid >> 1); int rs = rq - 4; rs = rs < 0 ? 0 : (rs > 120 ? 120 : rs);
    const bool rowvalid = (kr >= rs) && (kr < rs + 8);
    if (!rowvalid) {
#pragma unroll
      for (int r = 0; r < 16; ++r) { p0[r] = NEG; p1[r] = NEG; }
      return; }
    int cq = (wid & 1) * 32 + r32; int hi_ = hi;
    asm volatile("" : "+v"(cq), "+v"(hi_));
    int cs = cq - 8; cs = cs < 0 ? 0 : (cs > 48 ? 48 : cs);
    int brow = kr - rq + 7; brow = brow < 0 ? 0 : (brow > 14 ? 14 : brow);
    const float* bl = biasL + brow * 31 + 15 - cq;
#pragma unroll
    for (int r = 0; r < 16; ++r) { const int k0 = crow(r, hi_), k1 = k0 + 32;
      const bool v0 = rowvalid && (k0 >= cs) && (k0 < cs + 16); const bool v1 = rowvalid && (k1 >= cs) && (k1 < cs + 16);
      int i0 = k0 - cq; i0 = i0 < -15 ? -15 : (i0 > 15 ? 15 : i0); int i1 = k1 - cq; i1 = i1 < -15 ? -15 : (i1 > 15 ? 15 : i1);
      const float b0 = bl[cq + i0], b1 = bl[cq + i1];
      p0[r] = v0 ? p0[r] + b0 : NEG; p1[r] = v1 ? p1[r] + b1 : NEG;
      SBAR(); }
  }
}

template <int MODE, int SDEPTH>
__device__ __forceinline__ void attn_unit(const UnitP& u, char* lds) {
  const int tid = TID(), wid = tid >> 6, lane = tid & 63, r32 = lane & 31, hi = lane >> 5;
  bf16_t* V_lds = (bf16_t*)lds; bf16_t* K_lds = (bf16_t*)(lds + 2 * SHM_V);
  float* ws = (float*)(lds + 2 * SHM_V + 2 * SHM_K) + wid * 64; float* li_l = ws; float* al_l = ws + 32;
  const float* biasL = (const float*)(lds + BIAS_OFF);
  const bf16_t* __restrict__ Kh = u.K; const bf16_t* __restrict__ Vh = u.V; const int LDK = u.ldk;
  float m_reg = -1e30f, l_reg = 0; f32x16 o[4] = {}; bf16x8 qr[8];
  const bf16_t* Qw = u.Q + (long)(wid * QBLK + r32) * u.ldq + hi * 8;
#pragma unroll
  for (int d0 = 0; d0 < 8; ++d0) qr[d0] = *reinterpret_cast<const bf16x8*>(Qw + d0 * 16);
  const int vb0 = (int)(uintptr_t)V_lds + v_rd_base(lane);
  struct { bf16x8 vs0, vs1, ks0, ks1; } sr_[SDEPTH];
#define SLOAD(i, k0) do { int t_ = tid; if (MODE != DENSE) asm volatile("" : "+v"(t_)); const int sr = t_ >> 4, sc = (t_ & 15) * 8; \
    const long _r0 = (long)((k0) + sr) * LDK + sc, _r1 = (long)((k0) + 32 + sr) * LDK + sc; \
    sr_[i].vs0 = *reinterpret_cast<const bf16x8*>(&Vh[_r0]); sr_[i].vs1 = *reinterpret_cast<const bf16x8*>(&Vh[_r1]); \
    sr_[i].ks0 = *reinterpret_cast<const bf16x8*>(&Kh[_r0]); sr_[i].ks1 = *reinterpret_cast<const bf16x8*>(&Kh[_r1]); } while (0)
#define SWRITE(b, i) do { int t_ = tid; if (MODE != DENSE) asm volatile("" : "+v"(t_)); const int sr = t_ >> 4, sc = (t_ & 15) * 8, vst0 = v_st(sr, sc), vst1 = v_st(32 + sr, sc); \
    *(bf16x8*)((char*)V_lds + (b) * SHM_V + vst0) = sr_[i].vs0;          \
    *(bf16x8*)((char*)V_lds + (b) * SHM_V + vst1) = sr_[i].vs1; int kc = sc * 2;               \
    *(bf16x8*)((char*)K_lds + (b) * SHM_K + KSWZ(sr, kc)) = sr_[i].ks0;                       \
    *(bf16x8*)((char*)K_lds + (b) * SHM_K + KSWZ(32 + sr, kc)) = sr_[i].ks1; } while (0)
#define SWAIT() do { if constexpr (SDEPTH == 2) asm volatile("s_waitcnt vmcnt(4)" ::: "memory"); else asm volatile("s_waitcnt vmcnt(0)" ::: "memory"); } while (0)
#define RESC(a) do { if (__any((a) < 1.f)) { if (hi == 0) al_l[r32] = (a); asm volatile("s_waitcnt lgkmcnt(0)" ::: "memory"); \
    _Pragma("unroll") for (int d = 0; d < 4; ++d) _Pragma("unroll") for (int r = 0; r < 16; ++r) o[d][r] *= al_l[crow(r, hi)]; } } while (0)
#define ROW0(t) tile_row0<MODE>(u, (t))
  f32x16 pA0, pA1, pB0, pB1; float mnA, mnB, alA, alB; bf16x8 pa0, pa1, pa2, pa3; const int NT = u.NT;
  constexpr int SE = 0, SO = SDEPTH - 1;
  SLOAD(SE, ROW0(0)); asm volatile("s_waitcnt vmcnt(0)" ::: "memory"); SWRITE(0, SE); __syncthreads();
  qkt(pA0, pA1, K_lds, qr, r32, hi); mask_tile<MODE>(pA0, pA1, u, 0, wid, r32, hi, biasL); partialSM(pA0, pA1, m_reg, mnA, alA);
  SLOAD(SO, ROW0(1)); if constexpr (SDEPTH == 2) { if (2 < NT) SLOAD(SE, ROW0(2)); }
  SWAIT(); SWRITE(1, SO); __syncthreads();
  for (int j = 1; j + 1 < NT; j += 2) {
    SBAR(); qkt(pB0, pB1, (bf16_t*)((char*)K_lds + SHM_K), qr, r32, hi);
    finishSM(pA0, pA1, alA, l_reg, pa0, pa1, pa2, pa3); SBAR();
    SLOAD(SO, ROW0(j + SDEPTH)); SBAR();
    pv_d0(o, vb0, pa0, pa1, pa2, pa3); mask_tile<MODE>(pB0, pB1, u, j, wid, r32, hi, biasL); partialSM(pB0, pB1, m_reg, mnB, alB);
    __syncthreads(); SWAIT(); SWRITE(0, SE);
    RESC(alB); __syncthreads();
    SBAR(); qkt(pA0, pA1, K_lds, qr, r32, hi);
    finishSM(pB0, pB1, alB, l_reg, pa0, pa1, pa2, pa3); SBAR();
    if (SDEPTH == 1 || j + 3 < NT) SLOAD(SE, ROW0(j + 1 + SDEPTH)); SBAR();
    pv_d0(o, vb0 + (int)SHM_V, pa0, pa1, pa2, pa3); mask_tile<MODE>(pA0, pA1, u, j + 1, wid, r32, hi, biasL); partialSM(pA0, pA1, m_reg, mnA, alA);
    __syncthreads(); SWAIT(); SWRITE(1, SO);
    RESC(alA); __syncthreads();
  }
  SBAR(); qkt(pB0, pB1, (bf16_t*)((char*)K_lds + SHM_K), qr, r32, hi);
  finishSM(pA0, pA1, alA, l_reg, pa0, pa1, pa2, pa3); SBAR();
  pv_d0(o, vb0, pa0, pa1, pa2, pa3); mask_tile<MODE>(pB0, pB1, u, NT - 1, wid, r32, hi, biasL); partialSM(pB0, pB1, m_reg, mnB, alB);
  __syncthreads(); RESC(alB);
  finishSM(pB0, pB1, alB, l_reg, pa0, pa1, pa2, pa3); SBAR();
  pv_d0(o, vb0 + (int)SHM_V, pa0, pa1, pa2, pa3);
  l_reg += __builtin_amdgcn_exp2f(u.sink_l2e - m_reg * (SCALE * 1.4426950408889634f));
  if (hi == 0) li_l[r32] = l_reg; asm volatile("s_waitcnt lgkmcnt(0)" ::: "memory");
  float rli[16];
#pragma unroll
  for (int r = 0; r < 16; ++r) rli[r] = __builtin_amdgcn_rcpf(li_l[crow(r, hi)]);
  bf16_t* Ow = u.O + (long)(wid * QBLK) * u.ldo;
#pragma unroll
  for (int r = 0; r < 16; ++r) { int orow = crow(r, hi);
#pragma unroll
    for (int d0 = 0; d0 < 4; ++d0) { const float v = o[d0][r] * rli[r]; Ow[(long)orow * u.ldo + d0 * 32 + r32] = (bf16_t)(cvt_pk_bf16(v, v) & 0xffffu); } }
  __syncthreads();
#undef SLOAD
#undef SWRITE
#undef SWAIT
#undef RESC
#undef ROW0
}
#undef KSWZ
#undef SBAR
}

struct Args { const float* in[22]; float* out; unsigned char* ws; int ph_lo, ph_hi; };
#define CAS __attribute__((address_space(4)))
__device__ __forceinline__ const float* INP(int i) { const CAS char* k = (const CAS char*)__builtin_amdgcn_kernarg_segment_ptr(); asm volatile("" : "+s"(k)); return *(const float* const CAS*)(k + 8 * i); }
__device__ __forceinline__ float* OUTP() { const CAS char* k = (const CAS char*)__builtin_amdgcn_kernarg_segment_ptr(); asm volatile("" : "+s"(k)); return *(float* const CAS*)(k + 8 * 22); }
__device__ __forceinline__ unsigned char* WSP() { const CAS char* k = (const CAS char*)__builtin_amdgcn_kernarg_segment_ptr(); asm volatile("" : "+s"(k)); return *(unsigned char* const CAS*)(k + 8 * 23); }
enum { I_X = 0, I_C, I_CTX, I_CCTX, I_ADAW, I_ADAB, I_NORMG, I_WG, I_WU, I_WD, I_ABIN, I_ABOUT, I_NAQG, I_NAKG, I_NABIAS, I_SWQG, I_SWKG, I_SINK, I_GIN, I_GOUT, I_GQG, I_GKG };

__device__ __forceinline__ unsigned f2bf(float f) { unsigned u = __builtin_bit_cast(unsigned, f); return (u + 0x7fffu + ((u >> 16) & 1u)) >> 16; }
__device__ __forceinline__ unsigned pk2(float lo, float hi) { return f2bf(lo) | (f2bf(hi) << 16); }
template <bool DEEP> __device__ __forceinline__ void transpose_item(const float* __restrict__ W, int K, int N, bf16_t* WT, int mode, LAS float* scr, int item, int lane) {
    const int nblk = N / 32, kb = item / nblk, nb = item % nblk, k0 = 64 * kb, n0 = 32 * nb;
    if constexpr (DEEP) {
        float t[32];
#pragma unroll
        for (int i = 0; i < 32; ++i) { const int kk = 2 * i + (lane >> 5); t[i] = W[(size_t)(k0 + kk) * N + n0 + (lane & 31)]; }
#pragma unroll
        for (int i = 0; i < 32; ++i) { const int kk = 2 * i + (lane >> 5); scr[kk * 33 + (lane & 31)] = t[i]; }
    } else {
#pragma unroll 8
    for (int i = 0; i < 32; ++i) { const int kk = 2 * i + (lane >> 5); scr[kk * 33 + (lane & 31)] = W[(size_t)(k0 + kk) * N + n0 + (lane & 31)]; }
    }
    asm volatile("s_waitcnt lgkmcnt(0)" ::: "memory");
    const int c = lane & 7;
    const int rbase = (mode == 0) ? n0 : ((n0 >> 7) * 256 + (n0 & 127) + (mode == 2 ? 128 : 0));
#pragma unroll
    for (int j = 0; j < 4; ++j) { const int n = (lane >> 3) + 8 * j; const LAS float* s = scr + (8 * c) * 33 + n;
        u32x4 o; o.x = pk2(s[0 * 33], s[1 * 33]); o.y = pk2(s[2 * 33], s[3 * 33]); o.z = pk2(s[4 * 33], s[5 * 33]); o.w = pk2(s[6 * 33], s[7 * 33]);
        *(u32x4*)(WT + (size_t)(rbase + n) * K + k0 + 8 * c) = o; }
    asm volatile("s_waitcnt lgkmcnt(0)" ::: "memory");
}
constexpr int CV_GU1 = (DM / 64) * (FF / 32), CV_D1 = (FF / 64) * (DM / 32);
constexpr int CV_GU = 8 * CV_GU1, CV_D = 4 * CV_D1, CV_ABI = (DM / 64) * (AB_IN / 32), CV_SQ = (DM / 64) * (DM / 32), CV_GI = (DM / 64) * (C_IN / 32);
constexpr int CV_NP0 = 4 * CV_GU1 + 2 * CV_D1 + CV_ABI + CV_SQ;
constexpr int CV_NDEF = 3 * CV_GU1 + CV_GI + CV_SQ + 3 * CV_GU1;
__device__ __forceinline__ int cv_p0_to_full(int p) {
    if (p < 4 * CV_GU1) return p;
    p -= 4 * CV_GU1; if (p < 2 * CV_D1) return CV_GU + p;
    p -= 2 * CV_D1; if (p < CV_ABI) return CV_GU + CV_D + p;
    p -= CV_ABI; return CV_GU + CV_D + CV_ABI + p;
}
__device__ __forceinline__ int cv_def_to_full(int d) {
    if (d < 3 * CV_GU1) { const int sub = d / CV_GU1, r = d - sub * CV_GU1; return sub < 2 ? (2 * 2 + sub) * CV_GU1 + r : CV_GU + 2 * CV_D1 + r; }
    d -= 3 * CV_GU1; if (d < CV_GI) return CV_GU + CV_D + CV_ABI + CV_SQ + d;
    d -= CV_GI; if (d < CV_SQ) return CV_GU + CV_D + CV_ABI + CV_SQ + CV_GI + d;
    d -= CV_SQ; { const int sub = d / CV_GU1, r = d - sub * CV_GU1; return sub < 2 ? (3 * 2 + sub) * CV_GU1 + r : CV_GU + 3 * CV_D1 + r; }
}
template <bool DEEP> __device__ __forceinline__ void convert_item(int it, LAS float* scr, int lane) {
    bf16_t* wgu = (bf16_t*)(WSP() + WS_WGU); bf16_t* wd = (bf16_t*)(WSP() + WS_WD);
    int r = it;
    if (r < CV_GU) { const int q = r / CV_GU1, lf = q >> 1, gu = q & 1; r -= q * CV_GU1;
        transpose_item<DEEP>((gu ? INP(I_WU) : INP(I_WG)) + (size_t)lf * DM * FF, DM, FF, wgu + (size_t)lf * WGU_ELEMS, 1 + gu, scr, r, lane); return; }
    r -= CV_GU;
    if (r < CV_D) { const int lf = r / CV_D1; r -= lf * CV_D1; transpose_item<DEEP>(INP(I_WD) + (size_t)lf * FF * DM, FF, DM, wd + (size_t)lf * WD_ELEMS, 0, scr, r, lane); return; }
    r -= CV_D;
    if (r < CV_ABI) { transpose_item<DEEP>(INP(I_ABIN), DM, AB_IN, (bf16_t*)(WSP() + WS_WABIN), 0, scr, r, lane); return; }
    r -= CV_ABI;
    if (r < CV_SQ) { transpose_item<DEEP>(INP(I_ABOUT), DM, DM, (bf16_t*)(WSP() + WS_WABOUT), 0, scr, r, lane); return; }
    r -= CV_SQ;
    if (r < CV_GI) { transpose_item<DEEP>(INP(I_GIN), DM, C_IN, (bf16_t*)(WSP() + WS_WGIN), 0, scr, r, lane); return; }
    r -= CV_GI;
    transpose_item<DEEP>(INP(I_GOUT), DM, DM, (bf16_t*)(WSP() + WS_WGOUT), 0, scr, r, lane);
}
__device__ __forceinline__ void phase0(const Args& a, unsigned char* lds_g, int G) {
    const int tid = TID(), lane = tid & 63, wave = tid >> 6; const int bid = BID();
    float* sc = (float*)lds_g;
    float* red = sc + 4096;
    for (int i = tid; i < DM; i += 512) { const float c = INP(I_C)[i]; sc[i] = c / (1.0f + __expf(-c)); const float cc = INP(I_CCTX)[i]; sc[DM + i] = cc / (1.0f + __expf(-cc)); }
    __syncthreads();
    float* mod = (float*)(WSP() + WS_MOD);
    for (int unit = bid; unit < 256; unit += G) {
        const int layer = unit >> 7, col0 = (unit & 127) * 144;
        f32x4 a1 = {0.f, 0.f, 0.f, 0.f}, a2 = {0.f, 0.f, 0.f, 0.f};
        if (lane < 36) {
            const float* W = INP(I_ADAW) + (size_t)layer * DM * NMODV + col0 + 4 * lane;
            for (int k = wave * 256; k < wave * 256 + 256; k += 8) {
                f32x4 w[8];
#pragma unroll
                for (int q = 0; q < 8; ++q) w[q] = __builtin_nontemporal_load((const f32x4*)(W + (size_t)(k + q) * NMODV));
#pragma unroll
                for (int q = 0; q < 8; ++q) { a1 += w[q] * sc[k + q]; a2 += w[q] * sc[DM + k + q]; }
            }
#pragma unroll
            for (int e = 0; e < 4; ++e) { red[(wave * 2 + 0) * 144 + 4 * lane + e] = a1[e]; red[(wave * 2 + 1) * 144 + 4 * lane + e] = a2[e]; }
        }
        __syncthreads();
        if (tid < 288) { const int v = tid / 144, j = tid % 144; float s = INP(I_ADAB)[layer * NMODV + col0 + j];
#pragma unroll
            for (int w = 0; w < 8; ++w) s += red[(w * 2 + v) * 144 + j];
            mod[(size_t)(layer * 2 + v) * NMODV + col0 + j] = s; }
        __syncthreads();
    }
    LAS float* scr = (LAS float*)((LAS unsigned char*)lds_g + wave * 16384);
    const int gw = bid * 8 + wave, NGW = G * 8;
    for (int p = gw; p < CV_NP0; p += NGW) convert_item<false>(cv_p0_to_full(p), scr, lane);
    for (int d = (G == 256 ? SIDE_END : 0) + gw; d < CV_NDEF; d += NGW) convert_item<false>(cv_def_to_full(d), scr, lane);
}
__device__ __forceinline__ void side_convert(unsigned char* lds_g, int idle_from, int quota, int base, int end) {
    const int bid = BID();
    if (bid < idle_from) return;
    const int tid = TID(), lane = tid & 63, wave = tid >> 6;
    LAS float* scr = (LAS float*)((LAS unsigned char*)lds_g + wave * 16384);
    const int first = base + ((bid - idle_from) * 8 + wave) * quota;
    for (int q = 0; q < quota; ++q) { const int d = first + q; if (d < end) convert_item<true>(cv_def_to_full(d), scr, lane); }
}

__device__ __forceinline__ void modulate_phase(const float* xsrc, const float* csrc, float* cdst, const float* part, int nsplit, const float* cgate, float ccoef,
                                               const float* g, const float* shift_l, const float* scale_l, const float* shift_c, const float* scale_c, bf16_t* h, int nrows, int G, unsigned char* lds_g) {
    const int tid = TID(), lane = tid & 63, wave = tid >> 6;
    const int bid = BID();
    if (nrows > SEQ) {
        float* red = (float*)lds_g;
        float* ssl = red + 8 * DM;
        for (int r = bid; r < CTXL; r += G) {
            f32x4 s[8];
#pragma unroll
            for (int j = 0; j < 8; ++j) s[j] = (f32x4){0.f, 0.f, 0.f, 0.f};
            for (int sp = wave; sp < nsplit; sp += 8) { const f32x4* pr = (const f32x4*)(part + ((size_t)sp * 256 + r) * DM) + lane;
#pragma unroll
                for (int j = 0; j < 8; ++j) s[j] += pr[64 * j]; }
#pragma unroll
            for (int j = 0; j < 8; ++j) *((f32x4*)(red + wave * DM) + lane + 64 * j) = s[j];
            __syncthreads();
            const int col = wave * 256 + 4 * lane;
            f32x4 t = *(const f32x4*)(red + col);
#pragma unroll
            for (int w = 1; w < 8; ++w) t += *(const f32x4*)(red + w * DM + col);
            f32x4 v = *(const f32x4*)(csrc + (size_t)r * DM + col);
            if (nsplit > 0) v += ccoef * (*(const f32x4*)(cgate + col)) * t;
            *(f32x4*)(cdst + (size_t)r * DM + col) = v;
            const float ssw = wave_sum((v.x * v.x + v.y * v.y) + (v.z * v.z + v.w * v.w));
            if (lane == 0) ssl[wave] = ssw;
            __syncthreads();
            float ss = 0.f;
#pragma unroll
            for (int w = 0; w < 8; ++w) ss += ssl[w];
            const float rstd = 1.0f / sqrtf(ss * (1.0f / DM) + EPS);
            const f32x4 y = (v * rstd) * (*(const f32x4*)(g + col)); const f32x4 z = y * (*(const f32x4*)(scale_c + col) + 1.0f) + *(const f32x4*)(shift_c + col);
            u32x2 w2; w2.x = cvt_pk_bf16(z.x, z.y); w2.y = cvt_pk_bf16(z.z, z.w); *(u32x2*)(h + (size_t)(SEQ + r) * DM + col) = w2;
            __syncthreads();
        }
    }
    const int gw = bid * 8 + wave, NGW = G * 8;
    for (int row = gw; row < SEQ; row += NGW) {
        f32x4 v[8];
        const f32x4* xr = (const f32x4*)(xsrc + (size_t)row * DM) + lane;
#pragma unroll
        for (int j = 0; j < 8; ++j) v[j] = xr[64 * j];
        float ss = 0.f;
#pragma unroll
        for (int j = 0; j < 8; ++j) ss += (v[j].x * v[j].x + v[j].y * v[j].y) + (v[j].z * v[j].z + v[j].w * v[j].w);
        const float rstd = 1.0f / sqrtf(wave_sum(ss) * (1.0f / DM) + EPS);
        const f32x4* sh = (const f32x4*)shift_l + lane; const f32x4* scl = (const f32x4*)scale_l + lane;
        const f32x4* gg = (const f32x4*)g + lane;
        u32x2* ho = (u32x2*)(h + (size_t)row * DM) + lane;
#pragma unroll
        for (int j = 0; j < 8; ++j) { const f32x4 y = (v[j] * rstd) * gg[64 * j]; const f32x4 z = y * (scl[64 * j] + 1.0f) + sh[64 * j];
            u32x2 w; w.x = cvt_pk_bf16(z.x, z.y); w.y = cvt_pk_bf16(z.z, z.w); ho[64 * j] = w; }
    }
}

__device__ __forceinline__ void attn_phase0(const Args& a, unsigned char* lds_g, int G) {
    bf16_t* P = (bf16_t*)(WSP() + WS_P); bf16_t* O = (bf16_t*)(WSP() + WS_O);
    float* biasL = (float*)(lds_g + att::BIAS_OFF);
    const int tid0 = TID();
    for (int un = BID(); un < 528; un += G) {
        att::UnitP u; u.ldq = AB_IN; u.ldk = AB_IN; u.ldo = DM; u.sink_l2e = -INFINITY;
        if (un < 256) {
            const int h = un & 7, qb = un >> 3;
            for (int i = tid0; i < 465; i += 512) biasL[i] = INP(I_NABIAS)[h * 465 + i] * att::INV_SCALE;
            __syncthreads();
            u.Q = P + (size_t)(256 * qb) * AB_IN + h * 128; u.K = P + (16 + h) * 128; u.V = P + (24 + h) * 128; u.O = O + (size_t)(256 * qb) * DM + h * 128;
            u.NT = 16; u.base_row = 0; u.qb = qb;
            att::attn_unit<att::NA, 1>(u, (char*)lds_g);
        } else if (un < 512) {
            const int hq = (un - 256) & 7, qb = (un - 256) >> 3, kvh = hq >> 2;
            u.Q = P + (size_t)(256 * qb) * AB_IN + (8 + hq) * 128; u.K = P + (32 + kvh) * 128; u.V = P + (34 + kvh) * 128; u.O = O + (size_t)(256 * qb) * DM + (8 + hq) * 128;
            u.NT = 12; u.base_row = 0; u.qb = qb; u.sink_l2e = INP(I_SINK)[hq] * 1.4426950408889634f;
            att::attn_unit<att::SW, 1>(u, (char*)lds_g);
        } else {
            const int hh = un - 512;
            u.Q = P + (size_t)SEQ * AB_IN + hh * 128; u.O = O + (size_t)SEQ * DM + hh * 128;
            const bool nah = hh < 8; const int hq = nah ? 0 : hh - 8, kvh = hq >> 2;
            const int kslot = nah ? 16 + hh : 32 + kvh, vslot = nah ? 24 + hh : 34 + kvh;
            u.K = P + kslot * 128; u.V = P + vslot * 128;
            const float sk = INP(I_SINK)[hq] * 1.4426950408889634f; u.sink_l2e = nah ? -INFINITY : sk;
            u.NT = 4; u.base_row = SEQ; u.qb = 0;
            att::attn_unit<att::DENSE, 2>(u, (char*)lds_g);
        }
    }
}
__device__ __forceinline__ void attn_phase1(const Args& a, unsigned char* lds_g, int G) {
    bf16_t* P = (bf16_t*)(WSP() + WS_P); bf16_t* O = (bf16_t*)(WSP() + WS_O);
    const int bid = BID();
    for (int i = 0;; ++i) {
        int un;
        if ((G & 7) == 0) { const int x = bid & 7, j = (bid >> 3) + i * (G >> 3); if (j >= 64) break; un = x * 64 + j; }
        else { un = bid + i * G; if (un >= 512) break; }
        const int h = un >> 5, qb = un & 31, kvh = h >> 2;
        att::UnitP u; u.ldq = C_IN; u.ldk = C_IN; u.ldo = DM; u.sink_l2e = -INFINITY;
        u.Q = P + (size_t)(256 * qb) * C_IN + h * 128; u.K = P + (16 + kvh) * 128; u.V = P + (20 + kvh) * 128; u.O = O + (size_t)(256 * qb) * DM + h * 128;
        u.NT = MT / 64; u.base_row = 0; u.qb = qb;
        att::attn_unit<att::DENSE, 2>(u, (char*)lds_g);
    }
}

#define XB_TMO      128
#define XB_XCNT(j)  (256  + 64 * (j))
#define XB_XSUB(j)  (1280 + 64 * (j))
#define XB_XGEN(j)  (2304 + 64 * (j))
#define XB_TOP      3328
#define XB_TOPGEN   3392
#define XCD_BAR_WORDS 3456
#define XB_SPIN_CAP (1u << 18)
__device__ __forceinline__ unsigned xb_ld(unsigned* p)              { return __hip_atomic_load(p, __ATOMIC_RELAXED, __HIP_MEMORY_SCOPE_AGENT); }
__device__ __forceinline__ unsigned xb_add(unsigned* p, unsigned v) { return __hip_atomic_fetch_add(p, v, __ATOMIC_RELAXED, __HIP_MEMORY_SCOPE_AGENT); }
__device__ __forceinline__ unsigned xb_xcc_id() { return (unsigned)__builtin_amdgcn_s_getreg((3 << 11) | 20) & 0xFu; }
#define XB_SPIN(cond, bar) do { unsigned _sp = 0; while (cond) { __builtin_amdgcn_s_sleep(1); \
    if ((++_sp & 255u) == 0u) { if (xb_ld(&(bar)[XB_TMO])) break; if (_sp > XB_SPIN_CAP) { atomicAdd(&(bar)[XB_TMO], 1u); break; } } } } while (0)
struct XcdBarrier { unsigned* bar; unsigned x; volatile LAS unsigned* st; };
__device__ __forceinline__ XcdBarrier xcd_barrier_post(unsigned* bar, volatile LAS unsigned* st) {
    XcdBarrier b; b.bar = bar; b.x = xb_xcc_id(); b.st = st;
    if (threadIdx.x == 0) (void)xb_add(&bar[XB_XCNT(b.x)], 1u);
    return b;
}
__device__ __forceinline__ void xcd_barrier_complete(unsigned* bar, unsigned x, unsigned& nloc, unsigned& nx) {
    const unsigned G = gridDim.x * gridDim.y * gridDim.z;
    unsigned sum, cnt, mine, sp = 0u;
    for (;;) {
        sum = 0u; cnt = 0u; mine = 0u;
#pragma unroll
        for (unsigned j = 0; j < 16; ++j) { const unsigned c = xb_ld(&bar[XB_XCNT(j)]); sum += c; cnt += (c > 0u) ? 1u : 0u; mine = (j == x) ? c : mine; }
        if (sum == G) break;
        __builtin_amdgcn_s_sleep(1);
        if ((++sp & 255u) == 0u) { if (xb_ld(&bar[XB_TMO])) break; if (sp > XB_SPIN_CAP) { atomicAdd(&bar[XB_TMO], 1u); break; } }
    }
    nloc = mine > 0u ? mine : 1u; nx = cnt > 0u ? cnt : 1u;
}
__device__ __forceinline__ void xcd_barrier(const XcdBarrier& b) {
    asm volatile("s_waitcnt vmcnt(0)" ::: "memory");
    __syncthreads();
    if (threadIdx.x == 0) {
        unsigned* bar = b.bar;
        __builtin_amdgcn_s_waitcnt(0);
        unsigned nloc = b.st[0], nx = b.st[1];
        if (nloc == 0u) { xcd_barrier_complete(bar, b.x, nloc, nx); b.st[0] = nloc; b.st[1] = nx; }
        const unsigned old = xb_add(&bar[XB_XSUB(b.x)], 1u);
        const unsigned gen = old / nloc;
        if (old + 1u == (gen + 1u) * nloc) {
            __builtin_amdgcn_fence(__ATOMIC_RELEASE, "agent");
            asm volatile("s_waitcnt vmcnt(0)" ::: "memory");
            const unsigned og = xb_add(&bar[XB_TOP], 1u);
            const unsigned tg = og / nx;
            if (og + 1u == (tg + 1u) * nx) xb_add(&bar[XB_TOPGEN], 1u);
            else XB_SPIN(xb_ld(&bar[XB_TOPGEN]) == tg, bar);
            __builtin_amdgcn_fence(__ATOMIC_ACQUIRE, "agent");
            xb_add(&bar[XB_XGEN(b.x)], 1u);
            asm volatile("s_waitcnt vmcnt(0)" ::: "memory");
        } else {
            XB_SPIN(xb_ld(&bar[XB_XGEN(b.x)]) == gen, bar);
            __builtin_amdgcn_fence(__ATOMIC_ACQUIRE, "agent");
            asm volatile("s_waitcnt vmcnt(0)" ::: "memory");
        }
    }
    __syncthreads();
}

__global__ void __launch_bounds__(512, 2) mk_fwd(Args a) {
    extern __shared__ __attribute__((aligned(16))) unsigned char lds[];
    cg::grid_group grid = cg::this_grid();
    const int G = gridDim.x;
    LAS unsigned char* lds3 = (LAS unsigned char*)lds;
    volatile LAS unsigned* misc = (volatile LAS unsigned*)(lds3 + MISC_OFF);
    if (threadIdx.x < 2) misc[threadIdx.x] = 0u;
    __syncthreads();
    XcdBarrier bar = xcd_barrier_post((unsigned*)(WSP() + WS_BAR), misc);
    float* mod = (float*)(WSP() + WS_MOD);
    float* xc = (float*)(WSP() + WS_XC); float* part = (float*)(WSP() + WS_PART);
    bf16_t* H = (bf16_t*)(WSP() + WS_H); bf16_t* O = (bf16_t*)(WSP() + WS_O); bf16_t* P = (bf16_t*)(WSP() + WS_P); bf16_t* A = (bf16_t*)(WSP() + WS_A);
    for (int ph = a.ph_lo; ph < a.ph_hi; ++ph) {
        if (ph == 0) { phase0(a, lds, G); if (REPMASK & 1) { __syncthreads(); phase0(a, lds, G); } }
        else {
            const int layer = (ph - 1) / 10, sub = (ph - 1) % 10;
            const float* mL = mod + (size_t)(layer * 2 + 0) * NMODV; const float* mC = mod + (size_t)(layer * 2 + 1) * NMODV;
            const bool with_ctx = layer == 0;
            if (sub == 0 || sub == 3 || sub == 7) {
                const int k = sub == 0 ? 0 : (sub == 3 ? 1 : 2);
                const bool first = (ph == 1);
                const float* xsrc = (ph <= 3) ? INP(I_X) : OUTP();
                const float* csrc = first ? INP(I_CTX) : xc;
                const bool upd_prev = (sub == 0 && layer == 1);
                const int nsplit = (upd_prev || sub == 3) ? NSPLIT_DOWN : ((sub == 7) ? NSPLIT_OUT : 0);
                const float* cgate = upd_prev ? (mod + (size_t)(0 * 2 + 1) * NMODV + 8 * DM) : (sub == 3 ? mC + 2 * DM : mC + 5 * DM);
                const float ccoef = (sub == 7) ? 1.0f : 0.5f;
                const int nrows = (sub == 7 && !with_ctx) ? SEQ : MT;
                modulate_phase(xsrc, csrc, xc, part, nsplit, cgate, ccoef, INP(I_NORMG) + (size_t)(layer * 3 + k) * DM,
                               mL + (3 * k) * DM, mL + (3 * k + 1) * DM, mC + (3 * k) * DM, mC + (3 * k + 1) * DM, H, nrows, G, lds);
            } else if (sub == 1 || sub == 8) {
                const int f = sub == 1 ? 0 : 1; const int nM = (f == 1 && !with_ctx) ? SEQ / 256 : MT / 256;
                pg8::Gemm g{H, (const bf16_t*)(WSP() + WS_WGU) + (size_t)(layer * 2 + f) * WGU_ELEMS, DM};
                pg8::Sched S; S.init(nM, 2 * FF / 256, DM, G, BID(), 0, 0, 0);
                pg8::EpiSwiGLU E{A, FF};
                pg8::gemm_phase<pg8::EpiSwiGLU, true, true>(lds3, g, S, E);
                if (REPMASK & 2) pg8::gemm_phase<pg8::EpiSwiGLU, true, true>(lds3, g, S, E);
                if (nM == MT / 256) { const int idle = (nM * (2 * FF / 256)) % G;
                    if (G == 256) { if (ph == 2) side_convert(lds, idle, SIDE_Q, 0, SIDE_E0); else if (ph == 9) side_convert(lds, idle, SIDE_Q, SIDE_E1, SIDE_E2); else if (ph == 12) side_convert(lds, idle, SIDE_Q, SIDE_E2, SIDE_E3 < SIDE_END ? SIDE_E3 : SIDE_END); } }
            } else if (sub == 2 || sub == 9) {
                const int f = sub == 2 ? 0 : 1; const bool ctxrows = !(f == 1 && !with_ctx);
                pg8::Gemm g{A, (const bf16_t*)(WSP() + WS_WD) + (size_t)(layer * 2 + f) * WD_ELEMS, FF};
                pg8::Sched S; S.init(SEQ / 256, DM / 256, FF, G, BID(), ctxrows ? NSPLIT_DOWN : 0, NT_SPLIT_DOWN, SEQ / 256);
                pg8::EpiResid E{(ph == 3) ? INP(I_X) : (const float*)OUTP(), OUTP(), mL + (f == 0 ? 2 : 8) * DM, 0.5f, part};
                pg8::gemm_phase<pg8::EpiResid, true, true>(lds3, g, S, E);
                if (REPMASK & 256) { pg8::EpiResid E2{(const float*)P, (float*)P, mL + (f == 0 ? 2 : 8) * DM, 0.5f, part}; pg8::gemm_phase<pg8::EpiResid, true, true>(lds3, g, S, E2); }
            } else if (sub == 4) {
                const int N = layer == 0 ? AB_IN : C_IN;
                pg8::Gemm g{H, (const bf16_t*)(WSP() + (layer == 0 ? WS_WABIN : WS_WGIN)), DM};
                pg8::Sched S; S.init(MT / 256, N / 256, DM, G, BID(), 0, 0, 0);
                pg8::EpiQK E{P, N, layer, layer == 0 ? INP(I_NAQG) : INP(I_GQG), layer == 0 ? INP(I_SWQG) : INP(I_GKG), INP(I_NAKG), INP(I_SWKG), (LAS float*)(lds3 + XCH_OFF)};
                pg8::gemm_phase<pg8::EpiQK, true, true>(lds3, g, S, E);
                if (REPMASK & 16) pg8::gemm_phase<pg8::EpiQK, true, true>(lds3, g, S, E);
                if (G == 256) { if (layer == 0) side_convert(lds, ((MT / 256) * (AB_IN / 256)) % G, SIDE_Q, SIDE_E0, SIDE_E1); else side_convert(lds, ((MT / 256) * (C_IN / 256)) % G, SIDE_Q, SIDE_E3 < SIDE_END ? SIDE_E3 : SIDE_END, SIDE_END); }
            }
            else if (sub == 5) { if (layer == 0) { attn_phase0(a, lds, G); if (REPMASK & 32) attn_phase0(a, lds, G); } else { attn_phase1(a, lds, G); if (REPMASK & 4) attn_phase1(a, lds, G); } }
            else if (sub == 6) {
                pg8::Gemm g{O, (const bf16_t*)(WSP() + (layer == 0 ? WS_WABOUT : WS_WGOUT)), DM};
                pg8::Sched S; S.init(SEQ / 256, DM / 256, DM, G, BID(), with_ctx ? NSPLIT_OUT : 0, NT_SPLIT_OUT, SEQ / 256);
                pg8::EpiResid E{OUTP(), OUTP(), mL + 5 * DM, 1.0f, part};
                pg8::gemm_phase<pg8::EpiResid, true, true>(lds3, g, S, E);
                if (REPMASK & 512) { pg8::EpiResid E2{(const float*)A, (float*)A, mL + 5 * DM, 1.0f, part}; pg8::gemm_phase<pg8::EpiResid, true, true>(lds3, g, S, E2); }
            }
        }
        if (ph + 1 < a.ph_hi) {
            if (a.ph_lo < 0) grid.sync(); else xcd_barrier(bar);
            if (REPMASK & 8) xcd_barrier(bar); }
    }
}

extern "C" void kernel_launch(void* const* d_in, const int* in_sizes, int n_in, void* d_out, int out_size, void* d_ws, size_t ws_size, hipStream_t stream) {
    static int grid = 0;
    if (grid == 0) {
        if (n_in != 22 || out_size != SEQ * DM || ws_size < WS_END) { fprintf(stderr, "kernel_launch: unexpected shapes (n_in %d out %d ws %zu)\n", n_in, out_size, ws_size); grid = -1; return; }
        int dev = 0, cus = 0, per_cu = 0;
        hipGetDevice(&dev); hipDeviceGetAttribute(&cus, hipDeviceAttributeMultiprocessorCount, dev);
        if (hipFuncSetAttribute((const void*)mk_fwd, hipFuncAttributeMaxDynamicSharedMemorySize, LDS_BYTES) != hipSuccess) { fprintf(stderr, "kernel_launch: hipFuncSetAttribute failed\n"); grid = -1; return; }
        if (hipOccupancyMaxActiveBlocksPerMultiprocessor(&per_cu, (const void*)mk_fwd, 512, LDS_BYTES) != hipSuccess || per_cu < 1) { fprintf(stderr, "kernel_launch: occupancy query gave %d\n", per_cu); per_cu = 1; }
        (void)hipGetLastError();
        grid = cus * per_cu;
        if (grid > 256) grid = 256;
    }
    if (grid < 0) return;
    if (hipMemsetAsync((char*)d_ws + WS_BAR, 0, BAR_BYTES, stream) != hipSuccess) { fprintf(stderr, "kernel_launch: memset failed\n"); return; }
    Args a{};
    for (int i = 0; i < 22; ++i) a.in[i] = (const float*)d_in[i];
    a.out = (float*)d_out; a.ws = (unsigned char*)d_ws;
#if MK_MULTI
    for (int p = 0; p < NPHASE; ++p) { a.ph_lo = p; a.ph_hi = p + 1; hipLaunchKernelGGL(mk_fwd, dim3(grid), dim3(512), LDS_BYTES, stream, a); }
#else
    a.ph_lo = 0; a.ph_hi = NPHASE;
    void* args[] = {&a};
    hipError_t e = hipLaunchCooperativeKernel((const void*)mk_fwd, dim3(grid), dim3(512), args, LDS_BYTES, stream);
    if (e != hipSuccess) fprintf(stderr, "cooperative launch failed: %s (grid %d)\n", hipGetErrorString(e), grid);
#endif
}
```

```cpp
#include <hip/hip_runtime.h>
#include <hip/hip_cooperative_groups.h>
#include <cstdio>
#include <cstdint>
namespace cg = cooperative_groups;

#ifndef REPMASK
#define REPMASK 0
#endif
#ifndef MK_MULTI
#define MK_MULTI 0
#endif

constexpr int SEQ = 8192, CTXL = 256, MT = SEQ + CTXL, DM = 2048, FF = 5632, NMODV = 9 * DM;
constexpr int AB_IN = 4608, C_IN = 3072, GRIDW = 64;
constexpr float EPS = 1e-6f;
constexpr int NPHASE = 21;
constexpr int SIDE_Q = 8, SIDE_E0 = 84 * 8 * SIDE_Q, SIDE_E1 = SIDE_E0 + 174 * 8 * SIDE_Q, SIDE_E2 = SIDE_E1 + 84 * 8 * SIDE_Q, SIDE_E3 = SIDE_E2 + 84 * 8 * SIDE_Q, SIDE_E4 = SIDE_E3 + 116 * 8 * SIDE_Q;
constexpr int SIDE_END = SIDE_E4 < 38912 ? SIDE_E4 : 38912;
static_assert(SIDE_E2 >= 3 * 5632 && SIDE_E3 >= 3 * 5632 + 3072 + 2048, "FFN(1,0) must be converted by phase 9, gqa_in / gqa_out by phase 12");
constexpr int NSPLIT_DOWN = 22, NT_SPLIT_DOWN = 4;
constexpr int NSPLIT_OUT = 16, NT_SPLIT_OUT = 2;

constexpr size_t MiB = 1u << 20;
constexpr size_t WS_MOD = 0;
constexpr size_t WS_BAR = 512 * 1024, BAR_BYTES = 16384;
constexpr size_t WS_XC = 1 * MiB;
constexpr size_t WS_PART = 4 * MiB;
constexpr size_t WS_H = 52 * MiB;
constexpr size_t WS_O = 88 * MiB;
constexpr size_t WS_P = 124 * MiB;
constexpr size_t WS_A = 200 * MiB;
constexpr size_t WS_WGU = 292 * MiB;
constexpr size_t WS_WD = 468 * MiB;
constexpr size_t WS_WABIN = 556 * MiB;
constexpr size_t WS_WABOUT = 574 * MiB;
constexpr size_t WS_WGIN = 582 * MiB;
constexpr size_t WS_WGOUT = 594 * MiB;
constexpr size_t WS_END = 602 * MiB;
constexpr size_t WGU_ELEMS = (size_t)2 * FF * DM, WD_ELEMS = (size_t)DM * FF;

constexpr int LDS_BYTES = 143360;
constexpr int XCH_OFF = 131072;
constexpr int MISC_OFF = 141312;

typedef unsigned short bf16_t;
typedef short bf16x8 __attribute__((ext_vector_type(8)));
typedef short s16x4 __attribute__((ext_vector_type(4)));
typedef float f32x4 __attribute__((ext_vector_type(4)));
typedef float f32x2 __attribute__((ext_vector_type(2)));
typedef float f32x16 __attribute__((ext_vector_type(16)));
typedef unsigned u32x4 __attribute__((ext_vector_type(4)));
typedef unsigned u32x2 __attribute__((ext_vector_type(2)));
#define LAS __attribute__((address_space(3)))

__device__ __forceinline__ unsigned cvt_pk_bf16(float lo, float hi) { unsigned r; asm volatile("v_cvt_pk_bf16_f32 %0, %1, %2" : "=v"(r) : "v"(lo), "v"(hi)); return r; }
__device__ __forceinline__ int TID() { int t = threadIdx.x; asm volatile("" : "+v"(t)); return t; }
__device__ __forceinline__ int BID() { int b = blockIdx.x; asm volatile("" : "+s"(b)); return b; }
__device__ __forceinline__ float bf2f(unsigned short b) { return __uint_as_float(((unsigned)b) << 16); }
__device__ __forceinline__ float wave_sum(float v) {
#pragma unroll
    for (int o = 1; o < 64; o <<= 1) v += __shfl_xor(v, o);
    return v;
}

namespace pg8 {
constexpr int BM = 256, BK = 64, HALF = 128, HTB = HALF * BK * 2, STAGE_BYTES = 8 * HTB, NXCD = 8, WGM = 8;
__host__ __device__ __forceinline__ int lds_byte(int r, int c) { const int st = (r >> 4) * 2 + (c >> 5), rr = r & 15, cc = c & 31, ob = rr * 64 + cc * 2; return st * 1024 + (ob ^ (((ob >> 9) & 1) << 5)); }
__host__ __device__ __forceinline__ void stage_rc(int b, int& R, int& C) { const int st = b / 1024, sb = b % 1024, swz = sb ^ (((sb >> 9) & 1) << 5); R = (st >> 1) * 16 + swz / 64; C = (st & 1) * 32 + (swz % 64) / 2; }
__host__ __device__ __forceinline__ int perm32(int rho) { const int n = rho >> 4, i = rho & 15; return 8 * (i >> 2) + 4 * n + (i & 3); }

__host__ __device__ __forceinline__ int permrope(int s) { return 64 * ((s >> 4) & 1) + 16 * (s >> 5) + (s & 15); }
struct Unit { int pm, pn, k0, nt, split; };
struct Gemm { const bf16_t* A; const bf16_t* Bt; int K; };

struct Sched {
    int nM, nN, nwg, G, c, nt_full, nsplit_units, split_nt, split_pm;
    __device__ __forceinline__ void init(int nM_, int nN_, int K, int G_, int c_, int nsplit, int snt, int spm) {
        nM = nM_; nN = nN_; nwg = nM * nN; G = G_; c = c_; nt_full = K / BK; nsplit_units = nsplit * nN_; split_nt = snt; split_pm = spm; }
    __device__ __forceinline__ bool next(int i, Unit& u) const {
        const long L = (long)i * G + c;
        const bool reg = L < nwg; const int s = reg ? 0 : (int)(L - nwg);
        if (!reg && s >= nsplit_units) return false;
        int wgid = reg ? (int)L : 0; { const int q = nwg / NXCD, r = nwg % NXCD, xcd = wgid % NXCD, off = wgid / NXCD; wgid = (xcd < r ? xcd * (q + 1) : r * (q + 1) + (xcd - r) * q) + off; }
        const int nig = WGM * nN, gid = wgid / nig, fm = gid * WGM, gsz = (nM - fm) < WGM ? (nM - fm) : WGM;
        const int pm_r = fm + ((wgid % nig) % gsz), pn_r = (wgid % nig) / gsz;
        const int pn_s = s % nN, sp_s = s / nN;
        u.pm = __builtin_amdgcn_readfirstlane(reg ? pm_r : split_pm); u.pn = __builtin_amdgcn_readfirstlane(reg ? pn_r : pn_s);
        u.split = __builtin_amdgcn_readfirstlane(reg ? -1 : sp_s); u.k0 = __builtin_amdgcn_readfirstlane(reg ? 0 : sp_s * split_nt); u.nt = __builtin_amdgcn_readfirstlane(reg ? nt_full : split_nt);
        return true;
    }
};

__device__ __forceinline__ float silu_mul(float g, float u) { const float e = __builtin_amdgcn_exp2f(-g * 1.4426950408889634f); return g * __builtin_amdgcn_rcpf(1.0f + e) * u; }
struct EpiSwiGLU {
    static constexpr int PERM = 1;
    bf16_t* O; int ldc;
    __device__ __forceinline__ void operator()(const f32x4 (&acc)[2][2][4][2], const Unit& u, int wr, int wc, int fr, int fq) const {
        asm volatile("" : "+v"(fr), "+v"(fq));
        const int row0 = u.pm * BM + wr * 64 + fr; const int col0 = u.pn * HALF + wc * 32 + 8 * fq;
#pragma unroll
        for (int ai = 0; ai < 2; ++ai)
#pragma unroll
            for (int m = 0; m < 4; ++m) { bf16_t* rowp = O + (size_t)(row0 + ai * HALF + m * 16) * ldc + col0;
                const f32x4 g0 = acc[ai][0][m][0], g1 = acc[ai][0][m][1], u0 = acc[ai][1][m][0], u1 = acc[ai][1][m][1];
                u32x4 w; w.x = cvt_pk_bf16(silu_mul(g0[0], u0[0]), silu_mul(g0[1], u0[1])); w.y = cvt_pk_bf16(silu_mul(g0[2], u0[2]), silu_mul(g0[3], u0[3]));
                w.z = cvt_pk_bf16(silu_mul(g1[0], u1[0]), silu_mul(g1[1], u1[1])); w.w = cvt_pk_bf16(silu_mul(g1[2], u1[2]), silu_mul(g1[3], u1[3]));
                *(u32x4*)rowp = w; }
    }
};
struct EpiResid {
    static constexpr int PERM = 0;
    const float* Xs; float* X; const float* gate; float coef; float* part;
    __device__ __forceinline__ void operator()(const f32x4 (&acc)[2][2][4][2], const Unit& u, int wr, int wc, int fr, int fq) const {
        asm volatile("" : "+v"(fr), "+v"(fq));
        const int col0 = u.pn * BM + wc * 32 + 4 * fq;
        if (u.split < 0) {
            f32x4 gv[2][2];
#pragma unroll
            for (int bj = 0; bj < 2; ++bj)
#pragma unroll
                for (int n = 0; n < 2; ++n) gv[bj][n] = *(const f32x4*)(gate + col0 + bj * HALF + n * 16) * coef;
#pragma unroll
            for (int ai = 0; ai < 2; ++ai)
#pragma unroll
                for (int mh = 0; mh < 1; ++mh) {
                    f32x4 xv[4][2][2];
#pragma unroll
                    for (int mm = 0; mm < 4; ++mm) { const int m = mh * 4 + mm; const float* rows = Xs + (size_t)(u.pm * BM + ai * HALF + wr * 64 + m * 16 + fr) * DM + col0;
#pragma unroll
                        for (int bj = 0; bj < 2; ++bj)
#pragma unroll
                            for (int n = 0; n < 2; ++n) xv[mm][bj][n] = *(const f32x4*)(rows + bj * HALF + n * 16); }
#pragma unroll
                    for (int mm = 0; mm < 4; ++mm) { const int m = mh * 4 + mm; float* rowp = X + (size_t)(u.pm * BM + ai * HALF + wr * 64 + m * 16 + fr) * DM + col0;
#pragma unroll
                        for (int bj = 0; bj < 2; ++bj)
#pragma unroll
                            for (int n = 0; n < 2; ++n) *(f32x4*)(rowp + bj * HALF + n * 16) = xv[mm][bj][n] + gv[bj][n] * acc[ai][bj][m][n]; }
                    asm volatile("" ::: "memory"); }
        } else {
            float* base = part + (size_t)u.split * 256 * DM;
#pragma unroll
            for (int ai = 0; ai < 2; ++ai)
#pragma unroll
                for (int m = 0; m < 4; ++m) { float* rowp = base + (size_t)(ai * HALF + wr * 64 + m * 16 + fr) * DM + col0;
#pragma unroll
                    for (int bj = 0; bj < 2; ++bj)
#pragma unroll
                        for (int n = 0; n < 2; ++n) *(f32x4*)(rowp + bj * HALF + n * 16) = acc[ai][bj][m][n]; }
        }
    }
};

__device__ __forceinline__ void store_pair16(bf16_t* p, u32x2 w1, u32x2 w2, int fq) {
    auto rx = __builtin_amdgcn_permlane16_swap(w1.x, w2.x, false, false); auto ry = __builtin_amdgcn_permlane16_swap(w1.y, w2.y, false, false);
    u32x4 o; o.x = rx[0]; o.y = ry[0]; o.z = rx[1]; o.w = ry[1];
    *(u32x4*)(p + ((fq & 1) ? 60 : 0)) = o;
}
struct EpiQK {
    static constexpr int PERM = 2;
    bf16_t* O; int ldc; int layer; const float* g0; const float* g1; const float* g2; const float* g3; LAS float* xch;
    __device__ __forceinline__ void operator()(const f32x4 (&acc)[2][2][4][2], const Unit& u, int wr, int wc, int fr, int fq) const {
        asm volatile("" : "+v"(fr), "+v"(fq));
        const int pn = u.pn;
        const float* const q0 = g0; const float* const q1 = g1; const float* const q2 = g2; const float* const q3 = g3; const int lay = layer;
        const int kind0 = (pn < 4) ? 1 : ((pn < 8) ? 2 : ((pn < 12) ? 1 : ((pn == 16) ? 2 : 0))), kind1 = (pn < 10) ? 2 : 0;
        const float* const gain0 = (pn < 4) ? q0 : ((pn < 8) ? q1 : ((pn < 12) ? q2 : q3)); const float* const gain1 = (pn < 8) ? q0 : q1;
        const int kind = lay == 0 ? kind0 : kind1; const float* const gain = lay == 0 ? gain0 : gain1;
        const bool latent = u.pm < SEQ / 256;
        const int dl = 16 * wc + 4 * fq;
        bf16_t* obase = O + (size_t)(u.pm * BM + wr * 64 + fr) * ldc + pn * BM + dl;
        if (kind == 0) {
#pragma unroll
            for (int ai = 0; ai < 2; ++ai)
#pragma unroll
                for (int m = 0; m < 4; ++m)
#pragma unroll
                    for (int bj = 0; bj < 2; ++bj) { bf16_t* p = obase + (size_t)(ai * HALF + m * 16) * ldc + bj * HALF; const f32x4 x1 = acc[ai][bj][m][0], x2 = acc[ai][bj][m][1];
                        u32x2 w1, w2; w1.x = cvt_pk_bf16(x1[0], x1[1]); w1.y = cvt_pk_bf16(x1[2], x1[3]); w2.x = cvt_pk_bf16(x2[0], x2[1]); w2.y = cvt_pk_bf16(x2[2], x2[3]);
                        store_pair16(p, w1, w2, fq); }
            return;
        }
        LAS float* xr = xch + ((wr * 128 + fr) * 8 + wc);
#pragma unroll
        for (int ai = 0; ai < 2; ++ai)
#pragma unroll
            for (int m = 0; m < 4; ++m)
#pragma unroll
                for (int bj = 0; bj < 2; ++bj) { const f32x4 x1 = acc[ai][bj][m][0], x2 = acc[ai][bj][m][1];
                    float s = (x1[0] * x1[0] + x1[1] * x1[1]) + (x1[2] * x1[2] + x1[3] * x1[3]) + (x2[0] * x2[0] + x2[1] * x2[1]) + (x2[2] * x2[2] + x2[3] * x2[3]);
                    { auto r16 = __builtin_amdgcn_permlane16_swap(__float_as_uint(s), __float_as_uint(s), false, false); s = __uint_as_float(r16[0]) + __uint_as_float(r16[1]); }
                    { auto r32 = __builtin_amdgcn_permlane32_swap(__float_as_uint(s), __float_as_uint(s), false, false); s = __uint_as_float(r32[0]) + __uint_as_float(r32[1]); }
                    if (fq == 0) xr[(ai * 64 + m * 16) * 8 + bj * 4] = s; }
        const f32x4 ga = *(const f32x4*)(gain + dl), gb = *(const f32x4*)(gain + 64 + dl);
        asm volatile("s_waitcnt lgkmcnt(0)" ::: "memory"); __builtin_amdgcn_s_barrier(); asm volatile("" ::: "memory");
        const bool rope = (kind == 2) && latent;
        float cc[2][4], sc[2][4], cd[4], sd[4];
#pragma unroll
        for (int j = 0; j < 4; ++j) { cc[0][j] = 1.f; cc[1][j] = 1.f; sc[0][j] = 0.f; sc[1][j] = 0.f; cd[j] = 1.f; sd[j] = 0.f; }
        if (rope) {
#pragma unroll
            for (int j = 0; j < 4; ++j) {
                const float inv = __builtin_amdgcn_exp2f(-(float)((dl + j) & 31) * (13.287712379549449f / 32.0f)) * 0.15915494309189535f;
                if (wc < 2) {
#pragma unroll
                    for (int ai = 0; ai < 2; ++ai) { float rv = (float)((u.pm * BM + ai * HALF + wr * 64) >> 6) * inv; rv -= floorf(rv); sc[ai][j] = __builtin_amdgcn_sinf(rv); cc[ai][j] = __builtin_amdgcn_cosf(rv); }
                } else {
                    float rv = (float)fr * inv; rv -= floorf(rv); const float s0 = __builtin_amdgcn_sinf(rv), c0 = __builtin_amdgcn_cosf(rv);
                    sc[0][j] = s0; sc[1][j] = s0; cc[0][j] = c0; cc[1][j] = c0;
                    float rd = 16.0f * inv; rd -= floorf(rd); sd[j] = __builtin_amdgcn_sinf(rd); cd[j] = __builtin_amdgcn_cosf(rd);
                }
            }
        }
#pragma unroll
        for (int m = 0; m < 4; ++m) {
#pragma unroll
            for (int ai = 0; ai < 2; ++ai)
#pragma unroll
                for (int bj = 0; bj < 2; ++bj) {
                    const f32x4 pr = *(const LAS f32x4*)(xch + ((wr * 128 + ai * 64 + m * 16 + fr) * 8 + bj * 4));
                    const float rstd = __builtin_amdgcn_rsqf(((pr[0] + pr[1]) + (pr[2] + pr[3])) * (1.0f / 128.0f) + EPS);
                    const f32x4 x1 = acc[ai][bj][m][0] * rstd * ga, x2 = acc[ai][bj][m][1] * rstd * gb;
                    float y1[4], y2[4];
#pragma unroll
                    for (int j = 0; j < 4; ++j) { y1[j] = x1[j] * cc[ai][j] - x2[j] * sc[ai][j]; y2[j] = x1[j] * sc[ai][j] + x2[j] * cc[ai][j]; }
                    bf16_t* p = obase + (size_t)(ai * HALF + m * 16) * ldc + bj * HALF;
                    u32x2 w1, w2; w1.x = cvt_pk_bf16(y1[0], y1[1]); w1.y = cvt_pk_bf16(y1[2], y1[3]); w2.x = cvt_pk_bf16(y2[0], y2[1]); w2.y = cvt_pk_bf16(y2[2], y2[3]);
                    store_pair16(p, w1, w2, fq); }
            if (rope && wc >= 2) {
#pragma unroll
                for (int ai = 0; ai < 2; ++ai)
#pragma unroll
                    for (int j = 0; j < 4; ++j) { const float c = cc[ai][j], s = sc[ai][j]; cc[ai][j] = c * cd[j] - s * sd[j]; sc[ai][j] = s * cd[j] + c * sd[j]; }
            }
        }
    }
};

template <class Epi, bool ALIGN_EPI, bool SP2>
__device__ __forceinline__ void gemm_phase(LAS unsigned char* lds, const Gemm g, const Sched& S, const Epi& E) {
    const int tid = TID(), wid = __builtin_amdgcn_readfirstlane(tid >> 6), lane = tid & 63, wr = wid >> 2, wc = wid & 3, fr = lane & 15, fq = lane >> 4;
    const int K = g.K;
    unsigned voffA[2], voffB[2];
#pragma unroll
    for (int i = 0; i < 2; ++i) { int R, C; stage_rc(tid * 16 + i * 8192, R, C); const int Rb = Epi::PERM == 1 ? ((R & ~31) + perm32(R & 31)) : (Epi::PERM == 2 ? ((R & ~127) + permrope(R & 127)) : R);
        voffA[i] = (unsigned)(R * K + C) * 2u; voffB[i] = (unsigned)(Rb * K + C) * 2u; }
    const size_t kstep = (size_t)(BK * 2);
    const size_t hstep = (size_t)HALF * K * 2;
    const size_t tstep = 2 * hstep;
    const unsigned ldsw = (unsigned)wid * 1024u;
    const int aoff = lds_byte(wr * 64 + fr, fq * 8), boff = lds_byte(wc * 32 + fr, fq * 8);
#define PG8_SA(b, h) (((b) * 2 + (h)) * HTB)
#define PG8_SB(b, h) ((4 + (b) * 2 + (h)) * HTB)
#define PG8_STAGE(bufoff, gbase, voff) do { _Pragma("unroll") for (int _i = 0; _i < 2; ++_i) \
        __builtin_amdgcn_global_load_lds((const unsigned*)((const char*)(gbase) + (voff)[_i]), (LAS unsigned*)(lds + (bufoff) + ldsw + _i * 8192), 16, 0, 0); } while (0)
#define PG8_LDA(dst, b, h) do { _Pragma("unroll") for (int m = 0; m < 4; ++m) _Pragma("unroll") for (int k = 0; k < 2; ++k) dst[m][k] = *(const LAS bf16x8*)(lds + PG8_SA(b, h) + aoff + m * 2048 + k * 1024); } while (0)
#define PG8_LDB(dst, b, h) do { _Pragma("unroll") for (int n = 0; n < 2; ++n) _Pragma("unroll") for (int k = 0; k < 2; ++k) dst[n][k] = *(const LAS bf16x8*)(lds + PG8_SB(b, h) + boff + n * 2048 + k * 1024); } while (0)
#define PG8_MMA(ai, bj, At, Bt) do { __builtin_amdgcn_s_setprio(1); _Pragma("unroll") for (int m = 0; m < 4; ++m) _Pragma("unroll") for (int n = 0; n < 2; ++n) _Pragma("unroll") for (int k = 0; k < 2; ++k) \
        acc[ai][bj][m][n] = __builtin_amdgcn_mfma_f32_16x16x32_bf16(Bt[n][k], At[m][k], acc[ai][bj][m][n], 0, 0, 0); __builtin_amdgcn_s_setprio(0); } while (0)
#define PG8_WAIT_V(n) asm volatile("s_waitcnt vmcnt(" #n ")" ::: "memory")
#define PG8_WAIT_L(n) asm volatile("s_waitcnt lgkmcnt(" #n ")" ::: "memory")
#define PG8_BAR __builtin_amdgcn_s_barrier()
#define PG8_SCHED __builtin_amdgcn_sched_barrier(0)
    Unit cur, nxt; int ui = 0;
    if (!S.next(0, cur)) return;
    f32x4 acc[2][2][4][2];
#pragma unroll
    for (int a = 0; a < 2; ++a)
#pragma unroll
        for (int b = 0; b < 2; ++b)
#pragma unroll
            for (int m = 0; m < 4; ++m)
#pragma unroll
                for (int n = 0; n < 2; ++n) acc[a][b][m][n] = (f32x4){0.f, 0.f, 0.f, 0.f};
    bf16x8 At[4][2], B0[2][2], B1[2][2];
    const char* cA = (const char*)g.A + (size_t)cur.pm * tstep + (size_t)cur.k0 * kstep; const char* cB = (const char*)g.Bt + (size_t)cur.pn * tstep + (size_t)cur.k0 * kstep;
    if constexpr (SP2) {
        PG8_STAGE(PG8_SB(0, 0), cB, voffB); PG8_STAGE(PG8_SB(0, 1), cB + hstep, voffB); PG8_STAGE(PG8_SA(0, 0), cA, voffA); PG8_STAGE(PG8_SA(0, 1), cA + hstep, voffA);
        if (wr == 1) PG8_BAR;
        PG8_WAIT_V(2); PG8_BAR;
        PG8_STAGE(PG8_SB(1, 0), cB + kstep, voffB); PG8_STAGE(PG8_SA(1, 0), cA + kstep, voffA); PG8_STAGE(PG8_SB(1, 1), cB + hstep + kstep, voffB);
        PG8_WAIT_V(6); PG8_BAR;
    } else {
        PG8_STAGE(PG8_SB(0, 0), cB, voffB); PG8_STAGE(PG8_SA(0, 0), cA, voffA); PG8_STAGE(PG8_SB(0, 1), cB + hstep, voffB); PG8_STAGE(PG8_SA(0, 1), cA + hstep, voffA);
        if (wr == 1) PG8_BAR;
        PG8_WAIT_V(4); PG8_BAR;
        PG8_STAGE(PG8_SB(1, 0), cB + kstep, voffB); PG8_STAGE(PG8_SA(1, 0), cA + kstep, voffA); PG8_STAGE(PG8_SB(1, 1), cB + hstep + kstep, voffB);
        PG8_WAIT_V(6); PG8_BAR;
    }
    for (;;) {
        const bool has_next = S.next(ui + 1, nxt);
        const int nt = cur.nt;
        const char* nA = has_next ? (const char*)g.A + (size_t)nxt.pm * tstep + (size_t)nxt.k0 * kstep : cA; const char* nB = has_next ? (const char*)g.Bt + (size_t)nxt.pn * tstep + (size_t)nxt.k0 * kstep : cB;
        for (int t = 0; t < nt; t += 2) {
            const bool last = (t == nt - 2);
            const char* a1 = cA + (size_t)(t + 1) * kstep;
            const char* a2 = last ? nA : cA + (size_t)(t + 2) * kstep; const char* b2 = last ? nB : cB + (size_t)(t + 2) * kstep;
            const char* a3 = a2 + kstep; const char* b3 = b2 + kstep;
            if constexpr (SP2) {
            PG8_LDB(B0, 0, 0); PG8_LDB(B1, 0, 1); PG8_SCHED; PG8_LDA(At, 0, 0); PG8_STAGE(PG8_SA(1, 1), a1 + hstep, voffA);
            PG8_WAIT_V(8); PG8_WAIT_L(0); PG8_BAR; PG8_MMA(0, 0, At, B0); PG8_MMA(0, 1, At, B1); PG8_BAR; PG8_SCHED;
            PG8_LDA(At, 0, 1); PG8_STAGE(PG8_SB(0, 0), b2, voffB); PG8_STAGE(PG8_SB(0, 1), b2 + hstep, voffB); PG8_STAGE(PG8_SA(0, 0), a2, voffA);
            PG8_WAIT_V(8); PG8_WAIT_L(0); PG8_BAR; PG8_MMA(1, 0, At, B0); PG8_MMA(1, 1, At, B1); PG8_BAR; PG8_SCHED;
            PG8_LDB(B0, 1, 0); PG8_LDB(B1, 1, 1); PG8_SCHED; PG8_LDA(At, 1, 0); PG8_STAGE(PG8_SA(0, 1), a2 + hstep, voffA);
            PG8_WAIT_V(8); PG8_WAIT_L(0); PG8_BAR; PG8_MMA(0, 0, At, B0); PG8_MMA(0, 1, At, B1); PG8_BAR; PG8_SCHED;
            PG8_LDA(At, 1, 1); PG8_STAGE(PG8_SB(1, 0), b3, voffB); PG8_STAGE(PG8_SB(1, 1), b3 + hstep, voffB); PG8_STAGE(PG8_SA(1, 0), a3, voffA);
            PG8_WAIT_V(8); PG8_WAIT_L(0); PG8_BAR; PG8_MMA(1, 0, At, B0); PG8_MMA(1, 1, At, B1); PG8_BAR; PG8_SCHED;
            } else {
            PG8_LDB(B0, 0, 0); PG8_SCHED; PG8_LDA(At, 0, 0); PG8_STAGE(PG8_SA(1, 1), a1 + hstep, voffA);
            PG8_WAIT_L(8); PG8_BAR; PG8_WAIT_L(0); PG8_MMA(0, 0, At, B0); PG8_BAR; PG8_SCHED;
            PG8_LDB(B1, 0, 1); PG8_STAGE(PG8_SB(0, 0), b2, voffB);
            PG8_BAR; PG8_WAIT_L(0); PG8_MMA(0, 1, At, B1); PG8_BAR;
            PG8_LDA(At, 0, 1); PG8_STAGE(PG8_SA(0, 0), a2, voffA);
            PG8_BAR; PG8_WAIT_L(0); PG8_MMA(1, 0, At, B0); PG8_BAR; PG8_SCHED;
            PG8_STAGE(PG8_SB(0, 1), b2 + hstep, voffB);
            PG8_WAIT_V(6); PG8_BAR; PG8_MMA(1, 1, At, B1); PG8_BAR;
            PG8_LDB(B0, 1, 0); PG8_SCHED; PG8_LDA(At, 1, 0); PG8_STAGE(PG8_SA(0, 1), a2 + hstep, voffA);
            PG8_WAIT_L(8); PG8_BAR; PG8_WAIT_L(0); PG8_MMA(0, 0, At, B0); PG8_BAR; PG8_SCHED;
            PG8_LDB(B1, 1, 1); PG8_STAGE(PG8_SB(1, 0), b3, voffB);
            PG8_BAR; PG8_WAIT_L(0); PG8_MMA(0, 1, At, B1); PG8_BAR;
            PG8_LDA(At, 1, 1); PG8_STAGE(PG8_SA(1, 0), a3, voffA);
            PG8_BAR; PG8_WAIT_L(0); PG8_MMA(1, 0, At, B0); PG8_BAR; PG8_SCHED;
            PG8_STAGE(PG8_SB(1, 1), b3 + hstep, voffB);
            PG8_WAIT_V(6); PG8_BAR; PG8_MMA(1, 1, At, B1); PG8_BAR;
            }
        }
        if constexpr (ALIGN_EPI) { if (wr == 0) PG8_BAR; }
        E(acc, cur, wr, wc, fr, fq);
        if (!has_next) break;
#pragma unroll
        for (int a = 0; a < 2; ++a)
#pragma unroll
            for (int b = 0; b < 2; ++b)
#pragma unroll
                for (int m = 0; m < 4; ++m)
#pragma unroll
                    for (int n = 0; n < 2; ++n) acc[a][b][m][n] = (f32x4){0.f, 0.f, 0.f, 0.f};
        cur = nxt; cA = nA; cB = nB; ++ui;
        if constexpr (ALIGN_EPI) { if (wr == 1) PG8_BAR; }
    }
    PG8_WAIT_V(0);
    if constexpr (!ALIGN_EPI) { if (wr == 0) PG8_BAR; }
    PG8_BAR;
#undef PG8_SA
#undef PG8_SB
#undef PG8_STAGE
#undef PG8_LDA
#undef PG8_LDB
#undef PG8_MMA
#undef PG8_WAIT_V
#undef PG8_WAIT_L
#undef PG8_BAR
#undef PG8_SCHED
}
}

namespace att {
constexpr int D = 128, NW = 8, QBLK = 32, KVBLK = 64;
constexpr float SCALE = 0.088388347648318440f;
constexpr float INV_SCALE = 11.313708498984761f;
constexpr float THR = 8.f;
constexpr float NEG = -1e30f;
constexpr size_t SHM_V = KVBLK * D * 2, SHM_K = KVBLK * D * 2, SHM_ATTN = 2 * SHM_V + 2 * SHM_K + NW * 64 * 4;
constexpr int BIAS_OFF = (int)SHM_ATTN;
enum { DENSE = 0, NA = 1, SW = 2 };
#define KSWZ(row, colB) ((row) * 256 + ((colB) ^ (((row) & 7) << 4)))
#define SBAR() __builtin_amdgcn_sched_barrier(0)
__device__ __forceinline__ int crow(int r, int hi) { return (r & 3) + 8 * (r >> 2) + 4 * hi; }

__device__ __forceinline__ void partialSM(f32x16& p0, f32x16& p1, float& m_reg, float& mn, float& alpha) {
  constexpr float C = SCALE * 1.4426950408889634f;
  float pmax = p0[0];
#pragma unroll
  for (int r = 1; r < 16; ++r) pmax = fmaxf(pmax, p0[r]);
#pragma unroll
  for (int r = 0; r < 16; ++r) pmax = fmaxf(pmax, p1[r]);
  { auto rr = __builtin_amdgcn_permlane32_swap(__float_as_uint(pmax), __float_as_uint(pmax), false, false);
    pmax = fmaxf(__uint_as_float(rr[0]), __uint_as_float(rr[1])); }
  if (__builtin_expect(__all(pmax - m_reg <= THR / SCALE), 1)) { mn = m_reg; alpha = 1.f; }
  else { mn = fmaxf(m_reg, pmax); alpha = __builtin_amdgcn_exp2f((m_reg - mn) * C); m_reg = mn; }
  float mnC = -mn * C;
#pragma unroll
  for (int r = 0; r < 16; ++r) p0[r] = fmaf(p0[r], C, mnC);
#pragma unroll
  for (int r = 0; r < 16; ++r) p1[r] = fmaf(p1[r], C, mnC);
#pragma unroll
  for (int r = 0; r < 16; ++r) p0[r] = __builtin_amdgcn_exp2f(p0[r]);
}
__device__ __forceinline__ void finishSM(f32x16& p0, f32x16& p1, float alpha, float& l_reg, bf16x8& pa0, bf16x8& pa1, bf16x8& pa2, bf16x8& pa3) {
#pragma unroll
  for (int r = 0; r < 16; ++r) p1[r] = __builtin_amdgcn_exp2f(p1[r]);
  float ps = 0;
#pragma unroll
  for (int r = 0; r < 16; ++r) ps += p0[r];
#pragma unroll
  for (int r = 0; r < 16; ++r) ps += p1[r];
  { auto rr = __builtin_amdgcn_permlane32_swap(__float_as_uint(ps), __float_as_uint(ps), false, false);
    ps = __uint_as_float(rr[0]) + __uint_as_float(rr[1]); }
  l_reg = l_reg * alpha + ps;
#define PK4(P, BASE, OUT) do { unsigned a0 = cvt_pk_bf16(P[BASE + 0], P[BASE + 1]), a1 = cvt_pk_bf16(P[BASE + 2], P[BASE + 3]);   \
    unsigned b0 = cvt_pk_bf16(P[BASE + 4], P[BASE + 5]), b1 = cvt_pk_bf16(P[BASE + 6], P[BASE + 7]);                              \
    auto r0 = __builtin_amdgcn_permlane32_swap(a0, b0, false, false); auto r1 = __builtin_amdgcn_permlane32_swap(a1, b1, false, false); \
    u32x4 w = {r0[0], r1[0], r0[1], r1[1]}; OUT = *reinterpret_cast<bf16x8*>(&w); } while (0)
  PK4(p0, 0, pa0); PK4(p0, 8, pa1); PK4(p1, 0, pa2); PK4(p1, 8, pa3);
#undef PK4
}
__device__ __forceinline__ void qkt(f32x16& p0, f32x16& p1, const bf16_t* Ks, const bf16x8* qr, int r32, int hi) {
  p0 = f32x16{}; p1 = f32x16{};
#pragma unroll
  for (int d0 = 0; d0 < 8; ++d0) { int cb = (d0 * 16 + hi * 8) * 2;
    bf16x8 b0 = *reinterpret_cast<const bf16x8*>((const char*)Ks + KSWZ(r32, cb));
    bf16x8 b1 = *reinterpret_cast<const bf16x8*>((const char*)Ks + KSWZ(32 + r32, cb));
    p0 = __builtin_amdgcn_mfma_f32_32x32x16_bf16(b0, qr[d0], p0, 0, 0, 0);
    p1 = __builtin_amdgcn_mfma_f32_32x32x16_bf16(b1, qr[d0], p1, 0, 0, 0); }
}
__device__ __forceinline__ int v_st(int k, int c) { const int kk = (k & ~0xC) | ((k & 4) << 1) | ((k & 8) >> 1); return ((kk >> 3) * 4 + (c >> 5)) * 512 + ((kk & 7) * 32 + (c & 31)) * 2; }
__device__ __forceinline__ int v_rd_base(int lane) { return ((lane & 3) << 3) | (((lane >> 2) & 3) << 6) | (((lane >> 4) & 1) << 5) | (((lane >> 5) & 1) << 8); }
constexpr int v_rd_off(int d0, int ks, int half) { return d0 * 512 + ks * 4096 + half * 2048; }
template <int OFF> __device__ __forceinline__ s16x4 tr_read(int vb) {
  s16x4 r; asm volatile("ds_read_b64_tr_b16 %0, %1 offset:%2" : "=&v"(r) : "v"(vb), "i"(OFF) : "memory"); return r;
}
template <int D0> __device__ __forceinline__ void pv_one(f32x16& od, int vb, bf16x8 pa0, bf16x8 pa1, bf16x8 pa2, bf16x8 pa3) {
  const s16x4 l0 = tr_read<v_rd_off(D0, 0, 0)>(vb), h0 = tr_read<v_rd_off(D0, 0, 1)>(vb), l1 = tr_read<v_rd_off(D0, 1, 0)>(vb), h1 = tr_read<v_rd_off(D0, 1, 1)>(vb);
  const s16x4 l2 = tr_read<v_rd_off(D0, 2, 0)>(vb), h2 = tr_read<v_rd_off(D0, 2, 1)>(vb), l3 = tr_read<v_rd_off(D0, 3, 0)>(vb), h3 = tr_read<v_rd_off(D0, 3, 1)>(vb);
  asm volatile("s_waitcnt lgkmcnt(0)" ::: "memory"); SBAR();
#define PK(L, H) (bf16x8){L[0], L[1], L[2], L[3], H[0], H[1], H[2], H[3]}
  od = __builtin_amdgcn_mfma_f32_32x32x16_bf16(pa0, PK(l0, h0), od, 0, 0, 0);
  od = __builtin_amdgcn_mfma_f32_32x32x16_bf16(pa1, PK(l1, h1), od, 0, 0, 0);
  od = __builtin_amdgcn_mfma_f32_32x32x16_bf16(pa2, PK(l2, h2), od, 0, 0, 0);
  od = __builtin_amdgcn_mfma_f32_32x32x16_bf16(pa3, PK(l3, h3), od, 0, 0, 0);
#undef PK
}
__device__ __forceinline__ void pv_d0(f32x16* o, int vb, bf16x8 pa0, bf16x8 pa1, bf16x8 pa2, bf16x8 pa3) {
  pv_one<0>(o[0], vb, pa0, pa1, pa2, pa3); pv_one<1>(o[1], vb, pa0, pa1, pa2, pa3); pv_one<2>(o[2], vb, pa0, pa1, pa2, pa3); pv_one<3>(o[3], vb, pa0, pa1, pa2, pa3);
}

struct UnitP { const bf16_t* Q; const bf16_t* K; const bf16_t* V; bf16_t* O; int ldq, ldk, ldo, NT, base_row, qb; float sink_l2e; };

template <int MODE> __device__ __forceinline__ int tile_row0(const UnitP& u, int t) {
  if (MODE == DENSE) return u.base_row + KVBLK * t;
  if (t < 4) return SEQ + KVBLK * t;
  if (MODE == NA) { int R0 = 4 * u.qb - 4; R0 = R0 < 0 ? 0 : (R0 > 120 ? 120 : R0); int kr = R0 + t - 4; kr = kr > 127 ? 127 : kr; return kr * 64; }
  int k0 = 256 * u.qb - 128 + 64 * (t - 4); k0 = k0 < 0 ? 0 : (k0 > SEQ - 64 ? SEQ - 64 : k0); return k0;
}
template <int MODE> __device__ __forceinline__ void mask_tile(f32x16& p0, f32x16& p1, const UnitP& u, int t, int wid, int r32, int hi, const float* biasL) {
  if (MODE == DENSE) return;
  if (t < 4) return;
  if (MODE == SW) {
    const int kpos0 = 256 * u.qb - 128 + 64 * (t - 4); int qpos = 256 * u.qb + wid * 32 + r32; int hi_ = hi;
    asm volatile("" : "+v"(qpos), "+v"(hi_));
#pragma unroll
    for (int r = 0; r < 16; ++r) { const int k0 = kpos0 + crow(r, hi_), k1 = k0 + 32; const int d0 = k0 - qpos, d1 = k1 - qpos;
      const bool v0 = (k0 >= 0) && (k0 < SEQ) && (d0 <= 128) && (d0 >= -128); const bool v1 = (k1 >= 0) && (k1 < SEQ) && (d1 <= 128) && (d1 >= -128);
      p0[r] = v0 ? p0[r] : NEG; p1[r] = v1 ? p1[r] : NEG; }
  } else {
    int R0 = 4 * u.qb - 4; R0 = R0 < 0 ? 0 : (R0 > 120 ? 120 : R0); const int kr = R0 + t - 4;
    const int rq = 4 * u.qb + (wid >> 1); int rs = rq - 4; rs = rs < 0 ? 0 : (rs > 120 ? 120 : rs);
    const bool rowvalid = (kr >= rs) && (kr < rs + 8);
    if (!rowvalid) {
#pragma unroll
      for (int r = 0; r < 16; ++r) { p0[r] = NEG; p1[r] = NEG; }
      return; }
    int cq = (wid & 1) * 32 + r32; int hi_ = hi;
    asm volatile("" : "+v"(cq), "+v"(hi_));
    int cs = cq - 8; cs = cs < 0 ? 0 : (cs > 48 ? 48 : cs);
    int brow = kr - rq + 7; brow = brow < 0 ? 0 : (brow > 14 ? 14 : brow);
    const float* bl = biasL + brow * 31 + 15 - cq;
#pragma unroll
    for (int r = 0; r < 16; ++r) { const int k0 = crow(r, hi_), k1 = k0 + 32;
      const bool v0 = rowvalid && (k0 >= cs) && (k0 < cs + 16); const bool v1 = rowvalid && (k1 >= cs) && (k1 < cs + 16);
      int i0 = k0 - cq; i0 = i0 < -15 ? -15 : (i0 > 15 ? 15 : i0); int i1 = k1 - cq; i1 = i1 < -15 ? -15 : (i1 > 15 ? 15 : i1);
      const float b0 = bl[cq + i0], b1 = bl[cq + i1];
      p0[r] = v0 ? p0[r] + b0 : NEG; p1[r] = v1 ? p1[r] + b1 : NEG;
      SBAR(); }
  }
}

template <int MODE, int SDEPTH>
__device__ __forceinline__ void attn_unit(const UnitP& u, char* lds) {
  const int tid = TID(), wid = tid >> 6, lane = tid & 63, r32 = lane & 31, hi = lane >> 5;
  bf16_t* V_lds = (bf16_t*)lds; bf16_t* K_lds = (bf16_t*)(lds + 2 * SHM_V);
  float* ws = (float*)(lds + 2 * SHM_V + 2 * SHM_K) + wid * 64; float* li_l = ws; float* al_l = ws + 32;
  const float* biasL = (const float*)(lds + BIAS_OFF);
  const bf16_t* __restrict__ Kh = u.K; const bf16_t* __restrict__ Vh = u.V; const int LDK = u.ldk;
  float m_reg = -1e30f, l_reg = 0; f32x16 o[4] = {}; bf16x8 qr[8];
  const bf16_t* Qw = u.Q + (long)(wid * QBLK + r32) * u.ldq + hi * 8;
#pragma unroll
  for (int d0 = 0; d0 < 8; ++d0) qr[d0] = *reinterpret_cast<const bf16x8*>(Qw + d0 * 16);
  const int vb0 = (int)(uintptr_t)V_lds + v_rd_base(lane);
  struct { bf16x8 vs0, vs1, ks0, ks1; } sr_[SDEPTH];
#define SLOAD(i, k0) do { int t_ = tid; if (MODE != DENSE) asm volatile("" : "+v"(t_)); const int sr = t_ >> 4, sc = (t_ & 15) * 8; \
    const long _r0 = (long)((k0) + sr) * LDK + sc, _r1 = (long)((k0) + 32 + sr) * LDK + sc; \
    sr_[i].vs0 = *reinterpret_cast<const bf16x8*>(&Vh[_r0]); sr_[i].vs1 = *reinterpret_cast<const bf16x8*>(&Vh[_r1]); \
    sr_[i].ks0 = *reinterpret_cast<const bf16x8*>(&Kh[_r0]); sr_[i].ks1 = *reinterpret_cast<const bf16x8*>(&Kh[_r1]); } while (0)
#define SWRITE(b, i) do { int t_ = tid; if (MODE != DENSE) asm volatile("" : "+v"(t_)); const int sr = t_ >> 4, sc = (t_ & 15) * 8, vst0 = v_st(sr, sc), vst1 = v_st(32 + sr, sc); \
    *(bf16x8*)((char*)V_lds + (b) * SHM_V + vst0) = sr_[i].vs0;          \
    *(bf16x8*)((char*)V_lds + (b) * SHM_V + vst1) = sr_[i].vs1; int kc = sc * 2;               \
    *(bf16x8*)((char*)K_lds + (b) * SHM_K + KSWZ(sr, kc)) = sr_[i].ks0;                       \
    *(bf16x8*)((char*)K_lds + (b) * SHM_K + KSWZ(32 + sr, kc)) = sr_[i].ks1; } while (0)
#define SWAIT() do { if constexpr (SDEPTH == 2) asm volatile("s_waitcnt vmcnt(4)" ::: "memory"); else asm volatile("s_waitcnt vmcnt(0)" ::: "memory"); } while (0)
#define RESC(a) do { if (__any((a) < 1.f)) { if (hi == 0) al_l[r32] = (a); asm volatile("s_waitcnt lgkmcnt(0)" ::: "memory"); \
    _Pragma("unroll") for (int d = 0; d < 4; ++d) _Pragma("unroll") for (int r = 0; r < 16; ++r) o[d][r] *= al_l[crow(r, hi)]; } } while (0)
#define ROW0(t) tile_row0<MODE>(u, (t))
  f32x16 pA0, pA1, pB0, pB1; float mnA, mnB, alA, alB; bf16x8 pa0, pa1, pa2, pa3; const int NT = u.NT;
  constexpr int SE = 0, SO = SDEPTH - 1;
  SLOAD(SE, ROW0(0)); asm volatile("s_waitcnt vmcnt(0)" ::: "memory"); SWRITE(0, SE); __syncthreads();
  qkt(pA0, pA1, K_lds, qr, r32, hi); mask_tile<MODE>(pA0, pA1, u, 0, wid, r32, hi, biasL); partialSM(pA0, pA1, m_reg, mnA, alA);
  SLOAD(SO, ROW0(1)); if constexpr (SDEPTH == 2) { if (2 < NT) SLOAD(SE, ROW0(2)); }
  SWAIT(); SWRITE(1, SO); __syncthreads();
  for (int j = 1; j + 1 < NT; j += 2) {
    SBAR(); qkt(pB0, pB1, (bf16_t*)((char*)K_lds + SHM_K), qr, r32, hi);
    finishSM(pA0, pA1, alA, l_reg, pa0, pa1, pa2, pa3); SBAR();
    SLOAD(SO, ROW0(j + SDEPTH)); SBAR();
    pv_d0(o, vb0, pa0, pa1, pa2, pa3); mask_tile<MODE>(pB0, pB1, u, j, wid, r32, hi, biasL); partialSM(pB0, pB1, m_reg, mnB, alB);
    __syncthreads(); SWAIT(); SWRITE(0, SE);
    RESC(alB); __syncthreads();
    SBAR(); qkt(pA0, pA1, K_lds, qr, r32, hi);
    finishSM(pB0, pB1, alB, l_reg, pa0, pa1, pa2, pa3); SBAR();
    if (SDEPTH == 1 || j + 3 < NT) SLOAD(SE, ROW0(j + 1 + SDEPTH)); SBAR();
    pv_d0(o, vb0 + (int)SHM_V, pa0, pa1, pa2, pa3); mask_tile<MODE>(pA0, pA1, u, j + 1, wid, r32, hi, biasL); partialSM(pA0, pA1, m_reg, mnA, alA);
    __syncthreads(); SWAIT(); SWRITE(1, SO);
    RESC(alA); __syncthreads();
  }
  SBAR(); qkt(pB0, pB1, (bf16_t*)((char*)K_lds + SHM_K), qr, r32, hi);
  finishSM(pA0, pA1, alA, l_reg, pa0, pa1, pa2, pa3); SBAR();
  pv_d0(o, vb0, pa0, pa1, pa2, pa3); mask_tile<MODE>(pB0, pB1, u, NT - 1, wid, r32, hi, biasL); partialSM(pB0, pB1, m_reg, mnB, alB);
  __syncthreads(); RESC(alB);
  finishSM(pB0, pB1, alB, l_reg, pa0, pa1, pa2, pa3); SBAR();
  pv_d0(o, vb0 + (int)SHM_V, pa0, pa1, pa2, pa3);
  l_reg += __builtin_amdgcn_exp2f(u.sink_l2e - m_reg * (SCALE * 1.4426950408889634f));
  if (hi == 0) li_l[r32] = l_reg; asm volatile("s_waitcnt lgkmcnt(0)" ::: "memory");
  float rli[16];
#pragma unroll
  for (int r = 0; r < 16; ++r) rli[r] = __builtin_amdgcn_rcpf(li_l[crow(r, hi)]);
  bf16_t* Ow = u.O + (long)(wid * QBLK) * u.ldo;
#pragma unroll
  for (int r = 0; r < 16; ++r) { int orow = crow(r, hi);
#pragma unroll
    for (int d0 = 0; d0 < 4; ++d0) { const float v = o[d0][r] * rli[r]; Ow[(long)orow * u.ldo + d0 * 32 + r32] = (bf16_t)(cvt_pk_bf16(v, v) & 0xffffu); } }
  __syncthreads();
#undef SLOAD
#undef SWRITE
#undef SWAIT
#undef RESC
#undef ROW0
}
#undef KSWZ
#undef SBAR
}

struct Args { const float* in[22]; float* out; unsigned char* ws; int ph_lo, ph_hi; };
#define CAS __attribute__((address_space(4)))
__device__ __forceinline__ const float* INP(int i) { const CAS char* k = (const CAS char*)__builtin_amdgcn_kernarg_segment_ptr(); asm volatile("" : "+s"(k)); return *(const float* const CAS*)(k + 8 * i); }
__device__ __forceinline__ float* OUTP() { const CAS char* k = (const CAS char*)__builtin_amdgcn_kernarg_segment_ptr(); asm volatile("" : "+s"(k)); return *(float* const CAS*)(k + 8 * 22); }
__device__ __forceinline__ unsigned char* WSP() { const CAS char* k = (const CAS char*)__builtin_amdgcn_kernarg_segment_ptr(); asm volatile("" : "+s"(k)); return *(unsigned char* const CAS*)(k + 8 * 23); }
enum { I_X = 0, I_C, I_CTX, I_CCTX, I_ADAW, I_ADAB, I_NORMG, I_WG, I_WU, I_WD, I_ABIN, I_ABOUT, I_NAQG, I_NAKG, I_NABIAS, I_SWQG, I_SWKG, I_SINK, I_GIN, I_GOUT, I_GQG, I_GKG };

__device__ __forceinline__ unsigned f2bf(float f) { unsigned u = __builtin_bit_cast(unsigned, f); return (u + 0x7fffu + ((u >> 16) & 1u)) >> 16; }
__device__ __forceinline__ unsigned pk2(float lo, float hi) { return f2bf(lo) | (f2bf(hi) << 16); }
template <bool DEEP> __device__ __forceinline__ void transpose_item(const float* __restrict__ W, int K, int N, bf16_t* WT, int mode, LAS float* scr, int item, int lane) {
    const int nblk = N / 32, kb = item / nblk, nb = item % nblk, k0 = 64 * kb, n0 = 32 * nb;
    if constexpr (DEEP) {
        float t[32];
#pragma unroll
        for (int i = 0; i < 32; ++i) { const int kk = 2 * i + (lane >> 5); t[i] = W[(size_t)(k0 + kk) * N + n0 + (lane & 31)]; }
#pragma unroll
        for (int i = 0; i < 32; ++i) { const int kk = 2 * i + (lane >> 5); scr[kk * 33 + (lane & 31)] = t[i]; }
    } else {
#pragma unroll 8
    for (int i = 0; i < 32; ++i) { const int kk = 2 * i + (lane >> 5); scr[kk * 33 + (lane & 31)] = W[(size_t)(k0 + kk) * N + n0 + (lane & 31)]; }
    }
    asm volatile("s_waitcnt lgkmcnt(0)" ::: "memory");
    const int c = lane & 7;
    const int rbase = (mode == 0) ? n0 : ((n0 >> 7) * 256 + (n0 & 127) + (mode == 2 ? 128 : 0));
#pragma unroll
    for (int j = 0; j < 4; ++j) { const int n = (lane >> 3) + 8 * j; const LAS float* s = scr + (8 * c) * 33 + n;
        u32x4 o; o.x = pk2(s[0 * 33], s[1 * 33]); o.y = pk2(s[2 * 33], s[3 * 33]); o.z = pk2(s[4 * 33], s[5 * 33]); o.w = pk2(s[6 * 33], s[7 * 33]);
        *(u32x4*)(WT + (size_t)(rbase + n) * K + k0 + 8 * c) = o; }
    asm volatile("s_waitcnt lgkmcnt(0)" ::: "memory");
}
constexpr int CV_GU1 = (DM / 64) * (FF / 32), CV_D1 = (FF / 64) * (DM / 32);
constexpr int CV_GU = 8 * CV_GU1, CV_D = 4 * CV_D1, CV_ABI = (DM / 64) * (AB_IN / 32), CV_SQ = (DM / 64) * (DM / 32), CV_GI = (DM / 64) * (C_IN / 32);
constexpr int CV_NP0 = 4 * CV_GU1 + 2 * CV_D1 + CV_ABI + CV_SQ;
constexpr int CV_NDEF = 3 * CV_GU1 + CV_GI + CV_SQ + 3 * CV_GU1;
__device__ __forceinline__ int cv_p0_to_full(int p) {
    if (p < 4 * CV_GU1) return p;
    p -= 4 * CV_GU1; if (p < 2 * CV_D1) return CV_GU + p;
    p -= 2 * CV_D1; if (p < CV_ABI) return CV_GU + CV_D + p;
    p -= CV_ABI; return CV_GU + CV_D + CV_ABI + p;
}
__device__ __forceinline__ int cv_def_to_full(int d) {
    if (d < 3 * CV_GU1) { const int sub = d / CV_GU1, r = d - sub * CV_GU1; return sub < 2 ? (2 * 2 + sub) * CV_GU1 + r : CV_GU + 2 * CV_D1 + r; }
    d -= 3 * CV_GU1; if (d < CV_GI) return CV_GU + CV_D + CV_ABI + CV_SQ + d;
    d -= CV_GI; if (d < CV_SQ) return CV_GU + CV_D + CV_ABI + CV_SQ + CV_GI + d;
    d -= CV_SQ; { const int sub = d / CV_GU1, r = d - sub * CV_GU1; return sub < 2 ? (3 * 2 + sub) * CV_GU1 + r : CV_GU + 3 * CV_D1 + r; }
}
template <bool DEEP> __device__ __forceinline__ void convert_item(int it, LAS float* scr, int lane) {
    bf16_t* wgu = (bf16_t*)(WSP() + WS_WGU); bf16_t* wd = (bf16_t*)(WSP() + WS_WD);
    int r = it;
    if (r < CV_GU) { const int q = r / CV_GU1, lf = q >> 1, gu = q & 1; r -= q * CV_GU1;
        transpose_item<DEEP>((gu ? INP(I_WU) : INP(I_WG)) + (size_t)lf * DM * FF, DM, FF, wgu + (size_t)lf * WGU_ELEMS, 1 + gu, scr, r, lane); return; }
    r -= CV_GU;
    if (r < CV_D) { const int lf = r / CV_D1; r -= lf * CV_D1; transpose_item<DEEP>(INP(I_WD) + (size_t)lf * FF * DM, FF, DM, wd + (size_t)lf * WD_ELEMS, 0, scr, r, lane); return; }
    r -= CV_D;
    if (r < CV_ABI) { transpose_item<DEEP>(INP(I_ABIN), DM, AB_IN, (bf16_t*)(WSP() + WS_WABIN), 0, scr, r, lane); return; }
    r -= CV_ABI;
    if (r < CV_SQ) { transpose_item<DEEP>(INP(I_ABOUT), DM, DM, (bf16_t*)(WSP() + WS_WABOUT), 0, scr, r, lane); return; }
    r -= CV_SQ;
    if (r < CV_GI) { transpose_item<DEEP>(INP(I_GIN), DM, C_IN, (bf16_t*)(WSP() + WS_WGIN), 0, scr, r, lane); return; }
    r -= CV_GI;
    transpose_item<DEEP>(INP(I_GOUT), DM, DM, (bf16_t*)(WSP() + WS_WGOUT), 0, scr, r, lane);
}
__device__ __forceinline__ void phase0(const Args& a, unsigned char* lds_g, int G) {
    const int tid = TID(), lane = tid & 63, wave = tid >> 6; const int bid = BID();
    float* sc = (float*)lds_g;
    float* red = sc + 4096;
    for (int i = tid; i < DM; i += 512) { const float c = INP(I_C)[i]; sc[i] = c / (1.0f + __expf(-c)); const float cc = INP(I_CCTX)[i]; sc[DM + i] = cc / (1.0f + __expf(-cc)); }
    __syncthreads();
    float* mod = (float*)(WSP() + WS_MOD);
    for (int unit = bid; unit < 256; unit += G) {
        const int layer = unit >> 7, col0 = (unit & 127) * 144;
        f32x4 a1 = {0.f, 0.f, 0.f, 0.f}, a2 = {0.f, 0.f, 0.f, 0.f};
        if (lane < 36) {
            const float* W = INP(I_ADAW) + (size_t)layer * DM * NMODV + col0 + 4 * lane;
            for (int k = wave * 256; k < wave * 256 + 256; k += 8) {
                f32x4 w[8];
#pragma unroll
                for (int q = 0; q < 8; ++q) w[q] = __builtin_nontemporal_load((const f32x4*)(W + (size_t)(k + q) * NMODV));
#pragma unroll
                for (int q = 0; q < 8; ++q) { a1 += w[q] * sc[k + q]; a2 += w[q] * sc[DM + k + q]; }
            }
#pragma unroll
            for (int e = 0; e < 4; ++e) { red[(wave * 2 + 0) * 144 + 4 * lane + e] = a1[e]; red[(wave * 2 + 1) * 144 + 4 * lane + e] = a2[e]; }
        }
        __syncthreads();
        if (tid < 288) { const int v = tid / 144, j = tid % 144; float s = INP(I_ADAB)[layer * NMODV + col0 + j];
#pragma unroll
            for (int w = 0; w < 8; ++w) s += red[(w * 2 + v) * 144 + j];
            mod[(size_t)(layer * 2 + v) * NMODV + col0 + j] = s; }
        __syncthreads();
    }
    LAS float* scr = (LAS float*)((LAS unsigned char*)lds_g + wave * 16384);
    const int gw = bid * 8 + wave, NGW = G * 8;
    for (int p = gw; p < CV_NP0; p += NGW) convert_item<false>(cv_p0_to_full(p), scr, lane);
    for (int d = (G == 256 ? SIDE_END : 0) + gw; d < CV_NDEF; d += NGW) convert_item<false>(cv_def_to_full(d), scr, lane);
}
__device__ __forceinline__ void side_convert(unsigned char* lds_g, int idle_from, int quota, int base, int end) {
    const int bid = BID();
    if (bid < idle_from) return;
    const int tid = TID(), lane = tid & 63, wave = tid >> 6;
    LAS float* scr = (LAS float*)((LAS unsigned char*)lds_g + wave * 16384);
    const int first = base + ((bid - idle_from) * 8 + wave) * quota;
    for (int q = 0; q < quota; ++q) { const int d = first + q; if (d < end) convert_item<true>(cv_def_to_full(d), scr, lane); }
}

__device__ __forceinline__ void modulate_phase(const float* xsrc, const float* csrc, float* cdst, const float* part, int nsplit, const float* cgate, float ccoef,
                                               const float* g, const float* shift_l, const float* scale_l, const float* shift_c, const float* scale_c, bf16_t* h, int nrows, int G, unsigned char* lds_g) {
    const int tid = TID(), lane = tid & 63, wave = tid >> 6;
    const int bid = BID();
    if (nrows > SEQ) {
        float* red = (float*)lds_g;
        float* ssl = red + 8 * DM;
        for (int r = bid; r < CTXL; r += G) {
            f32x4 s[8];
#pragma unroll
            for (int j = 0; j < 8; ++j) s[j] = (f32x4){0.f, 0.f, 0.f, 0.f};
            for (int sp = wave; sp < nsplit; sp += 8) { const f32x4* pr = (const f32x4*)(part + ((size_t)sp * 256 + r) * DM) + lane;
#pragma unroll
                for (int j = 0; j < 8; ++j) s[j] += pr[64 * j]; }
#pragma unroll
            for (int j = 0; j < 8; ++j) *((f32x4*)(red + wave * DM) + lane + 64 * j) = s[j];
            __syncthreads();
            const int col = wave * 256 + 4 * lane;
            f32x4 t = *(const f32x4*)(red + col);
#pragma unroll
            for (int w = 1; w < 8; ++w) t += *(const f32x4*)(red + w * DM + col);
            f32x4 v = *(const f32x4*)(csrc + (size_t)r * DM + col);
            if (nsplit > 0) v += ccoef * (*(const f32x4*)(cgate + col)) * t;
            *(f32x4*)(cdst + (size_t)r * DM + col) = v;
            const float ssw = wave_sum((v.x * v.x + v.y * v.y) + (v.z * v.z + v.w * v.w));
            if (lane == 0) ssl[wave] = ssw;
            __syncthreads();
            float ss = 0.f;
#pragma unroll
            for (int w = 0; w < 8; ++w) ss += ssl[w];
            const float rstd = 1.0f / sqrtf(ss * (1.0f / DM) + EPS);
            const f32x4 y = (v * rstd) * (*(const f32x4*)(g + col)); const f32x4 z = y * (*(const f32x4*)(scale_c + col) + 1.0f) + *(const f32x4*)(shift_c + col);
            u32x2 w2; w2.x = cvt_pk_bf16(z.x, z.y); w2.y = cvt_pk_bf16(z.z, z.w); *(u32x2*)(h + (size_t)(SEQ + r) * DM + col) = w2;
            __syncthreads();
        }
    }
    const int gw = bid * 8 + wave, NGW = G * 8;
    for (int row = gw; row < SEQ; row += NGW) {
        f32x4 v[8];
        const f32x4* xr = (const f32x4*)(xsrc + (size_t)row * DM) + lane;
#pragma unroll
        for (int j = 0; j < 8; ++j) v[j] = xr[64 * j];
        float ss = 0.f;
#pragma unroll
        for (int j = 0; j < 8; ++j) ss += (v[j].x * v[j].x + v[j].y * v[j].y) + (v[j].z * v[j].z + v[j].w * v[j].w);
        const float rstd = 1.0f / sqrtf(wave_sum(ss) * (1.0f / DM) + EPS);
        const f32x4* sh = (const f32x4*)shift_l + lane; const f32x4* scl = (const f32x4*)scale_l + lane;
        const f32x4* gg = (const f32x4*)g + lane;
        u32x2* ho = (u32x2*)(h + (size_t)row * DM) + lane;
#pragma unroll
        for (int j = 0; j < 8; ++j) { const f32x4 y = (v[j] * rstd) * gg[64 * j]; const f32x4 z = y * (scl[64 * j] + 1.0f) + sh[64 * j];
            u32x2 w; w.x = cvt_pk_bf16(z.x, z.y); w.y = cvt_pk_bf16(z.z, z.w); ho[64 * j] = w; }
    }
}

__device__ __forceinline__ void attn_phase0(const Args& a, unsigned char* lds_g, int G) {
    bf16_t* P = (bf16_t*)(WSP() + WS_P); bf16_t* O = (bf16_t*)(WSP() + WS_O);
    float* biasL = (float*)(lds_g + att::BIAS_OFF);
    const int tid0 = TID();
    for (int un = BID(); un < 528; un += G) {
        att::UnitP u; u.ldq = AB_IN; u.ldk = AB_IN; u.ldo = DM; u.sink_l2e = -INFINITY;
        if (un < 256) {
            const int h = un & 7, qb = un >> 3;
            for (int i = tid0; i < 465; i += 512) biasL[i] = INP(I_NABIAS)[h * 465 + i] * att::INV_SCALE;
            __syncthreads();
            u.Q = P + (size_t)(256 * qb) * AB_IN + h * 128; u.K = P + (16 + h) * 128; u.V = P + (24 + h) * 128; u.O = O + (size_t)(256 * qb) * DM + h * 128;
            u.NT = 16; u.base_row = 0; u.qb = qb;
            att::attn_unit<att::NA, 1>(u, (char*)lds_g);
        } else if (un < 512) {
            const int hq = (un - 256) & 7, qb = (un - 256) >> 3, kvh = hq >> 2;
            u.Q = P + (size_t)(256 * qb) * AB_IN + (8 + hq) * 128; u.K = P + (32 + kvh) * 128; u.V = P + (34 + kvh) * 128; u.O = O + (size_t)(256 * qb) * DM + (8 + hq) * 128;
            u.NT = 12; u.base_row = 0; u.qb = qb; u.sink_l2e = INP(I_SINK)[hq] * 1.4426950408889634f;
            att::attn_unit<att::SW, 1>(u, (char*)lds_g);
        } else {
            const int hh = un - 512;
            u.Q = P + (size_t)SEQ * AB_IN + hh * 128; u.O = O + (size_t)SEQ * DM + hh * 128;
            const bool nah = hh < 8; const int hq = nah ? 0 : hh - 8, kvh = hq >> 2;
            const int kslot = nah ? 16 + hh : 32 + kvh, vslot = nah ? 24 + hh : 34 + kvh;
            u.K = P + kslot * 128; u.V = P + vslot * 128;
            const float sk = INP(I_SINK)[hq] * 1.4426950408889634f; u.sink_l2e = nah ? -INFINITY : sk;
            u.NT = 4; u.base_row = SEQ; u.qb = 0;
            att::attn_unit<att::DENSE, 2>(u, (char*)lds_g);
        }
    }
}
__device__ __forceinline__ void attn_phase1(const Args& a, unsigned char* lds_g, int G) {
    bf16_t* P = (bf16_t*)(WSP() + WS_P); bf16_t* O = (bf16_t*)(WSP() + WS_O);
    const int bid = BID();
    for (int i = 0;; ++i) {
        int un;
        if ((G & 7) == 0) { const int x = bid & 7, j = (bid >> 3) + i * (G >> 3); if (j >= 64) break; un = x * 64 + j; }
        else { un = bid + i * G; if (un >= 512) break; }
        const int h = un >> 5, qb = un & 31, kvh = h >> 2;
        att::UnitP u; u.ldq = C_IN; u.ldk = C_IN; u.ldo = DM; u.sink_l2e = -INFINITY;
        u.Q = P + (size_t)(256 * qb) * C_IN + h * 128; u.K = P + (16 + kvh) * 128; u.V = P + (20 + kvh) * 128; u.O = O + (size_t)(256 * qb) * DM + h * 128;
        u.NT = MT / 64; u.base_row = 0; u.qb = qb;
        att::attn_unit<att::DENSE, 2>(u, (char*)lds_g);
    }
}

#define XB_TMO      128
#define XB_XCNT(j)  (256  + 64 * (j))
#define XB_XSUB(j)  (1280 + 64 * (j))
#define XB_XGEN(j)  (2304 + 64 * (j))
#define XB_TOP      3328
#define XB_TOPGEN   3392
#define XCD_BAR_WORDS 3456
#define XB_SPIN_CAP (1u << 18)
__device__ __forceinline__ unsigned xb_ld(unsigned* p)              { return __hip_atomic_load(p, __ATOMIC_RELAXED, __HIP_MEMORY_SCOPE_AGENT); }
__device__ __forceinline__ unsigned xb_add(unsigned* p, unsigned v) { return __hip_atomic_fetch_add(p, v, __ATOMIC_RELAXED, __HIP_MEMORY_SCOPE_AGENT); }
__device__ __forceinline__ unsigned xb_xcc_id() { return (unsigned)__builtin_amdgcn_s_getreg((3 << 11) | 20) & 0xFu; }
#define XB_SPIN(cond, bar) do { unsigned _sp = 0; while (cond) { __builtin_amdgcn_s_sleep(1); \
    if ((++_sp & 255u) == 0u) { if (xb_ld(&(bar)[XB_TMO])) break; if (_sp > XB_SPIN_CAP) { atomicAdd(&(bar)[XB_TMO], 1u); break; } } } } while (0)
struct XcdBarrier { unsigned* bar; unsigned x; volatile LAS unsigned* st; };
__device__ __forceinline__ XcdBarrier xcd_barrier_post(unsigned* bar, volatile LAS unsigned* st) {
    XcdBarrier b; b.bar = bar; b.x = xb_xcc_id(); b.st = st;
    if (threadIdx.x == 0) (void)xb_add(&bar[XB_XCNT(b.x)], 1u);
    return b;
}
__device__ __forceinline__ void xcd_barrier_complete(unsigned* bar, unsigned x, unsigned& nloc, unsigned& nx) {
    const unsigned G = gridDim.x * gridDim.y * gridDim.z;
    unsigned sum, cnt, mine, sp = 0u;
    for (;;) {
        sum = 0u; cnt = 0u; mine = 0u;
#pragma unroll
        for (unsigned j = 0; j < 16; ++j) { const unsigned c = xb_ld(&bar[XB_XCNT(j)]); sum += c; cnt += (c > 0u) ? 1u : 0u; mine = (j == x) ? c : mine; }
        if (sum == G) break;
        __builtin_amdgcn_s_sleep(1);
        if ((++sp & 255u) == 0u) { if (xb_ld(&bar[XB_TMO])) break; if (sp > XB_SPIN_CAP) { atomicAdd(&bar[XB_TMO], 1u); break; } }
    }
    nloc = mine > 0u ? mine : 1u; nx = cnt > 0u ? cnt : 1u;
}
__device__ __forceinline__ void xcd_barrier(const XcdBarrier& b) {
    asm volatile("s_waitcnt vmcnt(0)" ::: "memory");
    __syncthreads();
    if (threadIdx.x == 0) {
        unsigned* bar = b.bar;
        __builtin_amdgcn_s_waitcnt(0);
        unsigned nloc = b.st[0], nx = b.st[1];
        if (nloc == 0u) { xcd_barrier_complete(bar, b.x, nloc, nx); b.st[0] = nloc; b.st[1] = nx; }
        const unsigned old = xb_add(&bar[XB_XSUB(b.x)], 1u);
        const unsigned gen = old / nloc;
        if (old + 1u == (gen + 1u) * nloc) {
            __builtin_amdgcn_fence(__ATOMIC_RELEASE, "agent");
            asm volatile("s_waitcnt vmcnt(0)" ::: "memory");
            const unsigned og = xb_add(&bar[XB_TOP], 1u);
            const unsigned tg = og / nx;
            if (og + 1u == (tg + 1u) * nx) xb_add(&bar[XB_TOPGEN], 1u);
            else XB_SPIN(xb_ld(&bar[XB_TOPGEN]) == tg, bar);
            __builtin_amdgcn_fence(__ATOMIC_ACQUIRE, "agent");
            xb_add(&bar[XB_XGEN(b.x)], 1u);
            asm volatile("s_waitcnt vmcnt(0)" ::: "memory");
        } else {
            XB_SPIN(xb_ld(&bar[XB_XGEN(b.x)]) == gen, bar);
            __builtin_amdgcn_fence(__ATOMIC_ACQUIRE, "agent");
            asm volatile("s_waitcnt vmcnt(0)" ::: "memory");
        }
    }
    __syncthreads();
}

__global__ void __launch_bounds__(512, 2) mk_fwd(Args a) {
    extern __shared__ __attribute__((aligned(16))) unsigned char lds[];
    cg::grid_group grid = cg::this_grid();
    const int G = gridDim.x;
    LAS unsigned char* lds3 = (LAS unsigned char*)lds;
    volatile LAS unsigned* misc = (volatile LAS unsigned*)(lds3 + MISC_OFF);
    if (threadIdx.x < 2) misc[threadIdx.x] = 0u;
    __syncthreads();
    XcdBarrier bar = xcd_barrier_post((unsigned*)(WSP() + WS_BAR), misc);
    float* mod = (float*)(WSP() + WS_MOD);
    float* xc = (float*)(WSP() + WS_XC); float* part = (float*)(WSP() + WS_PART);
    bf16_t* H = (bf16_t*)(WSP() + WS_H); bf16_t* O = (bf16_t*)(WSP() + WS_O); bf16_t* P = (bf16_t*)(WSP() + WS_P); bf16_t* A = (bf16_t*)(WSP() + WS_A);
    for (int ph = a.ph_lo; ph < a.ph_hi; ++ph) {
        if (ph == 0) { phase0(a, lds, G); if (REPMASK & 1) { __syncthreads(); phase0(a, lds, G); } }
        else {
            const int layer = (ph - 1) / 10, sub = (ph - 1) % 10;
            const float* mL = mod + (size_t)(layer * 2 + 0) * NMODV; const float* mC = mod + (size_t)(layer * 2 + 1) * NMODV;
            const bool with_ctx = layer == 0;
            if (sub == 0 || sub == 3 || sub == 7) {
                const int k = sub == 0 ? 0 : (sub == 3 ? 1 : 2);
                const bool first = (ph == 1);
                const float* xsrc = (ph <= 3) ? INP(I_X) : OUTP();
                const float* csrc = first ? INP(I_CTX) : xc;
                const bool upd_prev = (sub == 0 && layer == 1);
                const int nsplit = (upd_prev || sub == 3) ? NSPLIT_DOWN : ((sub == 7) ? NSPLIT_OUT : 0);
                const float* cgate = upd_prev ? (mod + (size_t)(0 * 2 + 1) * NMODV + 8 * DM) : (sub == 3 ? mC + 2 * DM : mC + 5 * DM);
                const float ccoef = (sub == 7) ? 1.0f : 0.5f;
                const int nrows = (sub == 7 && !with_ctx) ? SEQ : MT;
                modulate_phase(xsrc, csrc, xc, part, nsplit, cgate, ccoef, INP(I_NORMG) + (size_t)(layer * 3 + k) * DM,
                               mL + (3 * k) * DM, mL + (3 * k + 1) * DM, mC + (3 * k) * DM, mC + (3 * k + 1) * DM, H, nrows, G, lds);
            } else if (sub == 1 || sub == 8) {
                const int f = sub == 1 ? 0 : 1; const int nM = (f == 1 && !with_ctx) ? SEQ / 256 : MT / 256;
                pg8::Gemm g{H, (const bf16_t*)(WSP() + WS_WGU) + (size_t)(layer * 2 + f) * WGU_ELEMS, DM};
                pg8::Sched S; S.init(nM, 2 * FF / 256, DM, G, BID(), 0, 0, 0);
                pg8::EpiSwiGLU E{A, FF};
                pg8::gemm_phase<pg8::EpiSwiGLU, true, true>(lds3, g, S, E);
                if (REPMASK & 2) pg8::gemm_phase<pg8::EpiSwiGLU, true, true>(lds3, g, S, E);
                if (nM == MT / 256) { const int idle = (nM * (2 * FF / 256)) % G;
                    if (G == 256) { if (ph == 2) side_convert(lds, idle, SIDE_Q, 0, SIDE_E0); else if (ph == 9) side_convert(lds, idle, SIDE_Q, SIDE_E1, SIDE_E2); else if (ph == 12) side_convert(lds, idle, SIDE_Q, SIDE_E2, SIDE_E3 < SIDE_END ? SIDE_E3 : SIDE_END); } }
            } else if (sub == 2 || sub == 9) {
                const int f = sub == 2 ? 0 : 1; const bool ctxrows = !(f == 1 && !with_ctx);
                pg8::Gemm g{A, (const bf16_t*)(WSP() + WS_WD) + (size_t)(layer * 2 + f) * WD_ELEMS, FF};
                pg8::Sched S; S.init(SEQ / 256, DM / 256, FF, G, BID(), ctxrows ? NSPLIT_DOWN : 0, NT_SPLIT_DOWN, SEQ / 256);
                pg8::EpiResid E{(ph == 3) ? INP(I_X) : (const float*)OUTP(), OUTP(), mL + (f == 0 ? 2 : 8) * DM, 0.5f, part};
                pg8::gemm_phase<pg8::EpiResid, true, true>(lds3, g, S, E);
                if (REPMASK & 256) { pg8::EpiResid E2{(const float*)P, (float*)P, mL + (f == 0 ? 2 : 8) * DM, 0.5f, part}; pg8::gemm_phase<pg8::EpiResid, true, true>(lds3, g, S, E2); }
            } else if (sub == 4) {
                const int N = layer == 0 ? AB_IN : C_IN;
                pg8::Gemm g{H, (const bf16_t*)(WSP() + (layer == 0 ? WS_WABIN : WS_WGIN)), DM};
                pg8::Sched S; S.init(MT / 256, N / 256, DM, G, BID(), 0, 0, 0);
                pg8::EpiQK E{P, N, layer, layer == 0 ? INP(I_NAQG) : INP(I_GQG), layer == 0 ? INP(I_SWQG) : INP(I_GKG), INP(I_NAKG), INP(I_SWKG), (LAS float*)(lds3 + XCH_OFF)};
                pg8::gemm_phase<pg8::EpiQK, true, true>(lds3, g, S, E);
                if (REPMASK & 16) pg8::gemm_phase<pg8::EpiQK, true, true>(lds3, g, S, E);
                if (G == 256) { if (layer == 0) side_convert(lds, ((MT / 256) * (AB_IN / 256)) % G, SIDE_Q, SIDE_E0, SIDE_E1); else side_convert(lds, ((MT / 256) * (C_IN / 256)) % G, SIDE_Q, SIDE_E3 < SIDE_END ? SIDE_E3 : SIDE_END, SIDE_END); }
            }
            else if (sub == 5) { if (layer == 0) { attn_phase0(a, lds, G); if (REPMASK & 32) attn_phase0(a, lds, G); } else { attn_phase1(a, lds, G); if (REPMASK & 4) attn_phase1(a, lds, G); } }
            else if (sub == 6) {
                pg8::Gemm g{O, (const bf16_t*)(WSP() + (layer == 0 ? WS_WABOUT : WS_WGOUT)), DM};
                pg8::Sched S; S.init(SEQ / 256, DM / 256, DM, G, BID(), with_ctx ? NSPLIT_OUT : 0, NT_SPLIT_OUT, SEQ / 256);
                pg8::EpiResid E{OUTP(), OUTP(), mL + 5 * DM, 1.0f, part};
                pg8::gemm_phase<pg8::EpiResid, true, true>(lds3, g, S, E);
                if (REPMASK & 512) { pg8::EpiResid E2{(const float*)A, (float*)A, mL + 5 * DM, 1.0f, part}; pg8::gemm_phase<pg8::EpiResid, true, true>(lds3, g, S, E2); }
            }
        }
        if (ph + 1 < a.ph_hi) {
            if (a.ph_lo < 0) grid.sync(); else xcd_barrier(bar);
            if (REPMASK & 8) xcd_barrier(bar); }
    }
}

extern "C" void kernel_launch(void* const* d_in, const int* in_sizes, int n_in, void* d_out, int out_size, void* d_ws, size_t ws_size, hipStream_t stream) {
    static int grid = 0;
    if (grid == 0) {
        if (n_in != 22 || out_size != SEQ * DM || ws_size < WS_END) { fprintf(stderr, "kernel_launch: unexpected shapes (n_in %d out %d ws %zu)\n", n_in, out_size, ws_size); grid = -1; return; }
        int dev = 0, cus = 0, per_cu = 0;
        hipGetDevice(&dev); hipDeviceGetAttribute(&cus, hipDeviceAttributeMultiprocessorCount, dev);
        if (hipFuncSetAttribute((const void*)mk_fwd, hipFuncAttributeMaxDynamicSharedMemorySize, LDS_BYTES) != hipSuccess) { fprintf(stderr, "kernel_launch: hipFuncSetAttribute failed\n"); grid = -1; return; }
        if (hipOccupancyMaxActiveBlocksPerMultiprocessor(&per_cu, (const void*)mk_fwd, 512, LDS_BYTES) != hipSuccess || per_cu < 1) { fprintf(stderr, "kernel_launch: occupancy query gave %d\n", per_cu); per_cu = 1; }
        (void)hipGetLastError();
        grid = cus * per_cu;
        if (grid > 256) grid = 256;
    }
    if (grid < 0) return;
    if (hipMemsetAsync((char*)d_ws + WS_BAR, 0, BAR_BYTES, stream) != hipSuccess) { fprintf(stderr, "kernel_launch: memset failed\n"); return; }
    Args a{};
    for (int i = 0; i < 22; ++i) a.in[i] = (const float*)d_in[i];
    a.out = (float*)d_out; a.ws = (unsigned char*)d_ws;
#if MK_MULTI
    for (int p = 0; p < NPHASE; ++p) { a.ph_lo = p; a.ph_hi = p + 1; hipLaunchKernelGGL(mk_fwd, dim3(grid), dim3(512), LDS_BYTES, stream, a); }
#else
    a.ph_lo = 0; a.ph_hi = NPHASE;
    void* args[] = {&a};
    hipError_t e = hipLaunchCooperativeKernel((const void*)mk_fwd, dim3(grid), dim3(512), args, LDS_BYTES, stream);
    if (e != hipSuccess) fprintf(stderr, "cooperative launch failed: %s (grid %d)\n", hipGetErrorString(e), grid);
#endif
}
```

```cpp
#include <hip/hip_runtime.h>
#include <hip/hip_cooperative_groups.h>
#include <cstdio>
#include <cstdint>
namespace cg = cooperative_groups;

#ifndef REPMASK
#define REPMASK 0
#endif
#ifndef MK_MULTI
#define MK_MULTI 0
#endif

constexpr int SEQ = 8192, CTXL = 256, MT = SEQ + CTXL, DM = 2048, FF = 5632, NMODV = 9 * DM;
constexpr int AB_IN = 4608, C_IN = 3072, GRIDW = 64;
constexpr float EPS = 1e-6f;
constexpr int NPHASE = 21;
constexpr int SIDE_Q = 8, SIDE_E0 = 84 * 8 * SIDE_Q, SIDE_E1 = SIDE_E0 + 174 * 8 * SIDE_Q, SIDE_E2 = SIDE_E1 + 84 * 8 * SIDE_Q, SIDE_E3 = SIDE_E2 + 84 * 8 * SIDE_Q, SIDE_E4 = SIDE_E3 + 116 * 8 * SIDE_Q;
constexpr int SIDE_END = SIDE_E4 < 38912 ? SIDE_E4 : 38912;
static_assert(SIDE_E2 >= 3 * 5632 && SIDE_E3 >= 3 * 5632 + 3072 + 2048, "FFN(1,0) must be converted by phase 9, gqa_in / gqa_out by phase 12");
constexpr int NSPLIT_DOWN = 22, NT_SPLIT_DOWN = 4;
constexpr int NSPLIT_OUT = 16, NT_SPLIT_OUT = 2;

constexpr size_t MiB = 1u << 20;
constexpr size_t WS_MOD = 0;
constexpr size_t WS_BAR = 512 * 1024, BAR_BYTES = 16384;
constexpr size_t WS_XC = 1 * MiB;
constexpr size_t WS_PART = 4 * MiB;
constexpr size_t WS_H = 52 * MiB;
constexpr size_t WS_O = 88 * MiB;
constexpr size_t WS_P = 124 * MiB;
constexpr size_t WS_A = 200 * MiB;
constexpr size_t WS_WGU = 292 * MiB;
constexpr size_t WS_WD = 468 * MiB;
constexpr size_t WS_WABIN = 556 * MiB;
constexpr size_t WS_WABOUT = 574 * MiB;
constexpr size_t WS_WGIN = 582 * MiB;
constexpr size_t WS_WGOUT = 594 * MiB;
constexpr size_t WS_END = 602 * MiB;
constexpr size_t WGU_ELEMS = (size_t)2 * FF * DM, WD_ELEMS = (size_t)DM * FF;

constexpr int LDS_BYTES = 143360;
constexpr int XCH_OFF = 131072;
constexpr int MISC_OFF = 141312;

typedef unsigned short bf16_t;
typedef short bf16x8 __attribute__((ext_vector_type(8)));
typedef short s16x4 __attribute__((ext_vector_type(4)));
typedef float f32x4 __attribute__((ext_vector_type(4)));
typedef float f32x2 __attribute__((ext_vector_type(2)));
typedef float f32x16 __attribute__((ext_vector_type(16)));
typedef unsigned u32x4 __attribute__((ext_vector_type(4)));
typedef unsigned u32x2 __attribute__((ext_vector_type(2)));
#define LAS __attribute__((address_space(3)))

__device__ __forceinline__ unsigned cvt_pk_bf16(float lo, float hi) { unsigned r; asm volatile("v_cvt_pk_bf16_f32 %0, %1, %2" : "=v"(r) : "v"(lo), "v"(hi)); return r; }
__device__ __forceinline__ int TID() { int t = threadIdx.x; asm volatile("" : "+v"(t)); return t; }
__device__ __forceinline__ int BID() { int b = blockIdx.x; asm volatile("" : "+s"(b)); return b; }
__device__ __forceinline__ float bf2f(unsigned short b) { return __uint_as_float(((unsigned)b) << 16); }
__device__ __forceinline__ float wave_sum(float v) {
#pragma unroll
    for (int o = 1; o < 64; o <<= 1) v += __shfl_xor(v, o);
    return v;
}

namespace pg8 {
constexpr int BM = 256, BK = 64, HALF = 128, HTB = HALF * BK * 2, STAGE_BYTES = 8 * HTB, NXCD = 8, WGM = 8;
__host__ __device__ __forceinline__ int lds_byte(int r, int c) { const int st = (r >> 4) * 2 + (c >> 5), rr = r & 15, cc = c & 31, ob = rr * 64 + cc * 2; return st * 1024 + (ob ^ (((ob >> 9) & 1) << 5)); }
__host__ __device__ __forceinline__ void stage_rc(int b, int& R, int& C) { const int st = b / 1024, sb = b % 1024, swz = sb ^ (((sb >> 9) & 1) << 5); R = (st >> 1) * 16 + swz / 64; C = (st & 1) * 32 + (swz % 64) / 2; }
__host__ __device__ __forceinline__ int perm32(int rho) { const int n = rho >> 4, i = rho & 15; return 8 * (i >> 2) + 4 * n + (i & 3); }

__host__ __device__ __forceinline__ int permrope(int s) { return 64 * ((s >> 4) & 1) + 16 * (s >> 5) + (s & 15); }
struct Unit { int pm, pn, k0, nt, split; };
struct Gemm { const bf16_t* A; const bf16_t* Bt; int K; };

struct Sched {
    int nM, nN, nwg, G, c, nt_full, nsplit_units, split_nt, split_pm;
    __device__ __forceinline__ void init(int nM_, int nN_, int K, int G_, int c_, int nsplit, int snt, int spm) {
        nM = nM_; nN = nN_; nwg = nM * nN; G = G_; c = c_; nt_full = K / BK; nsplit_units = nsplit * nN_; split_nt = snt; split_pm = spm; }
    __device__ __forceinline__ bool next(int i, Unit& u) const {
        const long L = (long)i * G + c;
        const bool reg = L < nwg; const int s = reg ? 0 : (int)(L - nwg);
        if (!reg && s >= nsplit_units) return false;
        int wgid = reg ? (int)L : 0; { const int q = nwg / NXCD, r = nwg % NXCD, xcd = wgid % NXCD, off = wgid / NXCD; wgid = (xcd < r ? xcd * (q + 1) : r * (q + 1) + (xcd - r) * q) + off; }
        const int nig = WGM * nN, gid = wgid / nig, fm = gid * WGM, gsz = (nM - fm) < WGM ? (nM - fm) : WGM;
        const int pm_r = fm + ((wgid % nig) % gsz), pn_r = (wgid % nig) / gsz;
        const int pn_s = s % nN, sp_s = s / nN;
        u.pm = __builtin_amdgcn_readfirstlane(reg ? pm_r : split_pm); u.pn = __builtin_amdgcn_readfirstlane(reg ? pn_r : pn_s);
        u.split = __builtin_amdgcn_readfirstlane(reg ? -1 : sp_s); u.k0 = __builtin_amdgcn_readfirstlane(reg ? 0 : sp_s * split_nt); u.nt = __builtin_amdgcn_readfirstlane(reg ? nt_full : split_nt);
        return true;
    }
};

__device__ __forceinline__ float silu_mul(float g, float u) { const float e = __builtin_amdgcn_exp2f(-g * 1.4426950408889634f); return g * __builtin_amdgcn_rcpf(1.0f + e) * u; }
struct EpiSwiGLU {
    static constexpr int PERM = 1;
    bf16_t* O; int ldc;
    __device__ __forceinline__ void operator()(const f32x4 (&acc)[2][2][4][2], const Unit& u, int wr, int wc, int fr, int fq) const {
        asm volatile("" : "+v"(fr), "+v"(fq));
        const int row0 = u.pm * BM + wr * 64 + fr; const int col0 = u.pn * HALF + wc * 32 + 8 * fq;
#pragma unroll
        for (int ai = 0; ai < 2; ++ai)
#pragma unroll
            for (int m = 0; m < 4; ++m) { bf16_t* rowp = O + (size_t)(row0 + ai * HALF + m * 16) * ldc + col0;
                const f32x4 g0 = acc[ai][0][m][0], g1 = acc[ai][0][m][1], u0 = acc[ai][1][m][0], u1 = acc[ai][1][m][1];
                u32x4 w; w.x = cvt_pk_bf16(silu_mul(g0[0], u0[0]), silu_mul(g0[1], u0[1])); w.y = cvt_pk_bf16(silu_mul(g0[2], u0[2]), silu_mul(g0[3], u0[3]));
                w.z = cvt_pk_bf16(silu_mul(g1[0], u1[0]), silu_mul(g1[1], u1[1])); w.w = cvt_pk_bf16(silu_mul(g1[2], u1[2]), silu_mul(g1[3], u1[3]));
                *(u32x4*)rowp = w; }
    }
};
struct EpiResid {
    static constexpr int PERM = 0;
    const float* Xs; float* X; const float* gate; float coef; float* part;
    __device__ __forceinline__ void operator()(const f32x4 (&acc)[2][2][4][2], const Unit& u, int wr, int wc, int fr, int fq) const {
        asm volatile("" : "+v"(fr), "+v"(fq));
        const int col0 = u.pn * BM + wc * 32 + 4 * fq;
        if (u.split < 0) {
            f32x4 gv[2][2];
#pragma unroll
            for (int bj = 0; bj < 2; ++bj)
#pragma unroll
                for (int n = 0; n < 2; ++n) gv[bj][n] = *(const f32x4*)(gate + col0 + bj * HALF + n * 16) * coef;
#pragma unroll
            for (int ai = 0; ai < 2; ++ai)
#pragma unroll
                for (int mh = 0; mh < 1; ++mh) {
                    f32x4 xv[4][2][2];
#pragma unroll
                    for (int mm = 0; mm < 4; ++mm) { const int m = mh * 4 + mm; const float* rows = Xs + (size_t)(u.pm * BM + ai * HALF + wr * 64 + m * 16 + fr) * DM + col0;
#pragma unroll
                        for (int bj = 0; bj < 2; ++bj)
#pragma unroll
                            for (int n = 0; n < 2; ++n) xv[mm][bj][n] = *(const f32x4*)(rows + bj * HALF + n * 16); }
#pragma unroll
                    for (int mm = 0; mm < 4; ++mm) { const int m = mh * 4 + mm; float* rowp = X + (size_t)(u.pm * BM + ai * HALF + wr * 64 + m * 16 + fr) * DM + col0;
#pragma unroll
                        for (int bj = 0; bj < 2; ++bj)
#pragma unroll
                            for (int n = 0; n < 2; ++n) *(f32x4*)(rowp + bj * HALF + n * 16) = xv[mm][bj][n] + gv[bj][n] * acc[ai][bj][m][n]; }
                    asm volatile("" ::: "memory"); }
        } else {
            float* base = part + (size_t)u.split * 256 * DM;
#pragma unroll
            for (int ai = 0; ai < 2; ++ai)
#pragma unroll
                for (int m = 0; m < 4; ++m) { float* rowp = base + (size_t)(ai * HALF + wr * 64 + m * 16 + fr) * DM + col0;
#pragma unroll
                    for (int bj = 0; bj < 2; ++bj)
#pragma unroll
                        for (int n = 0; n < 2; ++n) *(f32x4*)(rowp + bj * HALF + n * 16) = acc[ai][bj][m][n]; }
        }
    }
};

__device__ __forceinline__ void store_pair16(bf16_t* p, u32x2 w1, u32x2 w2, int fq) {
    auto rx = __builtin_amdgcn_permlane16_swap(w1.x, w2.x, false, false); auto ry = __builtin_amdgcn_permlane16_swap(w1.y, w2.y, false, false);
    u32x4 o; o.x = rx[0]; o.y = ry[0]; o.z = rx[1]; o.w = ry[1];
    *(u32x4*)(p + ((fq & 1) ? 60 : 0)) = o;
}
struct EpiQK {
    static constexpr int PERM = 2;
    bf16_t* O; int ldc; int layer; const float* g0; const float* g1; const float* g2; const float* g3; LAS float* xch;
    __device__ __forceinline__ void operator()(const f32x4 (&acc)[2][2][4][2], const Unit& u, int wr, int wc, int fr, int fq) const {
        asm volatile("" : "+v"(fr), "+v"(fq));
        const int pn = u.pn;
        const float* const q0 = g0; const float* const q1 = g1; const float* const q2 = g2; const float* const q3 = g3; const int lay = layer;
        const int kind0 = (pn < 4) ? 1 : ((pn < 8) ? 2 : ((pn < 12) ? 1 : ((pn == 16) ? 2 : 0))), kind1 = (pn < 10) ? 2 : 0;
        const float* const gain0 = (pn < 4) ? q0 : ((pn < 8) ? q1 : ((pn < 12) ? q2 : q3)); const float* const gain1 = (pn < 8) ? q0 : q1;
        const int kind = lay == 0 ? kind0 : kind1; const float* const gain = lay == 0 ? gain0 : gain1;
        const bool latent = u.pm < SEQ / 256;
        const int dl = 16 * wc + 4 * fq;
        bf16_t* obase = O + (size_t)(u.pm * BM + wr * 64 + fr) * ldc + pn * BM + dl;
        if (kind == 0) {
#pragma unroll
            for (int ai = 0; ai < 2; ++ai)
#pragma unroll
                for (int m = 0; m < 4; ++m)
#pragma unroll
                    for (int bj = 0; bj < 2; ++bj) { bf16_t* p = obase + (size_t)(ai * HALF + m * 16) * ldc + bj * HALF; const f32x4 x1 = acc[ai][bj][m][0], x2 = acc[ai][bj][m][1];
                        u32x2 w1, w2; w1.x = cvt_pk_bf16(x1[0], x1[1]); w1.y = cvt_pk_bf16(x1[2], x1[3]); w2.x = cvt_pk_bf16(x2[0], x2[1]); w2.y = cvt_pk_bf16(x2[2], x2[3]);
                        store_pair16(p, w1, w2, fq); }
            return;
        }
        LAS float* xr = xch + ((wr * 128 + fr) * 8 + wc);
#pragma unroll
        for (int ai = 0; ai < 2; ++ai)
#pragma unroll
            for (int m = 0; m < 4; ++m)
#pragma unroll
                for (int bj = 0; bj < 2; ++bj) { const f32x4 x1 = acc[ai][bj][m][0], x2 = acc[ai][bj][m][1];
                    float s = (x1[0] * x1[0] + x1[1] * x1[1]) + (x1[2] * x1[2] + x1[3] * x1[3]) + (x2[0] * x2[0] + x2[1] * x2[1]) + (x2[2] * x2[2] + x2[3] * x2[3]);
                    { auto r16 = __builtin_amdgcn_permlane16_swap(__float_as_uint(s), __float_as_uint(s), false, false); s = __uint_as_float(r16[0]) + __uint_as_float(r16[1]); }
                    { auto r32 = __builtin_amdgcn_permlane32_swap(__float_as_uint(s), __float_as_uint(s), false, false); s = __uint_as_float(r32[0]) + __uint_as_float(r32[1]); }
                    if (fq == 0) xr[(ai * 64 + m * 16) * 8 + bj * 4] = s; }
        const f32x4 ga = *(const f32x4*)(gain + dl), gb = *(const f32x4*)(gain + 64 + dl);
        asm volatile("s_waitcnt lgkmcnt(0)" ::: "memory"); __builtin_amdgcn_s_barrier(); asm volatile("" ::: "memory");
        const bool rope = (kind == 2) && latent;
        float cc[2][4], sc[2][4], cd[4], sd[4];
#pragma unroll
        for (int j = 0; j < 4; ++j) { cc[0][j] = 1.f; cc[1][j] = 1.f; sc[0][j] = 0.f; sc[1][j] = 0.f; cd[j] = 1.f; sd[j] = 0.f; }
        if (rope) {
#pragma unroll
            for (int j = 0; j < 4; ++j) {
                const float inv = __builtin_amdgcn_exp2f(-(float)((dl + j) & 31) * (13.287712379549449f / 32.0f)) * 0.15915494309189535f;
                if (wc < 2) {
#pragma unroll
                    for (int ai = 0; ai < 2; ++ai) { float rv = (float)((u.pm * BM + ai * HALF + wr * 64) >> 6) * inv; rv -= floorf(rv); sc[ai][j] = __builtin_amdgcn_sinf(rv); cc[ai][j] = __builtin_amdgcn_cosf(rv); }
                } else {
                    float rv = (float)fr * inv; rv -= floorf(rv); const float s0 = __builtin_amdgcn_sinf(rv), c0 = __builtin_amdgcn_cosf(rv);
                    sc[0][j] = s0; sc[1][j] = s0; cc[0][j] = c0; cc[1][j] = c0;
                    float rd = 16.0f * inv; rd -= floorf(rd); sd[j] = __builtin_amdgcn_sinf(rd); cd[j] = __builtin_amdgcn_cosf(rd);
                }
            }
        }
#pragma unroll
        for (int m = 0; m < 4; ++m) {
#pragma unroll
            for (int ai = 0; ai < 2; ++ai)
#pragma unroll
                for (int bj = 0; bj < 2; ++bj) {
                    const f32x4 pr = *(const LAS f32x4*)(xch + ((wr * 128 + ai * 64 + m * 16 + fr) * 8 + bj * 4));
                    const float rstd = __builtin_amdgcn_rsqf(((pr[0] + pr[1]) + (pr[2] + pr[3])) * (1.0f / 128.0f) + EPS);
                    const f32x4 x1 = acc[ai][bj][m][0] * rstd * ga, x2 = acc[ai][bj][m][1] * rstd * gb;
                    float y1[4], y2[4];
#pragma unroll
                    for (int j = 0; j < 4; ++j) { y1[j] = x1[j] * cc[ai][j] - x2[j] * sc[ai][j]; y2[j] = x1[j] * sc[ai][j] + x2[j] * cc[ai][j]; }
                    bf16_t* p = obase + (size_t)(ai * HALF + m * 16) * ldc + bj * HALF;
                    u32x2 w1, w2; w1.x = cvt_pk_bf16(y1[0], y1[1]); w1.y = cvt_pk_bf16(y1[2], y1[3]); w2.x = cvt_pk_bf16(y2[0], y2[1]); w2.y = cvt_pk_bf16(y2[2], y2[3]);
                    store_pair16(p, w1, w2, fq); }
            if (rope && wc >= 2) {
#pragma unroll
                for (int ai = 0; ai < 2; ++ai)
#pragma unroll
                    for (int j = 0; j < 4; ++j) { const float c = cc[ai][j], s = sc[ai][j]; cc[ai][j] = c * cd[j] - s * sd[j]; sc[ai][j] = s * cd[j] + c * sd[j]; }
            }
        }
    }
};

template <class Epi, bool ALIGN_EPI, bool SP2>
__device__ __forceinline__ void gemm_phase(LAS unsigned char* lds, const Gemm g, const Sched& S, const Epi& E) {
    const int tid = TID(), wid = __builtin_amdgcn_readfirstlane(tid >> 6), lane = tid & 63, wr = wid >> 2, wc = wid & 3, fr = lane & 15, fq = lane >> 4;
    const int K = g.K;
    unsigned voffA[2], voffB[2];
#pragma unroll
    for (int i = 0; i < 2; ++i) { int R, C; stage_rc(tid * 16 + i * 8192, R, C); const int Rb = Epi::PERM == 1 ? ((R & ~31) + perm32(R & 31)) : (Epi::PERM == 2 ? ((R & ~127) + permrope(R & 127)) : R);
        voffA[i] = (unsigned)(R * K + C) * 2u; voffB[i] = (unsigned)(Rb * K + C) * 2u; }
    const size_t kstep = (size_t)(BK * 2);
    const size_t hstep = (size_t)HALF * K * 2;
    const size_t tstep = 2 * hstep;
    const unsigned ldsw = (unsigned)wid * 1024u;
    const int aoff = lds_byte(wr * 64 + fr, fq * 8), boff = lds_byte(wc * 32 + fr, fq * 8);
#define PG8_SA(b, h) (((b) * 2 + (h)) * HTB)
#define PG8_SB(b, h) ((4 + (b) * 2 + (h)) * HTB)
#define PG8_STAGE(bufoff, gbase, voff) do { _Pragma("unroll") for (int _i = 0; _i < 2; ++_i) \
        __builtin_amdgcn_global_load_lds((const unsigned*)((const char*)(gbase) + (voff)[_i]), (LAS unsigned*)(lds + (bufoff) + ldsw + _i * 8192), 16, 0, 0); } while (0)
#define PG8_LDA(dst, b, h) do { _Pragma("unroll") for (int m = 0; m < 4; ++m) _Pragma("unroll") for (int k = 0; k < 2; ++k) dst[m][k] = *(const LAS bf16x8*)(lds + PG8_SA(b, h) + aoff + m * 2048 + k * 1024); } while (0)
#define PG8_LDB(dst, b, h) do { _Pragma("unroll") for (int n = 0; n < 2; ++n) _Pragma("unroll") for (int k = 0; k < 2; ++k) dst[n][k] = *(const LAS bf16x8*)(lds + PG8_SB(b, h) + boff + n * 2048 + k * 1024); } while (0)
#define PG8_MMA(ai, bj, At, Bt) do { __builtin_amdgcn_s_setprio(1); _Pragma("unroll") for (int m = 0; m < 4; ++m) _Pragma("unroll") for (int n = 0; n < 2; ++n) _Pragma("unroll") for (int k = 0; k < 2; ++k) \
        acc[ai][bj][m][n] = __builtin_amdgcn_mfma_f32_16x16x32_bf16(Bt[n][k], At[m][k], acc[ai][bj][m][n], 0, 0, 0); __builtin_amdgcn_s_setprio(0); } while (0)
#define PG8_WAIT_V(n) asm volatile("s_waitcnt vmcnt(" #n ")" ::: "memory")
#define PG8_WAIT_L(n) asm volatile("s_waitcnt lgkmcnt(" #n ")" ::: "memory")
#define PG8_BAR __builtin_amdgcn_s_barrier()
#define PG8_SCHED __builtin_amdgcn_sched_barrier(0)
    Unit cur, nxt; int ui = 0;
    if (!S.next(0, cur)) return;
    f32x4 acc[2][2][4][2];
#pragma unroll
    for (int a = 0; a < 2; ++a)
#pragma unroll
        for (int b = 0; b < 2; ++b)
#pragma unroll
            for (int m = 0; m < 4; ++m)
#pragma unroll
                for (int n = 0; n < 2; ++n) acc[a][b][m][n] = (f32x4){0.f, 0.f, 0.f, 0.f};
    bf16x8 At[4][2], B0[2][2], B1[2][2];
    const char* cA = (const char*)g.A + (size_t)cur.pm * tstep + (size_t)cur.k0 * kstep; const char* cB = (const char*)g.Bt + (size_t)cur.pn * tstep + (size_t)cur.k0 * kstep;
    if constexpr (SP2) {
        PG8_STAGE(PG8_SB(0, 0), cB, voffB); PG8_STAGE(PG8_SB(0, 1), cB + hstep, voffB); PG8_STAGE(PG8_SA(0, 0), cA, voffA); PG8_STAGE(PG8_SA(0, 1), cA + hstep, voffA);
        if (wr == 1) PG8_BAR;
        PG8_WAIT_V(2); PG8_BAR;
        PG8_STAGE(PG8_SB(1, 0), cB + kstep, voffB); PG8_STAGE(PG8_SA(1, 0), cA + kstep, voffA); PG8_STAGE(PG8_SB(1, 1), cB + hstep + kstep, voffB);
        PG8_WAIT_V(6); PG8_BAR;
    } else {
        PG8_STAGE(PG8_SB(0, 0), cB, voffB); PG8_STAGE(PG8_SA(0, 0), cA, voffA); PG8_STAGE(PG8_SB(0, 1), cB + hstep, voffB); PG8_STAGE(PG8_SA(0, 1), cA + hstep, voffA);
        if (wr == 1) PG8_BAR;
        PG8_WAIT_V(4); PG8_BAR;
        PG8_STAGE(PG8_SB(1, 0), cB + kstep, voffB); PG8_STAGE(PG8_SA(1, 0), cA + kstep, voffA); PG8_STAGE(PG8_SB(1, 1), cB + hstep + kstep, voffB);
        PG8_WAIT_V(6); PG8_BAR;
    }
    for (;;) {
        const bool has_next = S.next(ui + 1, nxt);
        const int nt = cur.nt;
        const char* nA = has_next ? (const char*)g.A + (size_t)nxt.pm * tstep + (size_t)nxt.k0 * kstep : cA; const char* nB = has_next ? (const char*)g.Bt + (size_t)nxt.pn * tstep + (size_t)nxt.k0 * kstep : cB;
        for (int t = 0; t < nt; t += 2) {
            const bool last = (t == nt - 2);
            const char* a1 = cA + (size_t)(t + 1) * kstep;
            const char* a2 = last ? nA : cA + (size_t)(t + 2) * kstep; const char* b2 = last ? nB : cB + (size_t)(t + 2) * kstep;
            const char* a3 = a2 + kstep; const char* b3 = b2 + kstep;
            if constexpr (SP2) {
            PG8_LDB(B0, 0, 0); PG8_LDB(B1, 0, 1); PG8_SCHED; PG8_LDA(At, 0, 0); PG8_STAGE(PG8_SA(1, 1), a1 + hstep, voffA);
            PG8_WAIT_V(8); PG8_WAIT_L(0); PG8_BAR; PG8_MMA(0, 0, At, B0); PG8_MMA(0, 1, At, B1); PG8_BAR; PG8_SCHED;
            PG8_LDA(At, 0, 1); PG8_STAGE(PG8_SB(0, 0), b2, voffB); PG8_STAGE(PG8_SB(0, 1), b2 + hstep, voffB); PG8_STAGE(PG8_SA(0, 0), a2, voffA);
            PG8_WAIT_V(8); PG8_WAIT_L(0); PG8_BAR; PG8_MMA(1, 0, At, B0); PG8_MMA(1, 1, At, B1); PG8_BAR; PG8_SCHED;
            PG8_LDB(B0, 1, 0); PG8_LDB(B1, 1, 1); PG8_SCHED; PG8_LDA(At, 1, 0); PG8_STAGE(PG8_SA(0, 1), a2 + hstep, voffA);
            PG8_WAIT_V(8); PG8_WAIT_L(0); PG8_BAR; PG8_MMA(0, 0, At, B0); PG8_MMA(0, 1, At, B1); PG8_BAR; PG8_SCHED;
            PG8_LDA(At, 1, 1); PG8_STAGE(PG8_SB(1, 0), b3, voffB); PG8_STAGE(PG8_SB(1, 1), b3 + hstep, voffB); PG8_STAGE(PG8_SA(1, 0), a3, voffA);
            PG8_WAIT_V(8); PG8_WAIT_L(0); PG8_BAR; PG8_MMA(1, 0, At, B0); PG8_MMA(1, 1, At, B1); PG8_BAR; PG8_SCHED;
            } else {
            PG8_LDB(B0, 0, 0); PG8_SCHED; PG8_LDA(At, 0, 0); PG8_STAGE(PG8_SA(1, 1), a1 + hstep, voffA);
            PG8_WAIT_L(8); PG8_BAR; PG8_WAIT_L(0); PG8_MMA(0, 0, At, B0); PG8_BAR; PG8_SCHED;
            PG8_LDB(B1, 0, 1); PG8_STAGE(PG8_SB(0, 0), b2, voffB);
            PG8_BAR; PG8_WAIT_L(0); PG8_MMA(0, 1, At, B1); PG8_BAR;
            PG8_LDA(At, 0, 1); PG8_STAGE(PG8_SA(0, 0), a2, voffA);
            PG8_BAR; PG8_WAIT_L(0); PG8_MMA(1, 0, At, B0); PG8_BAR; PG8_SCHED;
            PG8_STAGE(PG8_SB(0, 1), b2 + hstep, voffB);
            PG8_WAIT_V(6); PG8_BAR; PG8_MMA(1, 1, At, B1); PG8_BAR;
            PG8_LDB(B0, 1, 0); PG8_SCHED; PG8_LDA(At, 1, 0); PG8_STAGE(PG8_SA(0, 1), a2 + hstep, voffA);
            PG8_WAIT_L(8); PG8_BAR; PG8_WAIT_L(0); PG8_MMA(0, 0, At, B0); PG8_BAR; PG8_SCHED;
            PG8_LDB(B1, 1, 1); PG8_STAGE(PG8_SB(1, 0), b3, voffB);
            PG8_BAR; PG8_WAIT_L(0); PG8_MMA(0, 1, At, B1); PG8_BAR;
            PG8_LDA(At, 1, 1); PG8_STAGE(PG8_SA(1, 0), a3, voffA);
            PG8_BAR; PG8_WAIT_L(0); PG8_MMA(1, 0, At, B0); PG8_BAR; PG8_SCHED;
            PG8_STAGE(PG8_SB(1, 1), b3 + hstep, voffB);
            PG8_WAIT_V(6); PG8_BAR; PG8_MMA(1, 1, At, B1); PG8_BAR;
            }
        }
        if constexpr (ALIGN_EPI) { if (wr == 0) PG8_BAR; }
        E(acc, cur, wr, wc, fr, fq);
        if (!has_next) break;
#pragma unroll
        for (int a = 0; a < 2; ++a)
#pragma unroll
            for (int b = 0; b < 2; ++b)
#pragma unroll
                for (int m = 0; m < 4; ++m)
#pragma unroll
                    for (int n = 0; n < 2; ++n) acc[a][b][m][n] = (f32x4){0.f, 0.f, 0.f, 0.f};
        cur = nxt; cA = nA; cB = nB; ++ui;
        if constexpr (ALIGN_EPI) { if (wr == 1) PG8_BAR; }
    }
    PG8_WAIT_V(0);
    if constexpr (!ALIGN_EPI) { if (wr == 0) PG8_BAR; }
    PG8_BAR;
#undef PG8_SA
#undef PG8_SB
#undef PG8_STAGE
#undef PG8_LDA
#undef PG8_LDB
#undef PG8_MMA
#undef PG8_WAIT_V
#undef PG8_WAIT_L
#undef PG8_BAR
#undef PG8_SCHED
}
}

namespace att {
constexpr int D = 128, NW = 8, QBLK = 32, KVBLK = 64;
constexpr float SCALE = 0.088388347648318440f;
constexpr float INV_SCALE = 11.313708498984761f;
constexpr float THR = 8.f;
constexpr float NEG = -1e30f;
constexpr size_t SHM_V = KVBLK * D * 2, SHM_K = KVBLK * D * 2, SHM_ATTN = 2 * SHM_V + 2 * SHM_K + NW * 64 * 4;
constexpr int OST_OFF = 69632, OST_PITCH = 272, OST_WAVE = 32 * OST_PITCH;
constexpr int BIAS_OFF = (int)SHM_ATTN;
enum { DENSE = 0, NA = 1, SW = 2 };
#define KSWZ(row, colB) ((row) * 256 + ((colB) ^ (((row) & 7) << 4)))
#define SBAR() __builtin_amdgcn_sched_barrier(0)
__device__ __forceinline__ int crow(int r, int hi) { return (r & 3) + 8 * (r >> 2) + 4 * hi; }

__device__ __forceinline__ void partialSM(f32x16& p0, f32x16& p1, float& m_reg, float& mn, float& alpha) {
  constexpr float C = SCALE * 1.4426950408889634f;
  float pmax = p0[0];
#pragma unroll
  for (int r = 1; r < 16; ++r) pmax = fmaxf(pmax, p0[r]);
#pragma unroll
  for (int r = 0; r < 16; ++r) pmax = fmaxf(pmax, p1[r]);
  { auto rr = __builtin_amdgcn_permlane32_swap(__float_as_uint(pmax), __float_as_uint(pmax), false, false);
    pmax = fmaxf(__uint_as_float(rr[0]), __uint_as_float(rr[1])); }
  if (__builtin_expect(__all(pmax - m_reg <= THR / SCALE), 1)) { mn = m_reg; alpha = 1.f; }
  else { mn = fmaxf(m_reg, pmax); alpha = __builtin_amdgcn_exp2f((m_reg - mn) * C); m_reg = mn; }
  float mnC = -mn * C;
#pragma unroll
  for (int r = 0; r < 16; ++r) p0[r] = fmaf(p0[r], C, mnC);
#pragma unroll
  for (int r = 0; r < 16; ++r) p1[r] = fmaf(p1[r], C, mnC);
#pragma unroll
  for (int r = 0; r < 16; ++r) p0[r] = __builtin_amdgcn_exp2f(p0[r]);
}
__device__ __forceinline__ void finishSM(f32x16& p0, f32x16& p1, float alpha, float& l_reg, bf16x8& pa0, bf16x8& pa1, bf16x8& pa2, bf16x8& pa3) {
#pragma unroll
  for (int r = 0; r < 16; ++r) p1[r] = __builtin_amdgcn_exp2f(p1[r]);
  float ps = 0;
#pragma unroll
  for (int r = 0; r < 16; ++r) ps += p0[r];
#pragma unroll
  for (int r = 0; r < 16; ++r) ps += p1[r];
  { auto rr = __builtin_amdgcn_permlane32_swap(__float_as_uint(ps), __float_as_uint(ps), false, false);
    ps = __uint_as_float(rr[0]) + __uint_as_float(rr[1]); }
  l_reg = l_reg * alpha + ps;
#define PK4(P, BASE, OUT) do { unsigned a0 = cvt_pk_bf16(P[BASE + 0], P[BASE + 1]), a1 = cvt_pk_bf16(P[BASE + 2], P[BASE + 3]);   \
    unsigned b0 = cvt_pk_bf16(P[BASE + 4], P[BASE + 5]), b1 = cvt_pk_bf16(P[BASE + 6], P[BASE + 7]);                              \
    auto r0 = __builtin_amdgcn_permlane32_swap(a0, b0, false, false); auto r1 = __builtin_amdgcn_permlane32_swap(a1, b1, false, false); \
    u32x4 w = {r0[0], r1[0], r0[1], r1[1]}; OUT = *reinterpret_cast<bf16x8*>(&w); } while (0)
  PK4(p0, 0, pa0); PK4(p0, 8, pa1); PK4(p1, 0, pa2); PK4(p1, 8, pa3);
#undef PK4
}
__device__ __forceinline__ void qkt(f32x16& p0, f32x16& p1, const bf16_t* Ks, const bf16x8* qr, int r32, int hi) {
  p0 = f32x16{}; p1 = f32x16{};
#pragma unroll
  for (int d0 = 0; d0 < 8; ++d0) { int cb = (d0 * 16 + hi * 8) * 2;
    bf16x8 b0 = *reinterpret_cast<const bf16x8*>((const char*)Ks + KSWZ(r32, cb));
    bf16x8 b1 = *reinterpret_cast<const bf16x8*>((const char*)Ks + KSWZ(32 + r32, cb));
    p0 = __builtin_amdgcn_mfma_f32_32x32x16_bf16(b0, qr[d0], p0, 0, 0, 0);
    p1 = __builtin_amdgcn_mfma_f32_32x32x16_bf16(b1, qr[d0], p1, 0, 0, 0); }
}
__device__ __forceinline__ int v_st(int k, int c) { const int kk = (k & ~0xC) | ((k & 4) << 1) | ((k & 8) >> 1); return ((kk >> 3) * 4 + (c >> 5)) * 512 + ((kk & 7) * 32 + (c & 31)) * 2; }
__device__ __forceinline__ int v_rd_base(int lane) { return ((lane & 3) << 3) | (((lane >> 2) & 3) << 6) | (((lane >> 4) & 1) << 5) | (((lane >> 5) & 1) << 8); }
constexpr int v_rd_off(int d0, int ks, int half) { return d0 * 512 + ks * 4096 + half * 2048; }
template <int OFF> __device__ __forceinline__ s16x4 tr_read(int vb) {
  s16x4 r; asm volatile("ds_read_b64_tr_b16 %0, %1 offset:%2" : "=&v"(r) : "v"(vb), "i"(OFF) : "memory"); return r;
}
template <int D0> __device__ __forceinline__ void pv_one(f32x16& od, int vb, bf16x8 pa0, bf16x8 pa1, bf16x8 pa2, bf16x8 pa3) {
  const s16x4 l0 = tr_read<v_rd_off(D0, 0, 0)>(vb), h0 = tr_read<v_rd_off(D0, 0, 1)>(vb), l1 = tr_read<v_rd_off(D0, 1, 0)>(vb), h1 = tr_read<v_rd_off(D0, 1, 1)>(vb);
  const s16x4 l2 = tr_read<v_rd_off(D0, 2, 0)>(vb), h2 = tr_read<v_rd_off(D0, 2, 1)>(vb), l3 = tr_read<v_rd_off(D0, 3, 0)>(vb), h3 = tr_read<v_rd_off(D0, 3, 1)>(vb);
  asm volatile("s_waitcnt lgkmcnt(0)" ::: "memory"); SBAR();
#define PK(L, H) (bf16x8){L[0], L[1], L[2], L[3], H[0], H[1], H[2], H[3]}
  od = __builtin_amdgcn_mfma_f32_32x32x16_bf16(pa0, PK(l0, h0), od, 0, 0, 0);
  od = __builtin_amdgcn_mfma_f32_32x32x16_bf16(pa1, PK(l1, h1), od, 0, 0, 0);
  od = __builtin_amdgcn_mfma_f32_32x32x16_bf16(pa2, PK(l2, h2), od, 0, 0, 0);
  od = __builtin_amdgcn_mfma_f32_32x32x16_bf16(pa3, PK(l3, h3), od, 0, 0, 0);
#undef PK
}
__device__ __forceinline__ void pv_d0(f32x16* o, int vb, bf16x8 pa0, bf16x8 pa1, bf16x8 pa2, bf16x8 pa3) {
  pv_one<0>(o[0], vb, pa0, pa1, pa2, pa3); pv_one<1>(o[1], vb, pa0, pa1, pa2, pa3); pv_one<2>(o[2], vb, pa0, pa1, pa2, pa3); pv_one<3>(o[3], vb, pa0, pa1, pa2, pa3);
}

struct UnitP { const bf16_t* Q; const bf16_t* K; const bf16_t* V; bf16_t* O; int ldq, ldk, ldo, NT, base_row, qb; float sink_l2e; };

template <int MODE> __device__ __forceinline__ int tile_row0(const UnitP& u, int t) {
  if (MODE == DENSE) return u.base_row + KVBLK * t;
  if (t < 4) return SEQ + KVBLK * t;
  if (MODE == NA) { int R0 = 4 * u.qb - 4; R0 = R0 < 0 ? 0 : (R0 > 120 ? 120 : R0); int kr = R0 + t - 4; kr = kr > 127 ? 127 : kr; return kr * 64; }
  int k0 = 256 * u.qb - 128 + 64 * (t - 4); k0 = k0 < 0 ? 0 : (k0 > SEQ - 64 ? SEQ - 64 : k0); return k0;
}
template <int MODE> __device__ __forceinline__ void mask_tile(f32x16& p0, f32x16& p1, const UnitP& u, int t, int wid, int r32, int hi, const float* biasL) {
  if (MODE == DENSE) return;
  if (t < 4) return;
  if (MODE == SW) {
    const int kpos0 = 256 * u.qb - 128 + 64 * (t - 4); int qpos = 256 * u.qb + wid * 32 + r32; int hi_ = hi;
    asm volatile("" : "+v"(qpos), "+v"(hi_));
#pragma unroll
    for (int r = 0; r < 16; ++r) { const int k0 = kpos0 + crow(r, hi_), k1 = k0 + 32; const int d0 = k0 - qpos, d1 = k1 - qpos;
      const bool v0 = (k0 >= 0) && (k0 < SEQ) && (d0 <= 128) && (d0 >= -128); const bool v1 = (k1 >= 0) && (k1 < SEQ) && (d1 <= 128) && (d1 >= -128);
      p0[r] = v0 ? p0[r] : NEG; p1[r] = v1 ? p1[r] : NEG; }
  } else {
    int R0 = 4 * u.qb - 4; R0 = R0 < 0 ? 0 : (R0 > 120 ? 120 : R0); const int kr = R0 + t - 4;
    const int rq = 4 * u.qb + (wid >> 1); int rs = rq - 4; rs = rs < 0 ? 0 : (rs > 120 ? 120 : rs);
    const bool rowvalid = (kr >= rs) && (kr < rs + 8);
    if (!rowvalid) {
#pragma unroll
      for (int r = 0; r < 16; ++r) { p0[r] = NEG; p1[r] = NEG; }
      return; }
    int cq = (wid & 1) * 32 + r32; int hi_ = hi;
    asm volatile("" : "+v"(cq), "+v"(hi_));
    int cs = cq - 8; cs = cs < 0 ? 0 : (cs > 48 ? 48 : cs);
    int brow = kr - rq + 7; brow = brow < 0 ? 0 : (brow > 14 ? 14 : brow);
    const float* bl = biasL + brow * 31 + 15 - cq;
#pragma unroll
    for (int r = 0; r < 16; ++r) { const int k0 = crow(r, hi_), k1 = k0 + 32;
      const bool v0 = rowvalid && (k0 >= cs) && (k0 < cs + 16); const bool v1 = rowvalid && (k1 >= cs) && (k1 < cs + 16);
      int i0 = k0 - cq; i0 = i0 < -15 ? -15 : (i0 > 15 ? 15 : i0); int i1 = k1 - cq; i1 = i1 < -15 ? -15 : (i1 > 15 ? 15 : i1);
      const float b0 = bl[cq + i0], b1 = bl[cq + i1];
      p0[r] = v0 ? p0[r] + b0 : NEG; p1[r] = v1 ? p1[r] + b1 : NEG;
      SBAR(); }
  }
}

template <int MODE, int SDEPTH>
__device__ __forceinline__ void attn_unit(const UnitP& u, char* lds) {
  const int tid = TID(), wid = tid >> 6, lane = tid & 63, r32 = lane & 31, hi = lane >> 5;
  bf16_t* V_lds = (bf16_t*)lds; bf16_t* K_lds = (bf16_t*)(lds + 2 * SHM_V);
  float* ws = (float*)(lds + 2 * SHM_V + 2 * SHM_K) + wid * 64; float* li_l = ws; float* al_l = ws + 32;
  const float* biasL = (const float*)(lds + BIAS_OFF);
  const bf16_t* __restrict__ Kh = u.K; const bf16_t* __restrict__ Vh = u.V; const int LDK = u.ldk;
  float m_reg = -1e30f, l_reg = 0; f32x16 o[4] = {}; bf16x8 qr[8];
  const bf16_t* Qw = u.Q + (long)(wid * QBLK + r32) * u.ldq + hi * 8;
#pragma unroll
  for (int d0 = 0; d0 < 8; ++d0) qr[d0] = *reinterpret_cast<const bf16x8*>(Qw + d0 * 16);
  const int vb0 = (int)(uintptr_t)V_lds + v_rd_base(lane);
  struct { bf16x8 vs0, vs1, ks0, ks1; } sr_[SDEPTH];
#define SLOAD(i, k0) do { int t_ = tid; if (MODE != DENSE) asm volatile("" : "+v"(t_)); const int sr = t_ >> 4, sc = (t_ & 15) * 8; \
    const long _r0 = (long)((k0) + sr) * LDK + sc, _r1 = (long)((k0) + 32 + sr) * LDK + sc; \
    sr_[i].vs0 = *reinterpret_cast<const bf16x8*>(&Vh[_r0]); sr_[i].vs1 = *reinterpret_cast<const bf16x8*>(&Vh[_r1]); \
    sr_[i].ks0 = *reinterpret_cast<const bf16x8*>(&Kh[_r0]); sr_[i].ks1 = *reinterpret_cast<const bf16x8*>(&Kh[_r1]); } while (0)
#define SWRITE(b, i) do { int t_ = tid; if (MODE != DENSE) asm volatile("" : "+v"(t_)); const int sr = t_ >> 4, sc = (t_ & 15) * 8, vst0 = v_st(sr, sc), vst1 = v_st(32 + sr, sc); \
    *(bf16x8*)((char*)V_lds + (b) * SHM_V + vst0) = sr_[i].vs0;          \
    *(bf16x8*)((char*)V_lds + (b) * SHM_V + vst1) = sr_[i].vs1; int kc = sc * 2;               \
    *(bf16x8*)((char*)K_lds + (b) * SHM_K + KSWZ(sr, kc)) = sr_[i].ks0;                       \
    *(bf16x8*)((char*)K_lds + (b) * SHM_K + KSWZ(32 + sr, kc)) = sr_[i].ks1; } while (0)
#define SWAIT() do { if constexpr (SDEPTH == 2) asm volatile("s_waitcnt vmcnt(4)" ::: "memory"); else asm volatile("s_waitcnt vmcnt(0)" ::: "memory"); } while (0)
#define RESC(a) do { if (__any((a) < 1.f)) { if (hi == 0) al_l[r32] = (a); asm volatile("s_waitcnt lgkmcnt(0)" ::: "memory"); \
    _Pragma("unroll") for (int d = 0; d < 4; ++d) _Pragma("unroll") for (int r = 0; r < 16; ++r) o[d][r] *= al_l[crow(r, hi)]; } } while (0)
#define ROW0(t) tile_row0<MODE>(u, (t))
  f32x16 pA0, pA1, pB0, pB1; float mnA, mnB, alA, alB; bf16x8 pa0, pa1, pa2, pa3; const int NT = u.NT;
  constexpr int SE = 0, SO = SDEPTH - 1;
  SLOAD(SE, ROW0(0)); asm volatile("s_waitcnt vmcnt(0)" ::: "memory"); SWRITE(0, SE); __syncthreads();
  qkt(pA0, pA1, K_lds, qr, r32, hi); mask_tile<MODE>(pA0, pA1, u, 0, wid, r32, hi, biasL); partialSM(pA0, pA1, m_reg, mnA, alA);
  SLOAD(SO, ROW0(1)); if constexpr (SDEPTH == 2) { if (2 < NT) SLOAD(SE, ROW0(2)); }
  SWAIT(); SWRITE(1, SO); __syncthreads();
  for (int j = 1; j + 1 < NT; j += 2) {
    SBAR(); qkt(pB0, pB1, (bf16_t*)((char*)K_lds + SHM_K), qr, r32, hi);
    finishSM(pA0, pA1, alA, l_reg, pa0, pa1, pa2, pa3); SBAR();
    SLOAD(SO, ROW0(j + SDEPTH)); SBAR();
    pv_d0(o, vb0, pa0, pa1, pa2, pa3); mask_tile<MODE>(pB0, pB1, u, j, wid, r32, hi, biasL); partialSM(pB0, pB1, m_reg, mnB, alB);
    __syncthreads(); SWAIT(); SWRITE(0, SE);
    RESC(alB); __syncthreads();
    SBAR(); qkt(pA0, pA1, K_lds, qr, r32, hi);
    finishSM(pB0, pB1, alB, l_reg, pa0, pa1, pa2, pa3); SBAR();
    if (SDEPTH == 1 || j + 3 < NT) SLOAD(SE, ROW0(j + 1 + SDEPTH)); SBAR();
    pv_d0(o, vb0 + (int)SHM_V, pa0, pa1, pa2, pa3); mask_tile<MODE>(pA0, pA1, u, j + 1, wid, r32, hi, biasL); partialSM(pA0, pA1, m_reg, mnA, alA);
    __syncthreads(); SWAIT(); SWRITE(1, SO);
    RESC(alA); __syncthreads();
  }
  SBAR(); qkt(pB0, pB1, (bf16_t*)((char*)K_lds + SHM_K), qr, r32, hi);
  finishSM(pA0, pA1, alA, l_reg, pa0, pa1, pa2, pa3); SBAR();
  pv_d0(o, vb0, pa0, pa1, pa2, pa3); mask_tile<MODE>(pB0, pB1, u, NT - 1, wid, r32, hi, biasL); partialSM(pB0, pB1, m_reg, mnB, alB);
  __syncthreads(); RESC(alB);
  finishSM(pB0, pB1, alB, l_reg, pa0, pa1, pa2, pa3); SBAR();
  pv_d0(o, vb0 + (int)SHM_V, pa0, pa1, pa2, pa3);
  l_reg += __builtin_amdgcn_exp2f(u.sink_l2e - m_reg * (SCALE * 1.4426950408889634f));
  if (hi == 0) li_l[r32] = l_reg; asm volatile("s_waitcnt lgkmcnt(0)" ::: "memory");
  float rli[16];
#pragma unroll
  for (int r = 0; r < 16; ++r) rli[r] = __builtin_amdgcn_rcpf(li_l[crow(r, hi)]);
  bf16_t* Ow = u.O + (long)(wid * QBLK) * u.ldo;
  { char* ostg = lds + OST_OFF + wid * OST_WAVE;
#pragma unroll
    for (int r = 0; r < 16; ++r) { const int orow = crow(r, hi);
#pragma unroll
      for (int d0 = 0; d0 < 4; ++d0) { const float v = o[d0][r] * rli[r]; *(bf16_t*)(ostg + orow * OST_PITCH + (d0 * 32 + r32) * 2) = (bf16_t)(cvt_pk_bf16(v, v) & 0xffffu); } }
    asm volatile("s_waitcnt lgkmcnt(0)" ::: "memory");
#pragma unroll
    for (int i = 0; i < 8; ++i) { const int row = i * 4 + (lane >> 4), ch = lane & 15; const u32x4 v = *(const u32x4*)(ostg + row * OST_PITCH + ch * 16); *(u32x4*)(Ow + (long)row * u.ldo + ch * 8) = v; } }
  __syncthreads();
#undef SLOAD
#undef SWRITE
#undef SWAIT
#undef RESC
#undef ROW0
}
#undef KSWZ
#undef SBAR
}

struct Args { const float* in[22]; float* out; unsigned char* ws; int ph_lo, ph_hi; };
#define CAS __attribute__((address_space(4)))
__device__ __forceinline__ const float* INP(int i) { const CAS char* k = (const CAS char*)__builtin_amdgcn_kernarg_segment_ptr(); asm volatile("" : "+s"(k)); return *(const float* const CAS*)(k + 8 * i); }
__device__ __forceinline__ float* OUTP() { const CAS char* k = (const CAS char*)__builtin_amdgcn_kernarg_segment_ptr(); asm volatile("" : "+s"(k)); return *(float* const CAS*)(k + 8 * 22); }
__device__ __forceinline__ unsigned char* WSP() { const CAS char* k = (const CAS char*)__builtin_amdgcn_kernarg_segment_ptr(); asm volatile("" : "+s"(k)); return *(unsigned char* const CAS*)(k + 8 * 23); }
enum { I_X = 0, I_C, I_CTX, I_CCTX, I_ADAW, I_ADAB, I_NORMG, I_WG, I_WU, I_WD, I_ABIN, I_ABOUT, I_NAQG, I_NAKG, I_NABIAS, I_SWQG, I_SWKG, I_SINK, I_GIN, I_GOUT, I_GQG, I_GKG };

__device__ __forceinline__ unsigned f2bf(float f) { unsigned u = __builtin_bit_cast(unsigned, f); return (u + 0x7fffu + ((u >> 16) & 1u)) >> 16; }
__device__ __forceinline__ unsigned pk2(float lo, float hi) { return f2bf(lo) | (f2bf(hi) << 16); }
template <bool DEEP> __device__ __forceinline__ void transpose_item(const float* __restrict__ W, int K, int N, bf16_t* WT, int mode, LAS float* scr, int item, int lane) {
    const int nblk = N / 32, kb = item / nblk, nb = item % nblk, k0 = 64 * kb, n0 = 32 * nb;
    if constexpr (DEEP) {
        float t[32];
#pragma unroll
        for (int i = 0; i < 32; ++i) { const int kk = 2 * i + (lane >> 5); t[i] = W[(size_t)(k0 + kk) * N + n0 + (lane & 31)]; }
#pragma unroll
        for (int i = 0; i < 32; ++i) { const int kk = 2 * i + (lane >> 5); scr[kk * 33 + (lane & 31)] = t[i]; }
    } else {
#pragma unroll 8
    for (int i = 0; i < 32; ++i) { const int kk = 2 * i + (lane >> 5); scr[kk * 33 + (lane & 31)] = W[(size_t)(k0 + kk) * N + n0 + (lane & 31)]; }
    }
    asm volatile("s_waitcnt lgkmcnt(0)" ::: "memory");
    const int c = lane & 7;
    const int rbase = (mode == 0) ? n0 : ((n0 >> 7) * 256 + (n0 & 127) + (mode == 2 ? 128 : 0));
#pragma unroll
    for (int j = 0; j < 4; ++j) { const int n = (lane >> 3) + 8 * j; const LAS float* s = scr + (8 * c) * 33 + n;
        u32x4 o; o.x = pk2(s[0 * 33], s[1 * 33]); o.y = pk2(s[2 * 33], s[3 * 33]); o.z = pk2(s[4 * 33], s[5 * 33]); o.w = pk2(s[6 * 33], s[7 * 33]);
        *(u32x4*)(WT + (size_t)(rbase + n) * K + k0 + 8 * c) = o; }
    asm volatile("s_waitcnt lgkmcnt(0)" ::: "memory");
}
constexpr int CV_GU1 = (DM / 64) * (FF / 32), CV_D1 = (FF / 64) * (DM / 32);
constexpr int CV_GU = 8 * CV_GU1, CV_D = 4 * CV_D1, CV_ABI = (DM / 64) * (AB_IN / 32), CV_SQ = (DM / 64) * (DM / 32), CV_GI = (DM / 64) * (C_IN / 32);
constexpr int CV_NP0 = 4 * CV_GU1 + 2 * CV_D1 + CV_ABI + CV_SQ;
constexpr int CV_NDEF = 3 * CV_GU1 + CV_GI + CV_SQ + 3 * CV_GU1;
__device__ __forceinline__ int cv_p0_to_full(int p) {
    if (p < 4 * CV_GU1) return p;
    p -= 4 * CV_GU1; if (p < 2 * CV_D1) return CV_GU + p;
    p -= 2 * CV_D1; if (p < CV_ABI) return CV_GU + CV_D + p;
    p -= CV_ABI; return CV_GU + CV_D + CV_ABI + p;
}
__device__ __forceinline__ int cv_def_to_full(int d) {
    if (d < 3 * CV_GU1) { const int sub = d / CV_GU1, r = d - sub * CV_GU1; return sub < 2 ? (2 * 2 + sub) * CV_GU1 + r : CV_GU + 2 * CV_D1 + r; }
    d -= 3 * CV_GU1; if (d < CV_GI) return CV_GU + CV_D + CV_ABI + CV_SQ + d;
    d -= CV_GI; if (d < CV_SQ) return CV_GU + CV_D + CV_ABI + CV_SQ + CV_GI + d;
    d -= CV_SQ; { const int sub = d / CV_GU1, r = d - sub * CV_GU1; return sub < 2 ? (3 * 2 + sub) * CV_GU1 + r : CV_GU + 3 * CV_D1 + r; }
}
template <bool DEEP> __device__ __forceinline__ void convert_item(int it, LAS float* scr, int lane) {
    bf16_t* wgu = (bf16_t*)(WSP() + WS_WGU); bf16_t* wd = (bf16_t*)(WSP() + WS_WD);
    int r = it;
    if (r < CV_GU) { const int q = r / CV_GU1, lf = q >> 1, gu = q & 1; r -= q * CV_GU1;
        transpose_item<DEEP>((gu ? INP(I_WU) : INP(I_WG)) + (size_t)lf * DM * FF, DM, FF, wgu + (size_t)lf * WGU_ELEMS, 1 + gu, scr, r, lane); return; }
    r -= CV_GU;
    if (r < CV_D) { const int lf = r / CV_D1; r -= lf * CV_D1; transpose_item<DEEP>(INP(I_WD) + (size_t)lf * FF * DM, FF, DM, wd + (size_t)lf * WD_ELEMS, 0, scr, r, lane); return; }
    r -= CV_D;
    if (r < CV_ABI) { transpose_item<DEEP>(INP(I_ABIN), DM, AB_IN, (bf16_t*)(WSP() + WS_WABIN), 0, scr, r, lane); return; }
    r -= CV_ABI;
    if (r < CV_SQ) { transpose_item<DEEP>(INP(I_ABOUT), DM, DM, (bf16_t*)(WSP() + WS_WABOUT), 0, scr, r, lane); return; }
    r -= CV_SQ;
    if (r < CV_GI) { transpose_item<DEEP>(INP(I_GIN), DM, C_IN, (bf16_t*)(WSP() + WS_WGIN), 0, scr, r, lane); return; }
    r -= CV_GI;
    transpose_item<DEEP>(INP(I_GOUT), DM, DM, (bf16_t*)(WSP() + WS_WGOUT), 0, scr, r, lane);
}
__device__ __forceinline__ void phase0(const Args& a, unsigned char* lds_g, int G) {
    const int tid = TID(), lane = tid & 63, wave = tid >> 6; const int bid = BID();
    float* sc = (float*)lds_g;
    float* red = sc + 4096;
    for (int i = tid; i < DM; i += 512) { const float c = INP(I_C)[i]; sc[i] = c / (1.0f + __expf(-c)); const float cc = INP(I_CCTX)[i]; sc[DM + i] = cc / (1.0f + __expf(-cc)); }
    __syncthreads();
    float* mod = (float*)(WSP() + WS_MOD);
    for (int unit = bid; unit < 256; unit += G) {
        const int layer = unit >> 7, col0 = (unit & 127) * 144;
        f32x4 a1 = {0.f, 0.f, 0.f, 0.f}, a2 = {0.f, 0.f, 0.f, 0.f};
        if (lane < 36) {
            const float* W = INP(I_ADAW) + (size_t)layer * DM * NMODV + col0 + 4 * lane;
            for (int k = wave * 256; k < wave * 256 + 256; k += 8) {
                f32x4 w[8];
#pragma unroll
                for (int q = 0; q < 8; ++q) w[q] = __builtin_nontemporal_load((const f32x4*)(W + (size_t)(k + q) * NMODV));
#pragma unroll
                for (int q = 0; q < 8; ++q) { a1 += w[q] * sc[k + q]; a2 += w[q] * sc[DM + k + q]; }
            }
#pragma unroll
            for (int e = 0; e < 4; ++e) { red[(wave * 2 + 0) * 144 + 4 * lane + e] = a1[e]; red[(wave * 2 + 1) * 144 + 4 * lane + e] = a2[e]; }
        }
        __syncthreads();
        if (tid < 288) { const int v = tid / 144, j = tid % 144; float s = INP(I_ADAB)[layer * NMODV + col0 + j];
#pragma unroll
            for (int w = 0; w < 8; ++w) s += red[(w * 2 + v) * 144 + j];
            mod[(size_t)(layer * 2 + v) * NMODV + col0 + j] = s; }
        __syncthreads();
    }
    LAS float* scr = (LAS float*)((LAS unsigned char*)lds_g + wave * 16384);
    const int gw = bid * 8 + wave, NGW = G * 8;
    for (int p = gw; p < CV_NP0; p += NGW) convert_item<false>(cv_p0_to_full(p), scr, lane);
    for (int d = (G == 256 ? SIDE_END : 0) + gw; d < CV_NDEF; d += NGW) convert_item<false>(cv_def_to_full(d), scr, lane);
}
__device__ __forceinline__ void side_convert(unsigned char* lds_g, int idle_from, int quota, int base, int end) {
    const int bid = BID();
    if (bid < idle_from) return;
    const int tid = TID(), lane = tid & 63, wave = tid >> 6;
    LAS float* scr = (LAS float*)((LAS unsigned char*)lds_g + wave * 16384);
    const int first = base + ((bid - idle_from) * 8 + wave) * quota;
    for (int q = 0; q < quota; ++q) { const int d = first + q; if (d < end) convert_item<true>(cv_def_to_full(d), scr, lane); }
}

__device__ __forceinline__ void modulate_phase(const float* xsrc, const float* csrc, float* cdst, const float* part, int nsplit, const float* cgate, float ccoef,
                                               const float* g, const float* shift_l, const float* scale_l, const float* shift_c, const float* scale_c, bf16_t* h, int nrows, int G, unsigned char* lds_g) {
    const int tid = TID(), lane = tid & 63, wave = tid >> 6;
    const int bid = BID();
    if (nrows > SEQ) {
        float* red = (float*)lds_g;
        float* ssl = red + 8 * DM;
        for (int r = bid; r < CTXL; r += G) {
            f32x4 s[8];
#pragma unroll
            for (int j = 0; j < 8; ++j) s[j] = (f32x4){0.f, 0.f, 0.f, 0.f};
            for (int sp = wave; sp < nsplit; sp += 8) { const f32x4* pr = (const f32x4*)(part + ((size_t)sp * 256 + r) * DM) + lane;
#pragma unroll
                for (int j = 0; j < 8; ++j) s[j] += pr[64 * j]; }
#pragma unroll
            for (int j = 0; j < 8; ++j) *((f32x4*)(red + wave * DM) + lane + 64 * j) = s[j];
            __syncthreads();
            const int col = wave * 256 + 4 * lane;
            f32x4 t = *(const f32x4*)(red + col);
#pragma unroll
            for (int w = 1; w < 8; ++w) t += *(const f32x4*)(red + w * DM + col);
            f32x4 v = *(const f32x4*)(csrc + (size_t)r * DM + col);
            if (nsplit > 0) v += ccoef * (*(const f32x4*)(cgate + col)) * t;
            *(f32x4*)(cdst + (size_t)r * DM + col) = v;
            const float ssw = wave_sum((v.x * v.x + v.y * v.y) + (v.z * v.z + v.w * v.w));
            if (lane == 0) ssl[wave] = ssw;
            __syncthreads();
            float ss = 0.f;
#pragma unroll
            for (int w = 0; w < 8; ++w) ss += ssl[w];
            const float rstd = 1.0f / sqrtf(ss * (1.0f / DM) + EPS);
            const f32x4 y = (v * rstd) * (*(const f32x4*)(g + col)); const f32x4 z = y * (*(const f32x4*)(scale_c + col) + 1.0f) + *(const f32x4*)(shift_c + col);
            u32x2 w2; w2.x = cvt_pk_bf16(z.x, z.y); w2.y = cvt_pk_bf16(z.z, z.w); *(u32x2*)(h + (size_t)(SEQ + r) * DM + col) = w2;
            __syncthreads();
        }
    }
    const int gw = bid * 8 + wave, NGW = G * 8;
    for (int row = gw; row < SEQ; row += NGW) {
        f32x4 v[8];
        const f32x4* xr = (const f32x4*)(xsrc + (size_t)row * DM) + lane;
#pragma unroll
        for (int j = 0; j < 8; ++j) v[j] = xr[64 * j];
        float ss = 0.f;
#pragma unroll
        for (int j = 0; j < 8; ++j) ss += (v[j].x * v[j].x + v[j].y * v[j].y) + (v[j].z * v[j].z + v[j].w * v[j].w);
        const float rstd = 1.0f / sqrtf(wave_sum(ss) * (1.0f / DM) + EPS);
        const f32x4* sh = (const f32x4*)shift_l + lane; const f32x4* scl = (const f32x4*)scale_l + lane;
        const f32x4* gg = (const f32x4*)g + lane;
        u32x2* ho = (u32x2*)(h + (size_t)row * DM) + lane;
#pragma unroll
        for (int j = 0; j < 8; ++j) { const f32x4 y = (v[j] * rstd) * gg[64 * j]; const f32x4 z = y * (scl[64 * j] + 1.0f) + sh[64 * j];
            u32x2 w; w.x = cvt_pk_bf16(z.x, z.y); w.y = cvt_pk_bf16(z.z, z.w); ho[64 * j] = w; }
    }
}

__device__ __forceinline__ void attn_phase0(const Args& a, unsigned char* lds_g, int G) {
    bf16_t* P = (bf16_t*)(WSP() + WS_P); bf16_t* O = (bf16_t*)(WSP() + WS_O);
    float* biasL = (float*)(lds_g + att::BIAS_OFF);
    const int tid0 = TID();
    for (int un = BID(); un < 528; un += G) {
        att::UnitP u; u.ldq = AB_IN; u.ldk = AB_IN; u.ldo = DM; u.sink_l2e = -INFINITY;
        if (un < 256) {
            const int h = un & 7, qb = un >> 3;
            for (int i = tid0; i < 465; i += 512) biasL[i] = INP(I_NABIAS)[h * 465 + i] * att::INV_SCALE;
            __syncthreads();
            u.Q = P + (size_t)(256 * qb) * AB_IN + h * 128; u.K = P + (16 + h) * 128; u.V = P + (24 + h) * 128; u.O = O + (size_t)(256 * qb) * DM + h * 128;
            u.NT = 16; u.base_row = 0; u.qb = qb;
            att::attn_unit<att::NA, 1>(u, (char*)lds_g);
        } else if (un < 512) {
            const int hq = (un - 256) & 7, qb = (un - 256) >> 3, kvh = hq >> 2;
            u.Q = P + (size_t)(256 * qb) * AB_IN + (8 + hq) * 128; u.K = P + (32 + kvh) * 128; u.V = P + (34 + kvh) * 128; u.O = O + (size_t)(256 * qb) * DM + (8 + hq) * 128;
            u.NT = 12; u.base_row = 0; u.qb = qb; u.sink_l2e = INP(I_SINK)[hq] * 1.4426950408889634f;
            att::attn_unit<att::SW, 1>(u, (char*)lds_g);
        } else {
            const int hh = un - 512;
            u.Q = P + (size_t)SEQ * AB_IN + hh * 128; u.O = O + (size_t)SEQ * DM + hh * 128;
            const bool nah = hh < 8; const int hq = nah ? 0 : hh - 8, kvh = hq >> 2;
            const int kslot = nah ? 16 + hh : 32 + kvh, vslot = nah ? 24 + hh : 34 + kvh;
            u.K = P + kslot * 128; u.V = P + vslot * 128;
            const float sk = INP(I_SINK)[hq] * 1.4426950408889634f; u.sink_l2e = nah ? -INFINITY : sk;
            u.NT = 4; u.base_row = SEQ; u.qb = 0;
            att::attn_unit<att::DENSE, 2>(u, (char*)lds_g);
        }
    }
}
__device__ __forceinline__ void attn_phase1(const Args& a, unsigned char* lds_g, int G) {
    bf16_t* P = (bf16_t*)(WSP() + WS_P); bf16_t* O = (bf16_t*)(WSP() + WS_O);
    const int bid = BID();
    for (int i = 0;; ++i) {
        int un;
        if ((G & 7) == 0) { const int x = bid & 7, j = (bid >> 3) + i * (G >> 3); if (j >= 64) break; un = x * 64 + j; }
        else { un = bid + i * G; if (un >= 512) break; }
        const int h = un >> 5, qb = un & 31, kvh = h >> 2;
        att::UnitP u; u.ldq = C_IN; u.ldk = C_IN; u.ldo = DM; u.sink_l2e = -INFINITY;
        u.Q = P + (size_t)(256 * qb) * C_IN + h * 128; u.K = P + (16 + kvh) * 128; u.V = P + (20 + kvh) * 128; u.O = O + (size_t)(256 * qb) * DM + h * 128;
        u.NT = MT / 64; u.base_row = 0; u.qb = qb;
        att::attn_unit<att::DENSE, 2>(u, (char*)lds_g);
    }
}

#define XB_TMO      128
#define XB_XCNT(j)  (256  + 64 * (j))
#define XB_XSUB(j)  (1280 + 64 * (j))
#define XB_XGEN(j)  (2304 + 64 * (j))
#define XB_TOP      3328
#define XB_TOPGEN   3392
#define XCD_BAR_WORDS 3456
#define XB_SPIN_CAP (1u << 18)
__device__ __forceinline__ unsigned xb_ld(unsigned* p)              { return __hip_atomic_load(p, __ATOMIC_RELAXED, __HIP_MEMORY_SCOPE_AGENT); }
__device__ __forceinline__ unsigned xb_add(unsigned* p, unsigned v) { return __hip_atomic_fetch_add(p, v, __ATOMIC_RELAXED, __HIP_MEMORY_SCOPE_AGENT); }
__device__ __forceinline__ unsigned xb_xcc_id() { return (unsigned)__builtin_amdgcn_s_getreg((3 << 11) | 20) & 0xFu; }
#define XB_SPIN(cond, bar) do { unsigned _sp = 0; while (cond) { __builtin_amdgcn_s_sleep(1); \
    if ((++_sp & 255u) == 0u) { if (xb_ld(&(bar)[XB_TMO])) break; if (_sp > XB_SPIN_CAP) { atomicAdd(&(bar)[XB_TMO], 1u); break; } } } } while (0)
struct XcdBarrier { unsigned* bar; unsigned x; volatile LAS unsigned* st; };
__device__ __forceinline__ XcdBarrier xcd_barrier_post(unsigned* bar, volatile LAS unsigned* st) {
    XcdBarrier b; b.bar = bar; b.x = xb_xcc_id(); b.st = st;
    if (threadIdx.x == 0) (void)xb_add(&bar[XB_XCNT(b.x)], 1u);
    return b;
}
__device__ __forceinline__ void xcd_barrier_complete(unsigned* bar, unsigned x, unsigned& nloc, unsigned& nx) {
    const unsigned G = gridDim.x * gridDim.y * gridDim.z;
    unsigned sum, cnt, mine, sp = 0u;
    for (;;) {
        sum = 0u; cnt = 0u; mine = 0u;
#pragma unroll
        for (unsigned j = 0; j < 16; ++j) { const unsigned c = xb_ld(&bar[XB_XCNT(j)]); sum += c; cnt += (c > 0u) ? 1u : 0u; mine = (j == x) ? c : mine; }
        if (sum == G) break;
        __builtin_amdgcn_s_sleep(1);
        if ((++sp & 255u) == 0u) { if (xb_ld(&bar[XB_TMO])) break; if (sp > XB_SPIN_CAP) { atomicAdd(&bar[XB_TMO], 1u); break; } }
    }
    nloc = mine > 0u ? mine : 1u; nx = cnt > 0u ? cnt : 1u;
}
__device__ __forceinline__ void xcd_barrier(const XcdBarrier& b) {
    asm volatile("s_waitcnt vmcnt(0)" ::: "memory");
    __syncthreads();
    if (threadIdx.x == 0) {
        unsigned* bar = b.bar;
        __builtin_amdgcn_s_waitcnt(0);
        unsigned nloc = b.st[0], nx = b.st[1];
        if (nloc == 0u) { xcd_barrier_complete(bar, b.x, nloc, nx); b.st[0] = nloc; b.st[1] = nx; }
        const unsigned old = xb_add(&bar[XB_XSUB(b.x)], 1u);
        const unsigned gen = old / nloc;
        if (old + 1u == (gen + 1u) * nloc) {
            __builtin_amdgcn_fence(__ATOMIC_RELEASE, "agent");
            asm volatile("s_waitcnt vmcnt(0)" ::: "memory");
            const unsigned og = xb_add(&bar[XB_TOP], 1u);
            const unsigned tg = og / nx;
            if (og + 1u == (tg + 1u) * nx) xb_add(&bar[XB_TOPGEN], 1u);
            else XB_SPIN(xb_ld(&bar[XB_TOPGEN]) == tg, bar);
            __builtin_amdgcn_fence(__ATOMIC_ACQUIRE, "agent");
            xb_add(&bar[XB_XGEN(b.x)], 1u);
            asm volatile("s_waitcnt vmcnt(0)" ::: "memory");
        } else {
            XB_SPIN(xb_ld(&bar[XB_XGEN(b.x)]) == gen, bar);
            __builtin_amdgcn_fence(__ATOMIC_ACQUIRE, "agent");
            asm volatile("s_waitcnt vmcnt(0)" ::: "memory");
        }
    }
    __syncthreads();
}

__global__ void __launch_bounds__(512, 2) mk_fwd(Args a) {
    extern __shared__ __attribute__((aligned(16))) unsigned char lds[];
    cg::grid_group grid = cg::this_grid();
    const int G = gridDim.x;
    LAS unsigned char* lds3 = (LAS unsigned char*)lds;
    volatile LAS unsigned* misc = (volatile LAS unsigned*)(lds3 + MISC_OFF);
    if (threadIdx.x < 2) misc[threadIdx.x] = 0u;
    __syncthreads();
    XcdBarrier bar = xcd_barrier_post((unsigned*)(WSP() + WS_BAR), misc);
    float* mod = (float*)(WSP() + WS_MOD);
    float* xc = (float*)(WSP() + WS_XC); float* part = (float*)(WSP() + WS_PART);
    bf16_t* H = (bf16_t*)(WSP() + WS_H); bf16_t* O = (bf16_t*)(WSP() + WS_O); bf16_t* P = (bf16_t*)(WSP() + WS_P); bf16_t* A = (bf16_t*)(WSP() + WS_A);
    for (int ph = a.ph_lo; ph < a.ph_hi; ++ph) {
        if (ph == 0) { phase0(a, lds, G); if (REPMASK & 1) { __syncthreads(); phase0(a, lds, G); } }
        else {
            const int layer = (ph - 1) / 10, sub = (ph - 1) % 10;
            const float* mL = mod + (size_t)(layer * 2 + 0) * NMODV; const float* mC = mod + (size_t)(layer * 2 + 1) * NMODV;
            const bool with_ctx = layer == 0;
            if (sub == 0 || sub == 3 || sub == 7) {
                const int k = sub == 0 ? 0 : (sub == 3 ? 1 : 2);
                const bool first = (ph == 1);
                const float* xsrc = (ph <= 3) ? INP(I_X) : OUTP();
                const float* csrc = first ? INP(I_CTX) : xc;
                const bool upd_prev = (sub == 0 && layer == 1);
                const int nsplit = (upd_prev || sub == 3) ? NSPLIT_DOWN : ((sub == 7) ? NSPLIT_OUT : 0);
                const float* cgate = upd_prev ? (mod + (size_t)(0 * 2 + 1) * NMODV + 8 * DM) : (sub == 3 ? mC + 2 * DM : mC + 5 * DM);
                const float ccoef = (sub == 7) ? 1.0f : 0.5f;
                const int nrows = (sub == 7 && !with_ctx) ? SEQ : MT;
                modulate_phase(xsrc, csrc, xc, part, nsplit, cgate, ccoef, INP(I_NORMG) + (size_t)(layer * 3 + k) * DM,
                               mL + (3 * k) * DM, mL + (3 * k + 1) * DM, mC + (3 * k) * DM, mC + (3 * k + 1) * DM, H, nrows, G, lds);
            } else if (sub == 1 || sub == 8) {
                const int f = sub == 1 ? 0 : 1; const int nM = (f == 1 && !with_ctx) ? SEQ / 256 : MT / 256;
                pg8::Gemm g{H, (const bf16_t*)(WSP() + WS_WGU) + (size_t)(layer * 2 + f) * WGU_ELEMS, DM};
                pg8::Sched S; S.init(nM, 2 * FF / 256, DM, G, BID(), 0, 0, 0);
                pg8::EpiSwiGLU E{A, FF};
                pg8::gemm_phase<pg8::EpiSwiGLU, true, true>(lds3, g, S, E);
                if (REPMASK & 2) pg8::gemm_phase<pg8::EpiSwiGLU, true, true>(lds3, g, S, E);
                if (nM == MT / 256) { const int idle = (nM * (2 * FF / 256)) % G;
                    if (G == 256) { if (ph == 2) side_convert(lds, idle, SIDE_Q, 0, SIDE_E0); else if (ph == 9) side_convert(lds, idle, SIDE_Q, SIDE_E1, SIDE_E2); else if (ph == 12) side_convert(lds, idle, SIDE_Q, SIDE_E2, SIDE_E3 < SIDE_END ? SIDE_E3 : SIDE_END); } }
            } else if (sub == 2 || sub == 9) {
                const int f = sub == 2 ? 0 : 1; const bool ctxrows = !(f == 1 && !with_ctx);
                pg8::Gemm g{A, (const bf16_t*)(WSP() + WS_WD) + (size_t)(layer * 2 + f) * WD_ELEMS, FF};
                pg8::Sched S; S.init(SEQ / 256, DM / 256, FF, G, BID(), ctxrows ? NSPLIT_DOWN : 0, NT_SPLIT_DOWN, SEQ / 256);
                pg8::EpiResid E{(ph == 3) ? INP(I_X) : (const float*)OUTP(), OUTP(), mL + (f == 0 ? 2 : 8) * DM, 0.5f, part};
                pg8::gemm_phase<pg8::EpiResid, true, true>(lds3, g, S, E);
                if (REPMASK & 256) { pg8::EpiResid E2{(const float*)P, (float*)P, mL + (f == 0 ? 2 : 8) * DM, 0.5f, part}; pg8::gemm_phase<pg8::EpiResid, true, true>(lds3, g, S, E2); }
            } else if (sub == 4) {
                const int N = layer == 0 ? AB_IN : C_IN;
                pg8::Gemm g{H, (const bf16_t*)(WSP() + (layer == 0 ? WS_WABIN : WS_WGIN)), DM};
                pg8::Sched S; S.init(MT / 256, N / 256, DM, G, BID(), 0, 0, 0);
                pg8::EpiQK E{P, N, layer, layer == 0 ? INP(I_NAQG) : INP(I_GQG), layer == 0 ? INP(I_SWQG) : INP(I_GKG), INP(I_NAKG), INP(I_SWKG), (LAS float*)(lds3 + XCH_OFF)};
                pg8::gemm_phase<pg8::EpiQK, true, true>(lds3, g, S, E);
                if (REPMASK & 16) pg8::gemm_phase<pg8::EpiQK, true, true>(lds3, g, S, E);
                if (G == 256) { if (layer == 0) side_convert(lds, ((MT / 256) * (AB_IN / 256)) % G, SIDE_Q, SIDE_E0, SIDE_E1); else side_convert(lds, ((MT / 256) * (C_IN / 256)) % G, SIDE_Q, SIDE_E3 < SIDE_END ? SIDE_E3 : SIDE_END, SIDE_END); }
            }
            else if (sub == 5) { if (layer == 0) { attn_phase0(a, lds, G); if (REPMASK & 32) attn_phase0(a, lds, G); } else { attn_phase1(a, lds, G); if (REPMASK & 4) attn_phase1(a, lds, G); } }
            else if (sub == 6) {
                pg8::Gemm g{O, (const bf16_t*)(WSP() + (layer == 0 ? WS_WABOUT : WS_WGOUT)), DM};
                pg8::Sched S; S.init(SEQ / 256, DM / 256, DM, G, BID(), with_ctx ? NSPLIT_OUT : 0, NT_SPLIT_OUT, SEQ / 256);
                pg8::EpiResid E{OUTP(), OUTP(), mL + 5 * DM, 1.0f, part};
                pg8::gemm_phase<pg8::EpiResid, true, true>(lds3, g, S, E);
                if (REPMASK & 512) { pg8::EpiResid E2{(const float*)A, (float*)A, mL + 5 * DM, 1.0f, part}; pg8::gemm_phase<pg8::EpiResid, true, true>(lds3, g, S, E2); }
            }
        }
        if (ph + 1 < a.ph_hi) {
            if (a.ph_lo < 0) grid.sync(); else xcd_barrier(bar);
            if (REPMASK & 8) xcd_barrier(bar); }
    }
}

extern "C" void kernel_launch(void* const* d_in, const int* in_sizes, int n_in, void* d_out, int out_size, void* d_ws, size_t ws_size, hipStream_t stream) {
    static int grid = 0;
    if (grid == 0) {
        if (n_in != 22 || out_size != SEQ * DM || ws_size < WS_END) { fprintf(stderr, "kernel_launch: unexpected shapes (n_in %d out %d ws %zu)\n", n_in, out_size, ws_size); grid = -1; return; }
        int dev = 0, cus = 0, per_cu = 0;
        hipGetDevice(&dev); hipDeviceGetAttribute(&cus, hipDeviceAttributeMultiprocessorCount, dev);
        if (hipFuncSetAttribute((const void*)mk_fwd, hipFuncAttributeMaxDynamicSharedMemorySize, LDS_BYTES) != hipSuccess) { fprintf(stderr, "kernel_launch: hipFuncSetAttribute failed\n"); grid = -1; return; }
        if (hipOccupancyMaxActiveBlocksPerMultiprocessor(&per_cu, (const void*)mk_fwd, 512, LDS_BYTES) != hipSuccess || per_cu < 1) { fprintf(stderr, "kernel_launch: occupancy query gave %d\n", per_cu); per_cu = 1; }
        (void)hipGetLastError();
        grid = cus * per_cu;
        if (grid > 256) grid = 256;
    }
    if (grid < 0) return;
    if (hipMemsetAsync((char*)d_ws + WS_BAR, 0, BAR_BYTES, stream) != hipSuccess) { fprintf(stderr, "kernel_launch: memset failed\n"); return; }
    Args a{};
    for (int i = 0; i < 22; ++i) a.in[i] = (const float*)d_in[i];
    a.out = (float*)d_out; a.ws = (unsigned char*)d_ws;
#if MK_MULTI
    for (int p = 0; p < NPHASE; ++p) { a.ph_lo = p; a.ph_hi = p + 1; hipLaunchKernelGGL(mk_fwd, dim3(grid), dim3(512), LDS_BYTES, stream, a); }
#else
    a.ph_lo = 0; a.ph_hi = NPHASE;
    void* args[] = {&a};
    hipError_t e = hipLaunchCooperativeKernel((const void*)mk_fwd, dim3(grid), dim3(512), args, LDS_BYTES, stream);
    if (e != hipSuccess) fprintf(stderr, "cooperative launch failed: %s (grid %d)\n", hipGetErrorString(e), grid);
#endif
}
```
